# Optimizing an MI355X kernel written in HIP

```python
import jax
import jax.numpy as jnp
from jax import lax
import numpy as np

D_MODEL = 1024
BATCH = 4
SEQ = 8192
DEPTH = 1
DEC_BATCH = 16
DEC_SEQ = 16
PAST_LEN = 4096

CHUNK = 64
D_PLE = 256
R_HEADS = 8
R_HEAD_DIM = 64
D_R = R_HEADS * R_HEAD_DIM
LORA_W = 64
LORA_A = 64
LORA_G = 128
R_PROJ = 3 * D_R + LORA_W + LORA_A + LORA_G
G_HEADS = 4
G_HEAD_DIM = 128
D_G = G_HEADS * G_HEAD_DIM
CONV_W = 4
G_QKV = 3 * D_G
D_MIX = D_R + D_G
OFF_QKV = R_PROJ
OFF_Z = OFF_QKV + G_QKV
OFF_B = OFF_Z + D_G
OFF_A = OFF_B + G_HEADS
D_IN = OFF_A + G_HEADS
D_FF = -(-(8 * D_MODEL) // (3 * 256)) * 256
RMS_EPS = 1e-6
GN_EPS = 64e-5

kernel_name = 'hybrid_rwkv7_gdn_stream_step'


def _rmsnorm(x, g):
    x32 = x.astype(jnp.float32)
    y = x32 * lax.rsqrt(jnp.mean(x32 * x32, axis=-1, keepdims=True) + RMS_EPS)
    return (y * g.astype(jnp.float32)).astype(x.dtype)


def _l2norm(x):
    return x * lax.rsqrt(jnp.sum(x * x, axis=-1, keepdims=True) + 1e-6)


def _rwkv7_scan(r, w, k, v, kk, a, S0):
    def step(S, xs):
        r_t, w_t, k_t, v_t, kk_t, a_t = xs
        sa = jnp.einsum('bhvk,bhk->bhv', S, kk_t)
        S = (S * w_t[:, :, None, :]
             - jnp.einsum('bhv,bhk->bhvk', sa, kk_t * a_t)
             + jnp.einsum('bhv,bhk->bhvk', v_t, k_t))
        y = jnp.einsum('bhvk,bhk->bhv', S, r_t)
        return S, y
    xs = tuple(jnp.moveaxis(t, 1, 0) for t in (r, w, k, v, kk, a))
    S, y = lax.scan(step, S0, xs)
    return jnp.moveaxis(y, 0, 1), S


def _rwkv7_group(f, shift_prev, S0, mu, w0, w_up, a0, a_up, g_up, k_k, k_a, r_k, lnx_w, lnx_b):
    B, L, _ = f.shape
    f32 = jnp.float32
    f_prev = jnp.concatenate([shift_prev[:, None, :].astype(f.dtype), f[:, :-1]], axis=1)
    fm = f + (f_prev - f) * mu
    r, k, v, wl, al, gl = jnp.split(
        fm, [D_R, 2 * D_R, 3 * D_R, 3 * D_R + LORA_W, 3 * D_R + LORA_W + LORA_A], axis=-1)
    w_log = -jax.nn.softplus(-(w0 + jnp.tanh(wl) @ w_up).astype(f32)) - 0.5
    decay = jnp.exp(-jnp.exp(w_log))
    a = jax.nn.sigmoid((a0 + al @ a_up).astype(f32))
    g = (jax.nn.sigmoid(gl) @ g_up).astype(f32)
    hd = lambda t: t.reshape(B, L, R_HEADS, R_HEAD_DIM)
    k32 = k.astype(f32)
    kk = hd(k32 * k_k)
    kk = kk * lax.rsqrt(jnp.sum(kk * kk, axis=-1, keepdims=True) + 1e-12)
    k_eff = hd(k32 * (1.0 + (a - 1.0) * k_a))
    rh = hd(r.astype(f32))
    vh = hd(v.astype(f32))
    y, S = _rwkv7_scan(rh, hd(decay), k_eff, vh, kk, hd(a), S0.astype(f32))
    mean = jnp.mean(y, axis=-1, keepdims=True)
    var = jnp.mean(jnp.square(y - mean), axis=-1, keepdims=True)
    yn = ((y - mean) * lax.rsqrt(var + GN_EPS)).reshape(B, L, D_R) * lnx_w + lnx_b
    bonus = (jnp.sum(rh * k_eff * r_k, axis=-1, keepdims=True) * vh).reshape(B, L, D_R)
    out = ((yn + bonus) * g).astype(f.dtype)
    return out, f[:, -1], S


def _gated_delta_chunked(q, k, v, glog, beta, S0):
    B, L, H, Dk = q.shape
    Dv = v.shape[-1]
    C = min(CHUNK, L)
    N = L // C
    blk = lambda t: jnp.moveaxis(t.reshape((B, N, C) + t.shape[2:]), 3, 1)
    q, k, v, glog, beta = blk(q), blk(k), blk(v), blk(glog), blk(beta)
    G = jnp.cumsum(glog, axis=-1)
    idx = jnp.arange(C)
    incl = idx[:, None] >= idx[None, :]
    strict = idx[:, None] > idx[None, :]
    dG = G[..., :, None] - G[..., None, :]
    dec_incl = jnp.where(incl, jnp.exp(jnp.where(incl, dG, 0.0)), 0.0)
    dec_strict = jnp.where(strict, dec_incl, 0.0)
    kb = k * beta[..., None]
    A = jnp.einsum('bhnid,bhnjd->bhnij', kb, k) * dec_strict
    eye = jnp.eye(C, dtype=jnp.float32)
    T = lax.linalg.triangular_solve(eye + A, jnp.broadcast_to(eye, A.shape),
                                    left_side=True, lower=True)
    U = jnp.einsum('bhnij,bhnje->bhnie', T, v * beta[..., None])
    Wk = jnp.einsum('bhnij,bhnjd->bhnid', T, kb * jnp.exp(G)[..., None])
    qk = jnp.einsum('bhnid,bhnjd->bhnij', q, k) * dec_incl
    qg = q * jnp.exp(G)[..., None]
    G_last = G[..., -1]
    kd = k * jnp.exp(G_last[..., None] - G)[..., None]

    def step(S, xs):
        U_n, W_n, qg_n, qk_n, kd_n, gl_n = xs
        v_new = U_n - jnp.einsum('bhcd,bhde->bhce', W_n, S)
        o = jnp.einsum('bhcd,bhde->bhce', qg_n, S) + jnp.einsum('bhij,bhje->bhie', qk_n, v_new)
        S = S * jnp.exp(gl_n)[..., None, None] + jnp.einsum('bhcd,bhce->bhde', kd_n, v_new)
        return S, o

    xs = tuple(jnp.moveaxis(t, 2, 0) for t in (U, Wk, qg, qk, kd, G_last))
    S, o = lax.scan(step, S0, xs)
    o = jnp.transpose(o, (1, 0, 3, 2, 4)).reshape(B, L, H, Dv)
    return o, S


def _gdn_group(qkv, z, b, a_raw, conv_prev, S0, conv_w, a_log, dt_bias, norm_g):
    B, L, _ = qkv.shape
    f32 = jnp.float32
    full = jnp.concatenate([conv_prev.astype(qkv.dtype), qkv], axis=1)
    conv = full[:, 0:L] * conv_w[0]
    for j in range(1, CONV_W):
        conv = conv + full[:, j:j + L] * conv_w[j]
    conv = jax.nn.silu(conv.astype(f32))
    q, k, v = jnp.split(conv, [D_G, 2 * D_G], axis=-1)
    hd = lambda t: t.reshape(B, L, G_HEADS, G_HEAD_DIM)
    q = _l2norm(hd(q)) * (G_HEAD_DIM ** -0.5)
    k = _l2norm(hd(k))
    v = hd(v)
    beta = jax.nn.sigmoid(b.astype(f32))
    glog = -jnp.exp(a_log.astype(f32)) * jax.nn.softplus(a_raw.astype(f32) + dt_bias)
    o, S = _gated_delta_chunked(q, k, v, glog, beta, S0.astype(f32))
    o = (o * lax.rsqrt(jnp.mean(o * o, axis=-1, keepdims=True) + RMS_EPS) * norm_g
         * jax.nn.silu(hd(z.astype(f32))))
    return o.reshape(B, L, D_G).astype(qkv.dtype), full[:, L:], S


def _layer(x, p, shift0, wkv0, conv0, gdn0, ln_mix_g, w_in, mu_shift, w0, w_lora_up, a0,
           a_lora_up, g_lora_up, k_k, k_a, r_k, ln_x_w, ln_x_b, conv_w, a_log, dt_bias,
           gdn_norm_g, w_out, ln_ffn_g, w_gate, w_up, w_down, ln_ple_g, w_ple_gate, w_ple_proj):
    h = _rmsnorm(x, ln_mix_g)
    proj = h @ w_in
    r_out, shift1, wkv1 = _rwkv7_group(proj[..., :R_PROJ], shift0, wkv0, mu_shift, w0, w_lora_up,
                                       a0, a_lora_up, g_lora_up, k_k, k_a, r_k, ln_x_w, ln_x_b)
    g_out, conv1, gdn1 = _gdn_group(proj[..., OFF_QKV:OFF_Z], proj[..., OFF_Z:OFF_B],
                                    proj[..., OFF_B:OFF_A], proj[..., OFF_A:], conv0, gdn0,
                                    conv_w, a_log, dt_bias, gdn_norm_g)
    x = x + jnp.concatenate([r_out, g_out], axis=-1) @ w_out
    h = _rmsnorm(x, ln_ffn_g)
    x = x + (jax.nn.silu(h @ w_gate) * (h @ w_up)) @ w_down
    h = _rmsnorm(x, ln_ple_g)
    x = x + jax.nn.sigmoid(h @ w_ple_gate) * (p @ w_ple_proj)
    return (x, shift1.astype(shift0.dtype), wkv1.astype(wkv0.dtype),
            conv1.astype(conv0.dtype), gdn1.astype(gdn0.dtype))


def setup_inputs(seed: int = 0) -> dict:
    key = jax.random.key(seed)
    ks = iter(jax.random.split(key, 48))
    f32 = jnp.float32
    nrm = lambda shape, s: jax.random.normal(next(ks), shape, f32) * s
    uni = lambda shape, lo, hi: jax.random.uniform(next(ks), shape, f32, lo, hi)
    dt = jnp.exp(uni((DEPTH, G_HEADS), float(np.log(1e-3)), float(np.log(1e-1))))
    return {
        'x_prompt': nrm((BATCH, SEQ, D_MODEL), 1.0),
        'x_sample': nrm((DEC_BATCH, DEC_SEQ, D_MODEL), 1.0),
        'state_shift': nrm((DEPTH, DEC_BATCH, R_PROJ), 1.0),
        'state_wkv': nrm((DEPTH, DEC_BATCH, R_HEADS, R_HEAD_DIM, R_HEAD_DIM), 0.1),
        'state_conv': nrm((DEPTH, DEC_BATCH, CONV_W - 1, G_QKV), 1.0),
        'state_gdn': nrm((DEPTH, DEC_BATCH, G_HEADS, G_HEAD_DIM, G_HEAD_DIM), 0.1),
        'p_prompt': nrm((DEPTH, BATCH, SEQ, D_PLE), 1.0),
        'p_sample': nrm((DEPTH, DEC_BATCH, DEC_SEQ, D_PLE), 1.0),
        'ln_mix_g': 1.0 + nrm((DEPTH, D_MODEL), 0.02),
        'w_in': nrm((DEPTH, D_MODEL, D_IN), D_MODEL ** -0.5),
        'mu_shift': uni((DEPTH, R_PROJ), 0.0, 1.0),
        'w0': uni((DEPTH, D_R), -5.0, 0.0),
        'w_lora_up': nrm((DEPTH, LORA_W, D_R), 0.1),
        'a0': nrm((DEPTH, D_R), 0.1),
        'a_lora_up': nrm((DEPTH, LORA_A, D_R), 0.1),
        'g_lora_up': nrm((DEPTH, LORA_G, D_R), LORA_G ** -0.5),
        'k_k': 0.85 + nrm((DEPTH, D_R), 0.05),
        'k_a': 1.0 + nrm((DEPTH, D_R), 0.05),
        'r_k': nrm((DEPTH, R_HEADS, R_HEAD_DIM), 0.1),
        'ln_x_w': 1.0 + nrm((DEPTH, D_R), 0.02),
        'ln_x_b': nrm((DEPTH, D_R), 0.02),
        'conv_w': nrm((DEPTH, CONV_W, G_QKV), 0.5),
        'a_log': jnp.log(uni((DEPTH, G_HEADS), 1.0, 16.0)),
        'dt_bias': dt + jnp.log(-jnp.expm1(-dt)),
        'gdn_norm_g': 1.0 + nrm((DEPTH, G_HEAD_DIM), 0.02),
        'w_out': nrm((DEPTH, D_MIX, D_MODEL), D_MIX ** -0.5),
        'ln_ffn_g': 1.0 + nrm((DEPTH, D_MODEL), 0.02),
        'w_gate': nrm((DEPTH, D_MODEL, D_FF), D_MODEL ** -0.5),
        'w_up': nrm((DEPTH, D_MODEL, D_FF), D_MODEL ** -0.5),
        'w_down': nrm((DEPTH, D_FF, D_MODEL), D_FF ** -0.5),
        'ln_ple_g': 1.0 + nrm((DEPTH, D_MODEL), 0.02),
        'w_ple_gate': nrm((DEPTH, D_MODEL, D_MODEL), D_MODEL ** -0.5),
        'w_ple_proj': nrm((DEPTH, D_PLE, D_MODEL), D_PLE ** -0.5),
        'final_norm_g': 1.0 + nrm((D_MODEL,), 0.02),
    }


def reference(x_prompt, x_sample, state_shift, state_wkv, state_conv, state_gdn, p_prompt, p_sample,
              ln_mix_g, w_in, mu_shift, w0, w_lora_up, a0, a_lora_up, g_lora_up, k_k, k_a, r_k,
              ln_x_w, ln_x_b, conv_w, a_log, dt_bias, gdn_norm_g, w_out, ln_ffn_g, w_gate, w_up,
              w_down, ln_ple_g, w_ple_gate, w_ple_proj, final_norm_g):
    Bp = x_prompt.shape[0]
    dt = x_prompt.dtype
    z_shift = jnp.zeros((Bp, R_PROJ), dt)
    z_wkv = jnp.zeros((Bp, R_HEADS, R_HEAD_DIM, R_HEAD_DIM), dt)
    z_conv = jnp.zeros((Bp, CONV_W - 1, G_QKV), dt)
    z_gdn = jnp.zeros((Bp, G_HEADS, G_HEAD_DIM, G_HEAD_DIM), dt)
    yp, ys = x_prompt, x_sample
    sp_shift, sp_wkv, sp_conv, sp_gdn = [], [], [], []
    ss_shift, ss_wkv, ss_conv, ss_gdn = [], [], [], []
    for l in range(DEPTH):
        wts = (ln_mix_g[l], w_in[l], mu_shift[l], w0[l], w_lora_up[l], a0[l], a_lora_up[l],
               g_lora_up[l], k_k[l], k_a[l], r_k[l], ln_x_w[l], ln_x_b[l], conv_w[l], a_log[l],
               dt_bias[l], gdn_norm_g[l], w_out[l], ln_ffn_g[l], w_gate[l], w_up[l], w_down[l],
               ln_ple_g[l], w_ple_gate[l], w_ple_proj[l])
        yp, a1, a2, a3, a4 = _layer(yp, p_prompt[l], z_shift, z_wkv, z_conv, z_gdn, *wts)
        ys, b1, b2, b3, b4 = _layer(ys, p_sample[l], state_shift[l], state_wkv[l],
                                    state_conv[l], state_gdn[l], *wts)
        sp_shift.append(a1); sp_wkv.append(a2); sp_conv.append(a3); sp_gdn.append(a4)
        ss_shift.append(b1); ss_wkv.append(b2); ss_conv.append(b3); ss_gdn.append(b4)
    y_prompt = _rmsnorm(yp, final_norm_g)
    y_sample = _rmsnorm(ys, final_norm_g)
    new_shift_p = jnp.stack(sp_shift)
    new_wkv_p = jnp.stack(sp_wkv)
    new_conv_p = jnp.stack(sp_conv)
    new_gdn_p = jnp.stack(sp_gdn)
    new_shift_s = jnp.stack(ss_shift)
    new_wkv_s = jnp.stack(ss_wkv)
    new_conv_s = jnp.stack(ss_conv)
    new_gdn_s = jnp.stack(ss_gdn)
    return (y_prompt, y_sample, new_shift_p, new_wkv_p, new_conv_p, new_gdn_p,
            new_shift_s, new_wkv_s, new_conv_s, new_gdn_s)
```

```cpp
#include <hip/hip_runtime.h>
#include <cstdio>
#include <cstdint>
namespace pg8 {
#define PG8_LAS __attribute__((address_space(3)))
typedef unsigned short bf16_t;
typedef short bf16x8 __attribute__((ext_vector_type(8)));
typedef float f32x4 __attribute__((ext_vector_type(4)));
typedef unsigned u32x4 __attribute__((ext_vector_type(4)));
constexpr int BM = 256, BK = 64, HALF = 128, HTB = HALF * BK * 2  , STAGE_BYTES = 8 * HTB, NXCD = 8, WGM = 8;

__host__ __device__ __forceinline__ int lds_byte(int r, int c) { const int st = (r >> 4) * 2 + (c >> 5), rr = r & 15, cc = c & 31, ob = rr * 64 + cc * 2; return st * 1024 + (ob ^ (((ob >> 9) & 1) << 5)); }
__host__ __device__ __forceinline__ void stage_rc(int b, int& R, int& C) { const int st = b / 1024, sb = b % 1024, swz = sb ^ (((sb >> 9) & 1) << 5); R = (st >> 1) * 16 + swz / 64; C = (st & 1) * 32 + (swz % 64) / 2; }
__host__ __device__ __forceinline__ int perm32(int rho) { const int n = rho >> 4, i = rho & 15; return 8 * (i >> 2) + 4 * n + (i & 3); }

struct Unit { int pm, pn; };
struct Gemm { const bf16_t* A; const bf16_t* Bt; int M, N, K; };

struct StaticOrder {
    int nM, nN, nwg, G, c;
    __host__ __device__ void init(int M, int N, int G_, int c_) { nM = M / BM; nN = N / BM; nwg = nM * nN; G = G_; c = c_; }
    __host__ __device__ bool next(int i, Unit& u) const {
        const long L = (long)i * G + c; if (L >= nwg) return false;
        int wgid = (int)L; { const int q = nwg / NXCD, r = nwg % NXCD, xcd = wgid % NXCD, off = wgid / NXCD; wgid = (xcd < r ? xcd * (q + 1) : r * (q + 1) + (xcd - r) * q) + off; }
        const int nig = WGM * nN, gid = wgid / nig, fm = gid * WGM, gsz = (nM - fm) < WGM ? (nM - fm) : WGM;
        u.pm = fm + ((wgid % nig) % gsz); u.pn = (wgid % nig) / gsz; return true;
    }
    __device__ __forceinline__ void a_ready(const Unit&) const {}
    __device__ __forceinline__ void done(const Unit&) const {}
};

__device__ __forceinline__ unsigned cvt_pk_bf16(float lo, float hi) { unsigned r; asm volatile("v_cvt_pk_bf16_f32 %0, %1, %2" : "=v"(r) : "v"(lo), "v"(hi)); return r; }
typedef float f32x2 __attribute__((ext_vector_type(2)));
__device__ __forceinline__ float fsigmoid(float x) { return __builtin_amdgcn_rcpf(1.f + __builtin_amdgcn_exp2f(-1.44269504f * x)); }
struct EpiBf16P {
    static constexpr bool PERM = true, AFTER_DRAIN = false;
    bf16_t* O; int ldc;
    __device__ __forceinline__ void operator()(const f32x4 (&acc)[2][2][4][2], const Unit& u, int wr, int wc, int fr, int fq) const {
        const int row0 = u.pm * BM + wr * 64 + fr, col0 = u.pn * BM + wc * 32 + 8 * fq;
#pragma unroll
        for (int ai = 0; ai < 2; ++ai)
#pragma unroll
            for (int m = 0; m < 4; ++m) { bf16_t* rowp = O + (size_t)(row0 + ai * HALF + m * 16) * ldc + col0;
#pragma unroll
                for (int bj = 0; bj < 2; ++bj) { const f32x4 v0 = acc[ai][bj][m][0], v1 = acc[ai][bj][m][1];
                    u32x4 w; w.x = cvt_pk_bf16(v0[0], v0[1]); w.y = cvt_pk_bf16(v0[2], v0[3]); w.z = cvt_pk_bf16(v1[0], v1[1]); w.w = cvt_pk_bf16(v1[2], v1[3]);
                    *(u32x4*)(rowp + bj * HALF) = w; } }
    }
};
struct EpiRes {
    static constexpr bool PERM = true, AFTER_DRAIN = false;
    const float* base_p; const float* base_s; float* out; bf16_t* ob; float* ssq; int msplit;
    __device__ __forceinline__ void operator()(const f32x4 (&acc)[2][2][4][2], const Unit& u, int wr, int wc, int fr, int fq) const {
        const int row0 = u.pm * BM + wr * 64 + fr, col0 = u.pn * BM + wc * 32 + 8 * fq;
#pragma unroll
        for (int ai = 0; ai < 2; ++ai)
#pragma unroll
            for (int m = 0; m < 4; ++m) { const int r = row0 + ai * HALF + m * 16;
                const float* bp = (r < msplit ? base_p + (size_t)r * 1024 : base_s + (size_t)(r - msplit) * 1024) + col0;
                float* op = out + (size_t)r * 1024 + col0; bf16_t* obp = ob + (size_t)r * 1024 + col0; float s = 0.f;
#pragma unroll
                for (int bj = 0; bj < 2; ++bj) { const f32x4 b0 = *(const f32x4*)(bp + bj * HALF), b1 = *(const f32x4*)(bp + bj * HALF + 4);
                    const f32x4 v0 = acc[ai][bj][m][0] + b0, v1 = acc[ai][bj][m][1] + b1;
                    *(f32x4*)(op + bj * HALF) = v0; *(f32x4*)(op + bj * HALF + 4) = v1;
                    u32x4 w; w.x = cvt_pk_bf16(v0[0], v0[1]); w.y = cvt_pk_bf16(v0[2], v0[3]); w.z = cvt_pk_bf16(v1[0], v1[1]); w.w = cvt_pk_bf16(v1[2], v1[3]);
                    *(u32x4*)(obp + bj * HALF) = w;
                    s += (v0[0] * v0[0] + v0[1] * v0[1]) + (v0[2] * v0[2] + v0[3] * v0[3]) + (v1[0] * v1[0] + v1[1] * v1[1]) + (v1[2] * v1[2] + v1[3] * v1[3]); }
                s += __shfl_xor(s, 16); s += __shfl_xor(s, 32);
                if (fq == 0) ssq[(size_t)r * 16 + u.pn * 4 + wc] = s; }
    }
};
__device__ __forceinline__ float row_rstd16(const float* ssq, int r, int fq) {
    const f32x4 p = *(const f32x4*)(ssq + (size_t)r * 16 + 4 * fq); float s = (p[0] + p[1]) + (p[2] + p[3]);
    s += __shfl_xor(s, 16); s += __shfl_xor(s, 32); return __builtin_amdgcn_rsqf(s * (1.0f / 1024.0f) + 1e-6f);
}
struct EpiSwiGLU {
    static constexpr bool PERM = false, AFTER_DRAIN = false;
    bf16_t* O; const float* ssq;
    __device__ __forceinline__ void operator()(const f32x4 (&acc)[2][2][4][2], const Unit& u, int wr, int wc, int fr, int fq) const {
        const int row0 = u.pm * BM + wr * 64 + fr, col0 = u.pn * 128 + wc * 32 + 8 * fq;
#pragma unroll
        for (int ai = 0; ai < 2; ++ai)
#pragma unroll
            for (int m = 0; m < 4; ++m) { const int r = row0 + ai * HALF + m * 16; const float rs = row_rstd16(ssq, r, fq);
                float o[8];
#pragma unroll
                for (int bj = 0; bj < 2; ++bj)
#pragma unroll
                    for (int j = 0; j < 4; ++j) { const float g = acc[ai][bj][m][0][j] * rs, up = acc[ai][bj][m][1][j] * rs; o[4 * bj + j] = g * fsigmoid(g) * up; }
                u32x4 w; w.x = cvt_pk_bf16(o[0], o[1]); w.y = cvt_pk_bf16(o[2], o[3]); w.z = cvt_pk_bf16(o[4], o[5]); w.w = cvt_pk_bf16(o[6], o[7]);
                *(u32x4*)(O + (size_t)r * 2816 + col0) = w; }
    }
};
struct EpiPle {
    static constexpr bool PERM = true, AFTER_DRAIN = false;
    float* io; const bf16_t* pp; const float* ssq;
    __device__ __forceinline__ void operator()(const f32x4 (&acc)[2][2][4][2], const Unit& u, int wr, int wc, int fr, int fq) const {
        const int row0 = u.pm * BM + wr * 64 + fr, col0 = u.pn * BM + wc * 32 + 8 * fq;
#pragma unroll
        for (int ai = 0; ai < 2; ++ai)
#pragma unroll
            for (int m = 0; m < 4; ++m) { const int r = row0 + ai * HALF + m * 16; const float rs = row_rstd16(ssq, r, fq);
                float* op = io + (size_t)r * 1024 + col0; const bf16_t* ppp = pp + (size_t)r * 1024 + col0;
#pragma unroll
                for (int bj = 0; bj < 2; ++bj) { const f32x4 b0 = *(const f32x4*)(op + bj * HALF), b1 = *(const f32x4*)(op + bj * HALF + 4); const u32x4 pw = *(const u32x4*)(ppp + bj * HALF);
                    f32x4 v0, v1;
                    v0[0] = b0[0] + fsigmoid(acc[ai][bj][m][0][0] * rs) * __uint_as_float(pw.x << 16); v0[1] = b0[1] + fsigmoid(acc[ai][bj][m][0][1] * rs) * __uint_as_float(pw.x & 0xffff0000u);
                    v0[2] = b0[2] + fsigmoid(acc[ai][bj][m][0][2] * rs) * __uint_as_float(pw.y << 16); v0[3] = b0[3] + fsigmoid(acc[ai][bj][m][0][3] * rs) * __uint_as_float(pw.y & 0xffff0000u);
                    v1[0] = b1[0] + fsigmoid(acc[ai][bj][m][1][0] * rs) * __uint_as_float(pw.z << 16); v1[1] = b1[1] + fsigmoid(acc[ai][bj][m][1][1] * rs) * __uint_as_float(pw.z & 0xffff0000u);
                    v1[2] = b1[2] + fsigmoid(acc[ai][bj][m][1][2] * rs) * __uint_as_float(pw.w << 16); v1[3] = b1[3] + fsigmoid(acc[ai][bj][m][1][3] * rs) * __uint_as_float(pw.w & 0xffff0000u);
                    *(f32x4*)(op + bj * HALF) = v0; *(f32x4*)(op + bj * HALF + 4) = v1; } }
    }
};
struct EpiLora {
    static constexpr bool PERM = true, AFTER_DRAIN = false;
    bf16_t* XA; size_t part_stride; const float* w0; const float* a0;
    __device__ __forceinline__ void operator()(const f32x4 (&acc)[2][2][4][2], const Unit& u, int wr, int wc, int fr, int fq) const {
        const int row0 = u.pm * BM + wr * 64 + fr; const int part = u.pn >> 1; const int col0 = (u.pn & 1) * BM + wc * 32 + 8 * fq;
        bf16_t* O = XA + (size_t)part * part_stride; const float* bias = part == 0 ? w0 : a0;
        f32x4 bv[2][2];
#pragma unroll
        for (int bj = 0; bj < 2; ++bj)
#pragma unroll
            for (int n = 0; n < 2; ++n) bv[bj][n] = part < 2 ? *(const f32x4*)(bias + col0 + bj * HALF + 4 * n) : (f32x4){0.f, 0.f, 0.f, 0.f};
#pragma unroll
        for (int ai = 0; ai < 2; ++ai)
#pragma unroll
            for (int m = 0; m < 4; ++m) { bf16_t* rowp = O + (size_t)(row0 + ai * HALF + m * 16) * 512 + col0;
#pragma unroll
                for (int bj = 0; bj < 2; ++bj) { const f32x4 v0 = acc[ai][bj][m][0] + bv[bj][0], v1 = acc[ai][bj][m][1] + bv[bj][1];
                    float o[8] = {v0[0], v0[1], v0[2], v0[3], v1[0], v1[1], v1[2], v1[3]};
                    if (part == 0) {
#pragma unroll
                        for (int j = 0; j < 8; ++j) { const float z = -o[j]; const float sp = fmaxf(z, 0.f) + __logf(1.f + __expf(-fabsf(z))); o[j] = __expf(-sp - 0.5f); } }
                    else if (part == 1) {
#pragma unroll
                        for (int j = 0; j < 8; ++j) o[j] = fsigmoid(o[j]); }
                    u32x4 w; w.x = cvt_pk_bf16(o[0], o[1]); w.y = cvt_pk_bf16(o[2], o[3]); w.z = cvt_pk_bf16(o[4], o[5]); w.w = cvt_pk_bf16(o[6], o[7]);
                    *(u32x4*)(rowp + bj * HALF) = w; }
                __builtin_amdgcn_sched_barrier(0); }
    }
};

template <class Epi, class Sched, bool ALIGN_EPI = false, bool SP2 = false>
__device__ __forceinline__ void gemm_phase(PG8_LAS unsigned char* lds, const Gemm g, const Sched& S, const Epi& E) {
    const int tid = threadIdx.x, wid = __builtin_amdgcn_readfirstlane(tid >> 6), lane = tid & 63, wr = wid >> 2, wc = wid & 3, fr = lane & 15, fq = lane >> 4;
    int K_ = g.K; asm volatile("" : "+s"(K_)); const int K = K_, nt = K / BK;
    unsigned voffA[2], voffB[2];
#pragma unroll
    for (int i = 0; i < 2; ++i) { int R, C; stage_rc(tid * 16 + i * 8192, R, C); const int Rb = Epi::PERM ? ((R & ~31) + perm32(R & 31)) : R;
        voffA[i] = (unsigned)(R * K + C) * 2u; voffB[i] = (unsigned)(Rb * K + C) * 2u; }
    const size_t kstep = (size_t)(BK * 2);
    const size_t hstep = (size_t)HALF * K * 2;
    const size_t tstep = 2 * hstep;
    const unsigned ldsw = (unsigned)wid * 1024u;
    const int aoff = lds_byte(wr * 64 + fr, fq * 8), boff = lds_byte(wc * 32 + fr, fq * 8);
#define PG8_SA(b, h) (((b) * 2 + (h)) * HTB)
#define PG8_SB(b, h) ((4 + (b) * 2 + (h)) * HTB)
#define PG8_STAGE(bufoff, gbase, voff) do { _Pragma("unroll") for (int _i = 0; _i < 2; ++_i) \
        __builtin_amdgcn_global_load_lds((const unsigned*)((const char*)(gbase) + (voff)[_i]), (PG8_LAS unsigned*)(lds + (bufoff) + ldsw + _i * 8192), 16, 0, 0); } while (0)
#define PG8_LDA(dst, b, h) do { _Pragma("unroll") for (int m = 0; m < 4; ++m) _Pragma("unroll") for (int k = 0; k < 2; ++k) dst[m][k] = *(const PG8_LAS bf16x8*)(lds + PG8_SA(b, h) + aoff + m * 2048 + k * 1024); } while (0)
#define PG8_LDB(dst, b, h) do { _Pragma("unroll") for (int n = 0; n < 2; ++n) _Pragma("unroll") for (int k = 0; k < 2; ++k) dst[n][k] = *(const PG8_LAS bf16x8*)(lds + PG8_SB(b, h) + boff + n * 2048 + k * 1024); } while (0)
#define PG8_MMA(ai, bj, At, Bt) do { __builtin_amdgcn_s_setprio(1); _Pragma("unroll") for (int m = 0; m < 4; ++m) _Pragma("unroll") for (int n = 0; n < 2; ++n) _Pragma("unroll") for (int k = 0; k < 2; ++k) \
        acc[ai][bj][m][n] = __builtin_amdgcn_mfma_f32_16x16x32_bf16(Bt[n][k], At[m][k], acc[ai][bj][m][n], 0, 0, 0); __builtin_amdgcn_s_setprio(0); } while (0)
#define PG8_WAIT_V(n) asm volatile("s_waitcnt vmcnt(" #n ")" ::: "memory")
#define PG8_WAIT_L(n) asm volatile("s_waitcnt lgkmcnt(" #n ")" ::: "memory")
#define PG8_BAR __builtin_amdgcn_s_barrier()
#define PG8_SCHED __builtin_amdgcn_sched_barrier(0)
    Unit cur, nxt; int ui = 0;
    if (!S.next(0, cur)) return;
    f32x4 acc[2][2][4][2];
#pragma unroll
    for (int a = 0; a < 2; ++a)
#pragma unroll
        for (int b = 0; b < 2; ++b)
#pragma unroll
            for (int m = 0; m < 4; ++m)
#pragma unroll
                for (int n = 0; n < 2; ++n) acc[a][b][m][n] = (f32x4){0.f, 0.f, 0.f, 0.f};
    bf16x8 At[4][2], B0[2][2], B1[2][2];
    const char* cA = (const char*)g.A + (size_t)cur.pm * tstep; const char* cB = (const char*)g.Bt + (size_t)cur.pn * tstep;
    S.a_ready(cur);
    if constexpr (SP2) {
        PG8_STAGE(PG8_SB(0, 0), cB, voffB); PG8_STAGE(PG8_SB(0, 1), cB + hstep, voffB); PG8_STAGE(PG8_SA(0, 0), cA, voffA); PG8_STAGE(PG8_SA(0, 1), cA + hstep, voffA);
        if (wr == 1) PG8_BAR;
        PG8_WAIT_V(2); PG8_BAR;
        PG8_STAGE(PG8_SB(1, 0), cB + kstep, voffB); PG8_STAGE(PG8_SA(1, 0), cA + kstep, voffA); PG8_STAGE(PG8_SB(1, 1), cB + hstep + kstep, voffB);
        PG8_WAIT_V(6); PG8_BAR;
    } else {
        PG8_STAGE(PG8_SB(0, 0), cB, voffB); PG8_STAGE(PG8_SA(0, 0), cA, voffA); PG8_STAGE(PG8_SB(0, 1), cB + hstep, voffB); PG8_STAGE(PG8_SA(0, 1), cA + hstep, voffA);
        if (wr == 1) PG8_BAR;
        PG8_WAIT_V(4); PG8_BAR;
        PG8_STAGE(PG8_SB(1, 0), cB + kstep, voffB); PG8_STAGE(PG8_SA(1, 0), cA + kstep, voffA); PG8_STAGE(PG8_SB(1, 1), cB + hstep + kstep, voffB);
        PG8_WAIT_V(6); PG8_BAR;
    }
    for (;;) {
        const bool has_next = S.next(ui + 1, nxt);
        const char* nA = has_next ? (const char*)g.A + (size_t)nxt.pm * tstep : cA; const char* nB = has_next ? (const char*)g.Bt + (size_t)nxt.pn * tstep : cB;
        for (int t = 0; t < nt; t += 2) {
            const bool last = (t == nt - 2);
            const char* a1 = cA + (size_t)(t + 1) * kstep;
            const char* a2 = last ? nA : cA + (size_t)(t + 2) * kstep; const char* b2 = last ? nB : cB + (size_t)(t + 2) * kstep;
            const char* a3 = a2 + kstep; const char* b3 = b2 + kstep;
            if (last && has_next) S.a_ready(nxt);
            if constexpr (SP2) {
            PG8_LDB(B0, 0, 0); PG8_LDB(B1, 0, 1); PG8_SCHED; PG8_LDA(At, 0, 0); PG8_STAGE(PG8_SA(1, 1), a1 + hstep, voffA);
            PG8_WAIT_V(8); PG8_WAIT_L(0); PG8_BAR; PG8_MMA(0, 0, At, B0); PG8_MMA(0, 1, At, B1); PG8_BAR; PG8_SCHED;
            PG8_LDA(At, 0, 1); PG8_STAGE(PG8_SB(0, 0), b2, voffB); PG8_STAGE(PG8_SB(0, 1), b2 + hstep, voffB); PG8_STAGE(PG8_SA(0, 0), a2, voffA);
            PG8_WAIT_V(8); PG8_WAIT_L(0); PG8_BAR; PG8_MMA(1, 0, At, B0); PG8_MMA(1, 1, At, B1); PG8_BAR; PG8_SCHED;
            PG8_LDB(B0, 1, 0); PG8_LDB(B1, 1, 1); PG8_SCHED; PG8_LDA(At, 1, 0); PG8_STAGE(PG8_SA(0, 1), a2 + hstep, voffA);
            PG8_WAIT_V(8); PG8_WAIT_L(0); PG8_BAR; PG8_MMA(0, 0, At, B0); PG8_MMA(0, 1, At, B1); PG8_BAR; PG8_SCHED;
            PG8_LDA(At, 1, 1); PG8_STAGE(PG8_SB(1, 0), b3, voffB); PG8_STAGE(PG8_SB(1, 1), b3 + hstep, voffB); PG8_STAGE(PG8_SA(1, 0), a3, voffA);
            PG8_WAIT_V(8); PG8_WAIT_L(0); PG8_BAR; PG8_MMA(1, 0, At, B0); PG8_MMA(1, 1, At, B1); PG8_BAR; PG8_SCHED;
            } else {
            PG8_LDB(B0, 0, 0); PG8_SCHED; PG8_LDA(At, 0, 0); PG8_STAGE(PG8_SA(1, 1), a1 + hstep, voffA);
            PG8_WAIT_L(8); PG8_BAR; PG8_WAIT_L(0); PG8_MMA(0, 0, At, B0); PG8_BAR; PG8_SCHED;
            PG8_LDB(B1, 0, 1); PG8_STAGE(PG8_SB(0, 0), b2, voffB);
            PG8_BAR; PG8_WAIT_L(0); PG8_MMA(0, 1, At, B1); PG8_BAR;
            PG8_LDA(At, 0, 1); PG8_STAGE(PG8_SA(0, 0), a2, voffA);
            PG8_BAR; PG8_WAIT_L(0); PG8_MMA(1, 0, At, B0); PG8_BAR; PG8_SCHED;
            PG8_STAGE(PG8_SB(0, 1), b2 + hstep, voffB);
            PG8_WAIT_V(6); PG8_BAR; PG8_MMA(1, 1, At, B1); PG8_BAR;
            PG8_LDB(B0, 1, 0); PG8_SCHED; PG8_LDA(At, 1, 0); PG8_STAGE(PG8_SA(0, 1), a2 + hstep, voffA);
            PG8_WAIT_L(8); PG8_BAR; PG8_WAIT_L(0); PG8_MMA(0, 0, At, B0); PG8_BAR; PG8_SCHED;
            PG8_LDB(B1, 1, 1); PG8_STAGE(PG8_SB(1, 0), b3, voffB);
            PG8_BAR; PG8_WAIT_L(0); PG8_MMA(0, 1, At, B1); PG8_BAR;
            PG8_LDA(At, 1, 1); PG8_STAGE(PG8_SA(1, 0), a3, voffA);
            PG8_BAR; PG8_WAIT_L(0); PG8_MMA(1, 0, At, B0); PG8_BAR; PG8_SCHED;
            PG8_STAGE(PG8_SB(1, 1), b3 + hstep, voffB);
            PG8_WAIT_V(6); PG8_BAR; PG8_MMA(1, 1, At, B1); PG8_BAR;
            }
        }
        if constexpr (ALIGN_EPI) { if (wr == 0) PG8_BAR; }
        if constexpr (!Epi::AFTER_DRAIN) { E(acc, cur, wr, wc, fr, fq); S.done(cur); }
        if (!has_next) break;
#pragma unroll
        for (int a = 0; a < 2; ++a)
#pragma unroll
            for (int b = 0; b < 2; ++b)
#pragma unroll
                for (int m = 0; m < 4; ++m)
#pragma unroll
                    for (int n = 0; n < 2; ++n) acc[a][b][m][n] = (f32x4){0.f, 0.f, 0.f, 0.f};
        cur = nxt; cA = nA; cB = nB; ++ui;
        if constexpr (ALIGN_EPI) { if (wr == 1) PG8_BAR; }
    }
    PG8_WAIT_V(0);
    if constexpr (!ALIGN_EPI) { if (wr == 0) PG8_BAR; }
    PG8_BAR;
    if constexpr (Epi::AFTER_DRAIN) { E.fused(acc, cur, wr, wc, fr, fq, lds, wid, lane); S.done(cur); }
#undef PG8_SA
#undef PG8_SB
#undef PG8_STAGE
#undef PG8_LDA
#undef PG8_LDB
#undef PG8_MMA
#undef PG8_WAIT_V
#undef PG8_WAIT_L
#undef PG8_BAR
#undef PG8_SCHED
}
}
using bf16 = unsigned short;
constexpr int NWAVES = 8;
constexpr int DM = 1024, MP = 32768, MS = 256, MROWS = MP + MS, SEQL = 8192, SSL = 16;
constexpr int NPROJ = 3840, DIN = 3848, RPROJ = 1792, OFF_QKV = 1792, OFF_Z = 3328, DFF = 2816, NGU = 5632, DPLE = 256, NLORA = 1536, KLORA = 256;
constexpr int GQ = 1536;
constexpr float RMS_EPS = 1e-6f, GN_EPS = 64e-5f;
constexpr size_t O_Y = 0, O_SHIFT_P = (size_t)MROWS * DM, O_WKV_P = O_SHIFT_P + 4 * 1792, O_CONV_P = O_WKV_P + 4 * 8 * 4096, O_GDN_P = O_CONV_P + 4 * 3 * 1536,
                 O_SHIFT_S = O_GDN_P + 4 * 4 * 16384, O_WKV_S = O_SHIFT_S + 16 * 1792, O_CONV_S = O_WKV_S + 16 * 8 * 4096, O_GDN_S = O_CONV_S + 16 * 3 * 1536, O_END = O_GDN_S + 16 * 4 * 16384;
static_assert(O_END == 35910656, "d_out size");
constexpr size_t MiB = 1u << 20;
constexpr size_t WS_CTL = 0, CTL_ZERO_BYTES = 1 * MiB;
constexpr size_t WS_WIN = 2 * MiB, WS_WOUT = 10 * MiB, WS_WGU = 12 * MiB, WS_WDOWN = 23 * MiB, WS_WPG = 29 * MiB, WS_WPP = 31 * MiB, WS_WLORA = 31 * MiB + 512 * 1024;
constexpr size_t WS_XN = 33 * MiB;
constexpr size_t WS_PROJ = 98 * MiB;
constexpr size_t WS_ACT = 163 * MiB;
constexpr size_t WS_XA = 341 * MiB, WS_AA = 374 * MiB, WS_GA = 407 * MiB;
constexpr size_t WS_PB = WS_XA;
constexpr size_t WS_LIN = 440 * MiB;
constexpr size_t WS_RN = 457 * MiB, WS_BG = 459 * MiB, WS_BA = 461 * MiB;
constexpr size_t WS_SSQ2 = 463 * MiB, WS_SSQ3 = 466 * MiB;
constexpr size_t WS_YBF = 469 * MiB;
constexpr size_t WS_END = 502 * MiB;
static_assert(WS_PROJ + (size_t)MROWS * NPROJ * 2 <= WS_XA && WS_ACT + (size_t)MROWS * DFF * 2 <= WS_XA && WS_XN + (size_t)MROWS * DM * 2 <= WS_PROJ && WS_PROJ + (size_t)MROWS * DM * 2 <= WS_ACT, "ws map");
static_assert(WS_YBF + (size_t)MROWS * 512 * 2 <= WS_END && WS_LIN + (size_t)MROWS * 256 * 2 <= WS_RN && WS_XA + (size_t)MROWS * 512 * 2 <= WS_AA && WS_GA + (size_t)MROWS * 512 * 2 <= WS_LIN, "ws map 2");
constexpr int CW_BAR = 4096;
constexpr int RING_OFF = 0, RING_BYTES = 131072;
constexpr int LDSCTL_OFF = RING_BYTES, MISC_OFF = LDSCTL_OFF + 320;
constexpr int LDS_BYTES = 147456;
#define GAS __attribute__((address_space(1)))
#define LAS __attribute__((address_space(3)))
typedef unsigned v4u __attribute__((ext_vector_type(4)));
typedef float f32x4 __attribute__((ext_vector_type(4)));
typedef short bf16x8 __attribute__((ext_vector_type(8)));
typedef GAS unsigned gu32;
typedef GAS unsigned long long gu64;
#define RLX_AGENT __ATOMIC_RELAXED, __HIP_MEMORY_SCOPE_AGENT
#define LDS_WAIT() asm volatile("s_waitcnt lgkmcnt(0)" ::: "memory")
#define VM_WAIT() asm volatile("s_waitcnt vmcnt(0)" ::: "memory")
__device__ __forceinline__ unsigned long long rt() { return __builtin_amdgcn_s_memrealtime(); }
__device__ __forceinline__ unsigned f2bf(float f) { unsigned u = __builtin_bit_cast(unsigned, f); return (u + 0x7fffu + ((u >> 16) & 1u)) >> 16; }
__device__ __forceinline__ unsigned pk2(float lo, float hi) { return f2bf(lo) | (f2bf(hi) << 16); }

#define XB_TMO      128
#define XB_XCNT(j)  (256  + 64 * (j))
#define XB_XSUB(j)  (1280 + 64 * (j))
#define XB_XGEN(j)  (2304 + 64 * (j))
#define XB_TOP      3328
#define XB_TOPGEN   3392
#define XCD_BAR_WORDS 3456
#define XB_SPIN_CAP (1u << 18)

__device__ __forceinline__ unsigned xb_ld(unsigned* p)              { return __hip_atomic_load(p, __ATOMIC_RELAXED, __HIP_MEMORY_SCOPE_AGENT); }
__device__ __forceinline__ unsigned xb_add(unsigned* p, unsigned v) { return __hip_atomic_fetch_add(p, v, __ATOMIC_RELAXED, __HIP_MEMORY_SCOPE_AGENT); }
__device__ __forceinline__ unsigned xb_xcc_id() { return (unsigned)__builtin_amdgcn_s_getreg((3 << 11) | 20) & 0xFu; }
#define XB_SPIN(cond, bar) do { unsigned _sp = 0; while (cond) { __builtin_amdgcn_s_sleep(1); \
    if ((++_sp & 255u) == 0u) { if (xb_ld(&(bar)[XB_TMO])) break; if (_sp > XB_SPIN_CAP) { atomicAdd(&(bar)[XB_TMO], 1u); break; } } } } while (0)

struct XcdBarrier {
    unsigned* bar; unsigned x;
    volatile LAS unsigned* st;
};

__device__ __forceinline__ XcdBarrier xcd_barrier_post(unsigned* bar, volatile LAS unsigned* st) {
    XcdBarrier b; b.bar = bar; b.x = xb_xcc_id(); b.st = st;
    if (threadIdx.x == 0) (void)xb_add(&bar[XB_XCNT(b.x)], 1u);
    return b;
}
__device__ __forceinline__ void xcd_barrier_complete(unsigned* bar, unsigned x, unsigned& nloc, unsigned& nx) {
    const unsigned G = gridDim.x * gridDim.y * gridDim.z;
    unsigned sum, cnt, mine, sp = 0u;
    for (;;) {
        sum = 0u; cnt = 0u; mine = 0u;
#pragma unroll
        for (unsigned j = 0; j < 16; ++j) { const unsigned c = xb_ld(&bar[XB_XCNT(j)]); sum += c; cnt += (c > 0u) ? 1u : 0u; mine = (j == x) ? c : mine; }
        if (sum == G) break;
        __builtin_amdgcn_s_sleep(1);
        if ((++sp & 255u) == 0u) { if (xb_ld(&bar[XB_TMO])) break; if (sp > XB_SPIN_CAP) { atomicAdd(&bar[XB_TMO], 1u); break; } }
    }
    nloc = mine > 0u ? mine : 1u; nx = cnt > 0u ? cnt : 1u;
}

__device__ __forceinline__ void xcd_barrier(const XcdBarrier& b) {
    asm volatile("s_waitcnt vmcnt(0)" ::: "memory");
    __syncthreads();
    if (threadIdx.x == 0) {
        unsigned* bar = b.bar;
        __builtin_amdgcn_s_waitcnt(0);
        unsigned nloc = b.st[0], nx = b.st[1];
        if (nloc == 0u) { xcd_barrier_complete(bar, b.x, nloc, nx); b.st[0] = nloc; b.st[1] = nx; }
        const unsigned old = xb_add(&bar[XB_XSUB(b.x)], 1u);
        const unsigned gen = old / nloc;
        if (old + 1u == (gen + 1u) * nloc) {
            __builtin_amdgcn_fence(__ATOMIC_RELEASE, "agent");
            asm volatile("s_waitcnt vmcnt(0)" ::: "memory");
            const unsigned og = xb_add(&bar[XB_TOP], 1u);
            const unsigned tg = og / nx;
            if (og + 1u == (tg + 1u) * nx) xb_add(&bar[XB_TOPGEN], 1u);
            else XB_SPIN(xb_ld(&bar[XB_TOPGEN]) == tg, bar);
            __builtin_amdgcn_fence(__ATOMIC_ACQUIRE, "agent");
            xb_add(&bar[XB_XGEN(b.x)], 1u);
            asm volatile("s_waitcnt vmcnt(0)" ::: "memory");
        } else {
            XB_SPIN(xb_ld(&bar[XB_XGEN(b.x)]) == gen, bar);
            __builtin_amdgcn_fence(__ATOMIC_ACQUIRE, "agent");
            asm volatile("s_waitcnt vmcnt(0)" ::: "memory");
        }
    }
    __syncthreads();
}
__device__ __forceinline__ float wave_sum(float v) {
#pragma unroll
    for (int o = 1; o < 64; o <<= 1) v += __shfl_xor(v, o);
    return v;
}
__device__ __forceinline__ float bflo(unsigned w) { return __uint_as_float(w << 16); }
__device__ __forceinline__ float bfhi(unsigned w) { return __uint_as_float(w & 0xffff0000u); }
__device__ __forceinline__ void unpack8(const v4u w, float (&o)[8]) { o[0] = bflo(w.x); o[1] = bfhi(w.x); o[2] = bflo(w.y); o[3] = bfhi(w.y); o[4] = bflo(w.z); o[5] = bfhi(w.z); o[6] = bflo(w.w); o[7] = bfhi(w.w); }
__device__ __forceinline__ v4u pack8(const float (&o)[8]) { v4u w; w.x = pk2(o[0], o[1]); w.y = pk2(o[2], o[3]); w.z = pk2(o[4], o[5]); w.w = pk2(o[6], o[7]); return w; }
__device__ __forceinline__ float fsig(float x) { return __builtin_amdgcn_rcpf(1.f + __builtin_amdgcn_exp2f(-1.44269504f * x)); }
__device__ __forceinline__ float ftanh(float x) { return 1.f - 2.f * __builtin_amdgcn_rcpf(1.f + __builtin_amdgcn_exp2f(2.88539008f * x)); }
__device__ __forceinline__ float fsoftplus(float z) { return fmaxf(z, 0.f) + __logf(1.f + __expf(-fabsf(z))); }

__device__ __forceinline__ int gu_row(int c, int ty) { const int pn = c >> 7, cc = c & 127, wc = cc >> 5, rem = cc & 31, fq = rem >> 3, bj = (rem >> 2) & 1, j = rem & 3; return 256 * pn + 128 * bj + 32 * wc + 16 * ty + 4 * fq + j; }
__device__ __forceinline__ void p0_tr(const float* W, int ldw, int sk0, int sn0, bf16* WT, int ldt, int dk0, int dn0, LAS float* scr, int lane, const float* kscale, int mode) {
#pragma unroll 8
    for (int i = 0; i < 32; ++i) { const int kk = 2 * i + (lane >> 5); float w = W[(size_t)(sk0 + kk) * ldw + sn0 + (lane & 31)]; if (kscale) w *= kscale[sk0 + kk]; scr[kk * 33 + (lane & 31)] = w; }
    LDS_WAIT(); asm volatile("" ::: "memory");
    const int c = lane & 7;
#pragma unroll
    for (int j = 0; j < 4; ++j) { const int n = (lane >> 3) + 8 * j; const LAS float* s = scr + (8 * c) * 33 + n;
        v4u o; o.x = pk2(s[0 * 33], s[1 * 33]); o.y = pk2(s[2 * 33], s[3 * 33]); o.z = pk2(s[4 * 33], s[5 * 33]); o.w = pk2(s[6 * 33], s[7 * 33]);
        const int drow = mode == 0 ? dn0 + n : gu_row(sn0 + n, mode - 1);
        *(GAS v4u*)(WT + (size_t)drow * ldt + dk0 + 8 * c) = o; }
    LDS_WAIT(); asm volatile("" ::: "memory");
}
struct Args { const float* in[34]; float* out; unsigned char* ws; int ph_lo, ph_hi; };
struct Ptrs {
    const __attribute__((address_space(4))) Args* Ap;
    __device__ __forceinline__ const float* xp() const { return Ap->in[0]; }
    __device__ __forceinline__ const float* xs() const { return Ap->in[1]; }
    __device__ __forceinline__ const float* sshift() const { return Ap->in[2]; }
    __device__ __forceinline__ const float* swkv() const { return Ap->in[3]; }
    __device__ __forceinline__ const float* sconv() const { return Ap->in[4]; }
    __device__ __forceinline__ const float* sgdn() const { return Ap->in[5]; }
    __device__ __forceinline__ const float* pp_() const { return Ap->in[6]; }
    __device__ __forceinline__ const float* ps_() const { return Ap->in[7]; }
    __device__ __forceinline__ const float* ln_mix_g() const { return Ap->in[8]; }
    __device__ __forceinline__ const float* w_in() const { return Ap->in[9]; }
    __device__ __forceinline__ const float* mu() const { return Ap->in[10]; }
    __device__ __forceinline__ const float* w0() const { return Ap->in[11]; }
    __device__ __forceinline__ const float* wl_up() const { return Ap->in[12]; }
    __device__ __forceinline__ const float* a0() const { return Ap->in[13]; }
    __device__ __forceinline__ const float* al_up() const { return Ap->in[14]; }
    __device__ __forceinline__ const float* gl_up() const { return Ap->in[15]; }
    __device__ __forceinline__ const float* k_k() const { return Ap->in[16]; }
    __device__ __forceinline__ const float* k_a() const { return Ap->in[17]; }
    __device__ __forceinline__ const float* r_k() const { return Ap->in[18]; }
    __device__ __forceinline__ const float* lnx_w() const { return Ap->in[19]; }
    __device__ __forceinline__ const float* lnx_b() const { return Ap->in[20]; }
    __device__ __forceinline__ const float* conv_w() const { return Ap->in[21]; }
    __device__ __forceinline__ const float* a_log() const { return Ap->in[22]; }
    __device__ __forceinline__ const float* dt_bias() const { return Ap->in[23]; }
    __device__ __forceinline__ const float* gdn_g() const { return Ap->in[24]; }
    __device__ __forceinline__ const float* w_out() const { return Ap->in[25]; }
    __device__ __forceinline__ const float* ln_ffn_g() const { return Ap->in[26]; }
    __device__ __forceinline__ const float* w_gate() const { return Ap->in[27]; }
    __device__ __forceinline__ const float* w_up() const { return Ap->in[28]; }
    __device__ __forceinline__ const float* w_down() const { return Ap->in[29]; }
    __device__ __forceinline__ const float* ln_ple_g() const { return Ap->in[30]; }
    __device__ __forceinline__ const float* w_pg() const { return Ap->in[31]; }
    __device__ __forceinline__ const float* w_pp() const { return Ap->in[32]; }
    __device__ __forceinline__ const float* fin_g() const { return Ap->in[33]; }
    __device__ __forceinline__ float* out() const { return Ap->out; }
    __device__ __forceinline__ bf16* Win_t() const { return (bf16*)(Ap->ws + WS_WIN); }
    __device__ __forceinline__ bf16* Wout_t() const { return (bf16*)(Ap->ws + WS_WOUT); }
    __device__ __forceinline__ bf16* Wgu_t() const { return (bf16*)(Ap->ws + WS_WGU); }
    __device__ __forceinline__ bf16* Wdown_t() const { return (bf16*)(Ap->ws + WS_WDOWN); }
    __device__ __forceinline__ bf16* Wpg_t() const { return (bf16*)(Ap->ws + WS_WPG); }
    __device__ __forceinline__ bf16* Wpp_t() const { return (bf16*)(Ap->ws + WS_WPP); }
    __device__ __forceinline__ bf16* Wlora_t() const { return (bf16*)(Ap->ws + WS_WLORA); }
    __device__ __forceinline__ bf16* XN() const { return (bf16*)(Ap->ws + WS_XN); }
    __device__ __forceinline__ bf16* PROJ() const { return (bf16*)(Ap->ws + WS_PROJ); }
    __device__ __forceinline__ bf16* ACT() const { return (bf16*)(Ap->ws + WS_ACT); }
    __device__ __forceinline__ bf16* XA() const { return (bf16*)(Ap->ws + WS_XA); }
    __device__ __forceinline__ bf16* AA() const { return (bf16*)(Ap->ws + WS_AA); }
    __device__ __forceinline__ bf16* GA() const { return (bf16*)(Ap->ws + WS_GA); }
    __device__ __forceinline__ bf16* PB() const { return (bf16*)(Ap->ws + WS_PB); }
    __device__ __forceinline__ bf16* LIN() const { return (bf16*)(Ap->ws + WS_LIN); }
    __device__ __forceinline__ bf16* YBF() const { return (bf16*)(Ap->ws + WS_YBF); }
    __device__ __forceinline__ float* RN() const { return (float*)(Ap->ws + WS_RN); }
    __device__ __forceinline__ float* BG() const { return (float*)(Ap->ws + WS_BG); }
    __device__ __forceinline__ float* BA() const { return (float*)(Ap->ws + WS_BA); }
    __device__ __forceinline__ float* SSQ2() const { return (float*)(Ap->ws + WS_SSQ2); }
    __device__ __forceinline__ float* SSQ3() const { return (float*)(Ap->ws + WS_SSQ3); }
    __device__ __forceinline__ bf16* GQKV() const { return (bf16*)Ap->out; }
    __device__ __forceinline__ bf16* OBF() const { return (bf16*)Ap->out + (size_t)MROWS * GQ; }
};
__device__ __forceinline__ void p0_prologue(const Ptrs& P, LAS unsigned char* lds, int gw, int NGW, int wave, int lane) {
    LAS float* scr = (LAS float*)(lds + RING_OFF + wave * 16384);
    constexpr int I_IN = 16 * 120, I_OUT = 16 * 32, I_G = 16 * 88, I_DN = 44 * 32, I_PG = 16 * 32, I_PP = 4 * 32, I_LO = 4 * 48;
    constexpr int NITEMS = I_IN + I_OUT + 2 * I_G + I_DN + I_PG + I_PP + I_LO;
    for (int it = gw; it < NITEMS; it += NGW) {
        int r = it;
        if (r < I_IN) { p0_tr(P.w_in(), DIN, 64 * (r / 120), 32 * (r % 120), P.Win_t(), 1024, 64 * (r / 120), 32 * (r % 120), scr, lane, nullptr, 0); continue; } r -= I_IN;
        if (r < I_OUT) { p0_tr(P.w_out(), 1024, 64 * (r / 32), 32 * (r % 32), P.Wout_t(), 1024, 64 * (r / 32), 32 * (r % 32), scr, lane, nullptr, 0); continue; } r -= I_OUT;
        if (r < I_G) { p0_tr(P.w_gate(), DFF, 64 * (r / 88), 32 * (r % 88), P.Wgu_t(), 1024, 64 * (r / 88), 0, scr, lane, P.ln_ffn_g(), 1); continue; } r -= I_G;
        if (r < I_G) { p0_tr(P.w_up(), DFF, 64 * (r / 88), 32 * (r % 88), P.Wgu_t(), 1024, 64 * (r / 88), 0, scr, lane, P.ln_ffn_g(), 2); continue; } r -= I_G;
        if (r < I_DN) { p0_tr(P.w_down(), 1024, 64 * (r / 32), 32 * (r % 32), P.Wdown_t(), DFF, 64 * (r / 32), 32 * (r % 32), scr, lane, nullptr, 0); continue; } r -= I_DN;
        if (r < I_PG) { p0_tr(P.w_pg(), 1024, 64 * (r / 32), 32 * (r % 32), P.Wpg_t(), 1024, 64 * (r / 32), 32 * (r % 32), scr, lane, P.ln_ple_g(), 0); continue; } r -= I_PG;
        if (r < I_PP) { p0_tr(P.w_pp(), 1024, 64 * (r / 32), 32 * (r % 32), P.Wpp_t(), 256, 64 * (r / 32), 32 * (r % 32), scr, lane, nullptr, 0); continue; } r -= I_PP;
        {
            const int kb = r / 48, nb = r % 48, part = nb / 16, n0 = 32 * (nb % 16);
            const bool nz = (part == 0 && kb == 0) || (part == 1 && kb == 1) || (part == 2 && kb >= 2);
            if (nz) { const float* W = part == 0 ? P.wl_up() : (part == 1 ? P.al_up() : P.gl_up()); p0_tr(W, 512, part == 2 ? 64 * (kb - 2) : 0, n0, P.Wlora_t(), 256, 64 * kb, 512 * part + n0, scr, lane, nullptr, 0); }
            else { const int c = lane & 7;
#pragma unroll
                for (int j = 0; j < 4; ++j) { const int n = (lane >> 3) + 8 * j; *(GAS v4u*)(P.Wlora_t() + (size_t)(512 * part + n0 + n) * 256 + 64 * kb + 8 * c) = (v4u){0u, 0u, 0u, 0u}; } }
        }
    }
    f32x4 gv[4];
#pragma unroll
    for (int j = 0; j < 4; ++j) gv[j] = *(const f32x4*)(P.ln_mix_g() + 4 * lane + 256 * j);
    f32x4 wq[16][2];
#pragma unroll
    for (int j = 0; j < 4; ++j)
#pragma unroll
        for (int i = 0; i < 4; ++i) { const float* wr_ = P.w_in() + (size_t)(256 * j + 4 * lane + i) * DIN + NPROJ; wq[4 * j + i][0] = *(const f32x4*)wr_; wq[4 * j + i][1] = *(const f32x4*)(wr_ + 4); }
    for (int m = gw; m < MROWS; m += NGW) {
        const float* xr = m < MP ? P.xp() + (size_t)m * DM : P.xs() + (size_t)(m - MP) * DM;
        const GAS f32x4* x4 = (const GAS f32x4*)xr + lane;
        f32x4 v[4]; float ss = 0.f;
#pragma unroll
        for (int j = 0; j < 4; ++j) { v[j] = x4[64 * j]; ss += (v[j].x * v[j].x + v[j].y * v[j].y) + (v[j].z * v[j].z + v[j].w * v[j].w); }
        const float rstd = 1.0f / sqrtf(wave_sum(ss) * (1.f / DM) + RMS_EPS);
        GAS unsigned long long* o8 = (GAS unsigned long long*)(P.XN() + (size_t)m * DM) + lane;
        f32x4 d0 = {0.f, 0.f, 0.f, 0.f}, d1 = {0.f, 0.f, 0.f, 0.f};
#pragma unroll
        for (int j = 0; j < 4; ++j) { const f32x4 h = v[j] * rstd * gv[j];
            o8[64 * j] = (unsigned long long)pk2(h.x, h.y) | ((unsigned long long)pk2(h.z, h.w) << 32);
#pragma unroll
            for (int i = 0; i < 4; ++i) { d0 += wq[4 * j + i][0] * h[i]; d1 += wq[4 * j + i][1] * h[i]; } }
#pragma unroll
        for (int c = 0; c < 4; ++c) { d0[c] = wave_sum(d0[c]); d1[c] = wave_sum(d1[c]); }
        if (lane == 0) { *(f32x4*)(P.BA() + (size_t)m * 8) = d0; *(f32x4*)(P.BA() + (size_t)m * 8 + 4) = d1; }
    }
}
__device__ __forceinline__ void row_info(int m, int& t, int& sb) { if (m < MP) { t = m & (SEQL - 1); sb = -1; } else { t = (m - MP) & (SSL - 1); sb = (m - MP) >> 4; } }
__device__ __forceinline__ void load_fm8(const Ptrs& P, int m, int t, int sb, int c0, float (&o)[8]) {
    float f[8], p[8];
    unpack8(*(const GAS v4u*)(P.PROJ() + (size_t)m * NPROJ + c0), f);
    if (t > 0) unpack8(*(const GAS v4u*)(P.PROJ() + (size_t)(m - 1) * NPROJ + c0), p);
    else if (sb >= 0) { const f32x4 a = *(const f32x4*)(P.sshift() + (size_t)sb * RPROJ + c0), b = *(const f32x4*)(P.sshift() + (size_t)sb * RPROJ + c0 + 4); p[0] = a.x; p[1] = a.y; p[2] = a.z; p[3] = a.w; p[4] = b.x; p[5] = b.y; p[6] = b.z; p[7] = b.w; }
    else {
#pragma unroll
        for (int i = 0; i < 8; ++i) p[i] = 0.f; }
    const f32x4 m0 = *(const f32x4*)(P.mu() + c0), m1 = *(const f32x4*)(P.mu() + c0 + 4);
#pragma unroll
    for (int i = 0; i < 8; ++i) o[i] = f[i] + (p[i] - f[i]) * (i < 4 ? m0[i] : m1[i - 4]);
}
__device__ __forceinline__ float load_fm1(const Ptrs& P, int m, int t, int sb, int c) {
    const float f = __uint_as_float((unsigned)P.PROJ()[(size_t)m * NPROJ + c] << 16);
    float p = 0.f;
    if (t > 0) p = __uint_as_float((unsigned)P.PROJ()[(size_t)(m - 1) * NPROJ + c] << 16); else if (sb >= 0) p = P.sshift()[(size_t)sb * RPROJ + c];
    return f + (p - f) * P.mu()[c];
}
__device__ __forceinline__ void p2_token_prep(const Ptrs& P, int gw, int NGW, int lane) {
    for (int m = gw; m < MROWS; m += NGW) {
        int t, sb; row_info(m, t, sb);
        {
            const float fw = load_fm1(P, m, t, sb, 1536 + lane), fa = load_fm1(P, m, t, sb, 1600 + lane), fg0 = load_fm1(P, m, t, sb, 1664 + lane), fg1 = load_fm1(P, m, t, sb, 1728 + lane);
            bf16* lr = P.LIN() + (size_t)m * KLORA;
            lr[lane] = (bf16)f2bf(ftanh(fw)); lr[64 + lane] = (bf16)f2bf(fa); lr[128 + lane] = (bf16)f2bf(fsig(fg0)); lr[192 + lane] = (bf16)f2bf(fsig(fg1));
        }
        {
            float k[8]; load_fm8(P, m, t, sb, 512 + 8 * lane, k);
            const f32x4 kk0 = *(const f32x4*)(P.k_k() + 8 * lane), kk1 = *(const f32x4*)(P.k_k() + 8 * lane + 4); float s = 0.f;
#pragma unroll
            for (int i = 0; i < 8; ++i) { const float q = k[i] * (i < 4 ? kk0[i] : kk1[i - 4]); s += q * q; }
            s += __shfl_xor(s, 1); s += __shfl_xor(s, 2); s += __shfl_xor(s, 4);
            if ((lane & 7) == 0) P.RN()[(size_t)m * 8 + (lane >> 3)] = 1.0f / sqrtf(s + 1e-12f);
        }
        {
#pragma unroll
            for (int part = 0; part < 3; ++part) {
                const int ch = part * 512 + 8 * lane; float acc[8];
#pragma unroll
                for (int i = 0; i < 8; ++i) acc[i] = 0.f;
#pragma unroll
                for (int j = 0; j < 4; ++j) {
                    const int tt = t - 3 + j; float v[8];
                    if (tt >= 0) unpack8(*(const GAS v4u*)(P.PROJ() + (size_t)(m - 3 + j) * NPROJ + OFF_QKV + ch), v);
                    else if (sb >= 0) { const float* sp = P.sconv() + ((size_t)sb * 3 + (3 + tt)) * GQ + ch; const f32x4 a = *(const f32x4*)sp, b = *(const f32x4*)(sp + 4); v[0] = a.x; v[1] = a.y; v[2] = a.z; v[3] = a.w; v[4] = b.x; v[5] = b.y; v[6] = b.z; v[7] = b.w; }
                    else {
#pragma unroll
                        for (int i = 0; i < 8; ++i) v[i] = 0.f; }
                    const f32x4 c0 = *(const f32x4*)(P.conv_w() + (size_t)j * GQ + ch), c1 = *(const f32x4*)(P.conv_w() + (size_t)j * GQ + ch + 4);
#pragma unroll
                    for (int i = 0; i < 8; ++i) acc[i] += v[i] * (i < 4 ? c0[i] : c1[i - 4]);
                }
                float s = 0.f;
#pragma unroll
                for (int i = 0; i < 8; ++i) { acc[i] = acc[i] * fsig(acc[i]); s += acc[i] * acc[i]; }
                if (part < 2) { s += __shfl_xor(s, 1); s += __shfl_xor(s, 2); s += __shfl_xor(s, 4); s += __shfl_xor(s, 8);
                    const float sc = (1.0f / sqrtf(s + 1e-6f)) * (part == 0 ? 0.08838834764831845f : 1.0f);
#pragma unroll
                    for (int i = 0; i < 8; ++i) acc[i] *= sc; }
                *(GAS v4u*)(P.GQKV() + (size_t)m * GQ + ch) = pack8(acc);
            }
            if (lane < 8) { const int h = lane & 3; const float raw = P.BA()[(size_t)m * 8 + lane];
                float r;
                if (lane < 4) r = fsig(raw); else r = __expf(-__expf(P.a_log()[h]) * fsoftplus(raw + P.dt_bias()[h]));
                P.BG()[(size_t)m * 8 + lane] = r; }
        }
    }
}
__device__ __forceinline__ void rwkv_naive(const Ptrs& P, LAS unsigned char* lds, int row0, int L, int sb, int h, float* out_state, int tid) {
    LAS float* Lr = (LAS float*)lds; LAS float* Lw = Lr + 4096; LAS float* Lk = Lw + 4096; LAS float* Lv = Lk + 4096; LAS float* Lp = Lv + 4096; LAS float* Lb = Lp + 4096;
    const int v = tid >> 3, kq = tid & 7;
    float S[8];
#pragma unroll
    for (int i = 0; i < 8; ++i) S[i] = sb >= 0 ? P.swkv()[(((size_t)sb * 8 + h) * 64 + v) * 64 + 8 * kq + i] : 0.f;
    const int c0 = h * 64 + 8 * kq;
    f32x4 kk0 = *(const f32x4*)(P.k_k() + c0), kk1 = *(const f32x4*)(P.k_k() + c0 + 4), ka0 = *(const f32x4*)(P.k_a() + c0), ka1 = *(const f32x4*)(P.k_a() + c0 + 4);
    for (int tile0 = 0; tile0 < L; tile0 += 64) {
        const int nt = (L - tile0) < 64 ? (L - tile0) : 64;
        {   const int tok = tid >> 3;
            if (tok < nt) { const int m = row0 + tile0 + tok; int t, sb2; row_info(m, t, sb2);
                float r[8], k[8], vv[8], a[8], x[8];
                load_fm8(P, m, t, sb2, c0, r); load_fm8(P, m, t, sb2, 512 + c0, k); load_fm8(P, m, t, sb2, 1024 + c0, vv);
                unpack8(*(const GAS v4u*)(P.AA() + (size_t)m * 512 + c0), a); unpack8(*(const GAS v4u*)(P.XA() + (size_t)m * 512 + c0), x);
                const float rn = P.RN()[(size_t)m * 8 + h];
#pragma unroll
                for (int i = 0; i < 8; ++i) { const float kki = i < 4 ? kk0[i] : kk1[i - 4], kai = i < 4 ? ka0[i] : ka1[i - 4];
                    const float kap = k[i] * kki * rn; const int o = tok * 64 + 8 * kq + i;
                    Lr[o] = r[i]; Lw[o] = __expf(-x[i]); Lk[o] = k[i] * (1.f + (a[i] - 1.f) * kai); Lv[o] = vv[i]; Lp[o] = kap; Lb[o] = kap * a[i]; }
            }
        }
        __syncthreads();
        for (int tt = 0; tt < nt; ++tt) {
            const int o = tt * 64 + 8 * kq; float r[8], w[8], k[8], p[8], b[8];
#pragma unroll
            for (int q = 0; q < 2; ++q) { const f32x4 a0 = *(const LAS f32x4*)(Lr + o + 4 * q), a1 = *(const LAS f32x4*)(Lw + o + 4 * q), a2 = *(const LAS f32x4*)(Lk + o + 4 * q), a3 = *(const LAS f32x4*)(Lp + o + 4 * q), a4 = *(const LAS f32x4*)(Lb + o + 4 * q);
#pragma unroll
                for (int i = 0; i < 4; ++i) { r[4 * q + i] = a0[i]; w[4 * q + i] = a1[i]; k[4 * q + i] = a2[i]; p[4 * q + i] = a3[i]; b[4 * q + i] = a4[i]; } }
            const float vv = Lv[tt * 64 + v];
            float sa = 0.f;
#pragma unroll
            for (int i = 0; i < 8; ++i) sa += S[i] * p[i];
            sa += __shfl_xor(sa, 1); sa += __shfl_xor(sa, 2); sa += __shfl_xor(sa, 4);
            float y = 0.f;
#pragma unroll
            for (int i = 0; i < 8; ++i) { S[i] = S[i] * w[i] - sa * b[i] + vv * k[i]; y += S[i] * r[i]; }
            y += __shfl_xor(y, 1); y += __shfl_xor(y, 2); y += __shfl_xor(y, 4);
            if (kq == 0) P.YBF()[(size_t)(row0 + tile0 + tt) * 512 + h * 64 + v] = (bf16)f2bf(y);
        }
        __syncthreads();
    }
#pragma unroll
    for (int i = 0; i < 8; ++i) out_state[(size_t)v * 64 + 8 * kq + i] = S[i];
}
__device__ __forceinline__ void gdn_naive(const Ptrs& P, LAS unsigned char* lds, int row0, int L, int sb, int h, float* out_state, int tid) {
    LAS float* Lq = (LAS float*)lds; LAS float* Lk = Lq + 8192; LAS float* Lv = Lk + 8192; LAS float* Lbg = Lv + 8192;
    const int e = tid >> 2, dq = tid & 3;
    float S[32];
#pragma unroll
    for (int i = 0; i < 32; ++i) S[i] = sb >= 0 ? P.sgdn()[(((size_t)sb * 4 + h) * 128 + 32 * dq + i) * 128 + e] : 0.f;
    for (int tile0 = 0; tile0 < L; tile0 += 64) {
        const int nt = (L - tile0) < 64 ? (L - tile0) : 64;
        {   const int tok = tid >> 3, pc = tid & 7;
            if (tok < nt) { const int m = row0 + tile0 + tok;
#pragma unroll
                for (int part = 0; part < 3; ++part) { LAS float* dst = (part == 0 ? Lq : (part == 1 ? Lk : Lv)) + tok * 128 + 16 * pc;
#pragma unroll
                    for (int q = 0; q < 2; ++q) { float f[8]; unpack8(*(const GAS v4u*)(P.GQKV() + (size_t)m * GQ + part * 512 + h * 128 + 16 * pc + 8 * q), f);
#pragma unroll
                        for (int i = 0; i < 8; ++i) dst[8 * q + i] = f[i]; } }
                if (pc == 0) { Lbg[2 * tok] = P.BG()[(size_t)m * 8 + h]; Lbg[2 * tok + 1] = P.BG()[(size_t)m * 8 + 4 + h]; }
            }
        }
        __syncthreads();
        for (int tt = 0; tt < nt; ++tt) {
            const float bt = Lbg[2 * tt], g = Lbg[2 * tt + 1];
            float k[32]; float kv = 0.f;
#pragma unroll
            for (int q = 0; q < 8; ++q) { const f32x4 a = *(const LAS f32x4*)(Lk + tt * 128 + 32 * dq + 4 * q);
#pragma unroll
                for (int i = 0; i < 4; ++i) { k[4 * q + i] = a[i]; S[4 * q + i] *= g; kv += a[i] * S[4 * q + i]; } }
            kv += __shfl_xor(kv, 1); kv += __shfl_xor(kv, 2);
            const float vn = bt * (Lv[tt * 128 + e] - kv);
            float o = 0.f;
#pragma unroll
            for (int q = 0; q < 8; ++q) { const f32x4 a = *(const LAS f32x4*)(Lq + tt * 128 + 32 * dq + 4 * q);
#pragma unroll
                for (int i = 0; i < 4; ++i) { S[4 * q + i] += k[4 * q + i] * vn; o += a[i] * S[4 * q + i]; } }
            o += __shfl_xor(o, 1); o += __shfl_xor(o, 2);
            if (dq == 0) P.OBF()[(size_t)(row0 + tile0 + tt) * 512 + h * 128 + e] = (bf16)f2bf(o);
        }
        __syncthreads();
    }
#pragma unroll
    for (int i = 0; i < 32; ++i) out_state[(size_t)(32 * dq + i) * 128 + e] = S[i];
}
__device__ __forceinline__ void p3_naive_scans(const Ptrs& P, LAS unsigned char* lds, int job, int tid) {
    if (job < 32) { const int b = job >> 3, h = job & 7; rwkv_naive(P, lds, b * SEQL, SEQL, -1, h, P.out() + O_WKV_P + ((size_t)b * 8 + h) * 4096, tid); }
    else if (job < 48) { const int j = job - 32, b = j >> 2, h = j & 3; gdn_naive(P, lds, b * SEQL, SEQL, -1, h, P.out() + O_GDN_P + ((size_t)b * 4 + h) * 16384, tid); }
    else if (job < 176) { const int j = job - 48, sb = j >> 3, h = j & 7; rwkv_naive(P, lds, MP + sb * SSL, SSL, sb, h, P.out() + O_WKV_S + ((size_t)sb * 8 + h) * 4096, tid); }
    else if (job < 240) { const int j = job - 176, sb = j >> 2, h = j & 3; gdn_naive(P, lds, MP + sb * SSL, SSL, sb, h, P.out() + O_GDN_S + ((size_t)sb * 4 + h) * 16384, tid); }
}
__device__ __forceinline__ void p4_post(const Ptrs& P, int gw, int NGW, int lane) {
    for (int m = gw; m < MROWS; m += NGW) {
        int t, sb; row_info(m, t, sb);
        {
            const int c0 = 8 * lane; float y[8], r[8], k[8], v[8], a[8], g[8];
            unpack8(*(const GAS v4u*)(P.YBF() + (size_t)m * 512 + c0), y);
            load_fm8(P, m, t, sb, c0, r); load_fm8(P, m, t, sb, 512 + c0, k); load_fm8(P, m, t, sb, 1024 + c0, v);
            unpack8(*(const GAS v4u*)(P.AA() + (size_t)m * 512 + c0), a); unpack8(*(const GAS v4u*)(P.GA() + (size_t)m * 512 + c0), g);
            float s = 0.f, rk = 0.f;
#pragma unroll
            for (int i = 0; i < 8; ++i) { s += y[i]; rk += r[i] * k[i] * (1.f + (a[i] - 1.f) * P.k_a()[c0 + i]) * P.r_k()[c0 + i]; }
            s += __shfl_xor(s, 1); s += __shfl_xor(s, 2); s += __shfl_xor(s, 4); rk += __shfl_xor(rk, 1); rk += __shfl_xor(rk, 2); rk += __shfl_xor(rk, 4);
            const float mean = s * (1.f / 64.f); float q = 0.f;
#pragma unroll
            for (int i = 0; i < 8; ++i) { y[i] -= mean; q += y[i] * y[i]; }
            q += __shfl_xor(q, 1); q += __shfl_xor(q, 2); q += __shfl_xor(q, 4);
            const float rstd = 1.0f / sqrtf(q * (1.f / 64.f) + GN_EPS); float o[8];
#pragma unroll
            for (int i = 0; i < 8; ++i) o[i] = (y[i] * rstd * P.lnx_w()[c0 + i] + P.lnx_b()[c0 + i] + rk * v[i]) * g[i];
            *(GAS v4u*)(P.XN() + (size_t)m * DM + c0) = pack8(o);
        }
        {
            const int c0 = 8 * lane; float o[8], z[8];
            unpack8(*(const GAS v4u*)(P.OBF() + (size_t)m * 512 + c0), o); unpack8(*(const GAS v4u*)(P.PROJ() + (size_t)m * NPROJ + OFF_Z + c0), z);
            float s = 0.f;
#pragma unroll
            for (int i = 0; i < 8; ++i) s += o[i] * o[i];
            s += __shfl_xor(s, 1); s += __shfl_xor(s, 2); s += __shfl_xor(s, 4); s += __shfl_xor(s, 8);
            const float rstd = 1.0f / sqrtf(s * (1.f / 128.f) + RMS_EPS);
#pragma unroll
            for (int i = 0; i < 8; ++i) o[i] = o[i] * rstd * P.gdn_g()[(c0 & 127) + i] * (z[i] * fsig(z[i]));
            *(GAS v4u*)(P.XN() + (size_t)m * DM + 512 + c0) = pack8(o);
        }
        {
            const float* pr = m < MP ? P.pp_() + (size_t)m * DPLE : P.ps_() + (size_t)(m - MP) * DPLE; const f32x4 pv = *(const f32x4*)(pr + 4 * lane);
            *(GAS unsigned long long*)(P.PB() + (size_t)m * DPLE + 4 * lane) = (unsigned long long)pk2(pv.x, pv.y) | ((unsigned long long)pk2(pv.z, pv.w) << 32);
        }
        const int L = sb >= 0 ? SSL : SEQL;
        if (t == L - 1) {
            float* dst = sb >= 0 ? P.out() + O_SHIFT_S + (size_t)sb * RPROJ : P.out() + O_SHIFT_P + (size_t)(m >> 13) * RPROJ;
            for (int c = lane; c < RPROJ; c += 64) dst[c] = __uint_as_float((unsigned)P.PROJ()[(size_t)m * NPROJ + c] << 16);
        }
        if (t >= L - 3) {
            float* dst = (sb >= 0 ? P.out() + O_CONV_S + (size_t)sb * 3 * GQ : P.out() + O_CONV_P + (size_t)(m >> 13) * 3 * GQ) + (size_t)(t - (L - 3)) * GQ;
            for (int c = lane; c < GQ; c += 64) dst[c] = __uint_as_float((unsigned)P.PROJ()[(size_t)m * NPROJ + OFF_QKV + c] << 16);
        }
    }
}
__device__ __forceinline__ void p_final_norm(const Ptrs& P, int gw, int NGW, int lane) {
    f32x4 gv[4];
#pragma unroll
    for (int j = 0; j < 4; ++j) gv[j] = *(const f32x4*)(P.fin_g() + 4 * lane + 256 * j);
    for (int m = gw; m < MROWS; m += NGW) {
        GAS f32x4* x4 = (GAS f32x4*)(P.out() + (size_t)m * DM) + lane; f32x4 v[4]; float ss = 0.f;
#pragma unroll
        for (int j = 0; j < 4; ++j) { v[j] = x4[64 * j]; ss += (v[j].x * v[j].x + v[j].y * v[j].y) + (v[j].z * v[j].z + v[j].w * v[j].w); }
        const float rstd = 1.0f / sqrtf(wave_sum(ss) * (1.f / DM) + RMS_EPS);
#pragma unroll
        for (int j = 0; j < 4; ++j) x4[64 * j] = v[j] * rstd * gv[j];
    }
}
#ifndef MK_N_LAUNCHES
#define MK_N_LAUNCHES 1
#endif
constexpr int PER_PHASE = 12;
constexpr int N_LAUNCHES = MK_N_LAUNCHES;
__global__ void __launch_bounds__(NWAVES * 64, 2) hybrid_fwd(Args args) {
    extern __shared__ __attribute__((aligned(16))) unsigned char lds_raw[];
    LAS unsigned char* lds = (LAS unsigned char*)lds_raw;
    volatile LAS unsigned* MISC = (volatile LAS unsigned*)(lds + MISC_OFF);
    const int tid = threadIdx.x, lane = tid & 63, wave = __builtin_amdgcn_readfirstlane(tid >> 6);
    const int G = gridDim.x; const int bx = blockIdx.x; const int vcu = (G % 8 == 0) ? (bx % 8) * (G / 8) + bx / 8 : bx;
    const int gw = vcu * NWAVES + wave, NGW = G * NWAVES;
    gu32* ctl = (gu32*)(args.ws + WS_CTL);
    for (int u = tid; u < (LDS_BYTES - LDSCTL_OFF) / 4; u += NWAVES * 64) ((LAS unsigned*)(lds + LDSCTL_OFF))[u] = 0u;
    __syncthreads();
    XcdBarrier bar; bar.bar = (unsigned*)(ctl + CW_BAR); bar.x = 0; bar.st = nullptr;
    if (N_LAUNCHES != PER_PHASE) bar = xcd_barrier_post((unsigned*)(ctl + CW_BAR), MISC + 8);
#define GRID_BAR() do { if (N_LAUNCHES != PER_PHASE) xcd_barrier(bar); } while (0)
    const int lo = args.ph_lo, hi = args.ph_hi;
#ifndef PHASE_MASK
#define PHASE_MASK 0xFFF
#endif
#define IN(k) (((PHASE_MASK >> (k)) & 1) && lo <= (k) && (k) < hi)
#define BOTH(k) (IN(k) && IN((k) + 1))
#define PHASE_PTRS() const __attribute__((address_space(4))) Args* ap_ = (const __attribute__((address_space(4))) Args*)__builtin_amdgcn_kernarg_segment_ptr(); asm volatile("" : "+s"(ap_)); const Ptrs P{ap_}
    if (IN(0)) { PHASE_PTRS(); p0_prologue(P, lds, gw, NGW, wave, lane); if (BOTH(0)) GRID_BAR(); }
    if (IN(1)) { PHASE_PTRS(); pg8::Gemm g{P.XN(), P.Win_t(), MROWS, NPROJ, DM}; pg8::StaticOrder S; S.init(MROWS, NPROJ, G, bx); pg8::EpiBf16P E{P.PROJ(), NPROJ};
        pg8::gemm_phase<pg8::EpiBf16P, pg8::StaticOrder, true, true>(lds + RING_OFF, g, S, E); if (BOTH(1)) GRID_BAR(); }
    if (IN(2)) { PHASE_PTRS(); p2_token_prep(P, gw, NGW, lane); if (BOTH(2)) GRID_BAR(); }
    if (IN(3)) { PHASE_PTRS(); pg8::Gemm g{P.LIN(), P.Wlora_t(), MROWS, NLORA, KLORA}; pg8::StaticOrder S; S.init(MROWS, NLORA, G, bx); pg8::EpiLora E{P.XA(), (WS_AA - WS_XA) / 2, P.w0(), P.a0()}; static_assert(WS_GA - WS_AA == WS_AA - WS_XA, "x|a|g spacing");
        pg8::gemm_phase<pg8::EpiLora, pg8::StaticOrder, true, true>(lds + RING_OFF, g, S, E); if (BOTH(3)) GRID_BAR(); }
    if (IN(4)) { PHASE_PTRS(); p3_naive_scans(P, lds, vcu, tid); if (BOTH(4)) GRID_BAR(); }
    if (IN(5)) { PHASE_PTRS(); p4_post(P, gw, NGW, lane); if (BOTH(5)) GRID_BAR(); }
    if (IN(6)) { PHASE_PTRS(); pg8::Gemm g{P.XN(), P.Wout_t(), MROWS, DM, DM}; pg8::StaticOrder S; S.init(MROWS, DM, G, bx); pg8::EpiRes E{P.xp(), P.xs(), P.out(), P.PROJ(), P.SSQ2(), MP};
        pg8::gemm_phase<pg8::EpiRes, pg8::StaticOrder, true, true>(lds + RING_OFF, g, S, E); if (BOTH(6)) GRID_BAR(); }
    if (IN(7)) { PHASE_PTRS(); pg8::Gemm g{P.PROJ(), P.Wgu_t(), MROWS, NGU, DM}; pg8::StaticOrder S; S.init(MROWS, NGU, G, bx); pg8::EpiSwiGLU E{P.ACT(), P.SSQ2()};
        pg8::gemm_phase<pg8::EpiSwiGLU, pg8::StaticOrder, true, true>(lds + RING_OFF, g, S, E); if (BOTH(7)) GRID_BAR(); }
    if (IN(8)) { PHASE_PTRS(); pg8::Gemm g{P.ACT(), P.Wdown_t(), MROWS, DM, DFF}; pg8::StaticOrder S; S.init(MROWS, DM, G, bx); pg8::EpiRes E{P.out(), P.out() + (size_t)MP * DM, P.out(), P.XN(), P.SSQ3(), MP};
        pg8::gemm_phase<pg8::EpiRes, pg8::StaticOrder, true, true>(lds + RING_OFF, g, S, E); if (BOTH(8)) GRID_BAR(); }
    if (IN(9)) { PHASE_PTRS(); pg8::Gemm g{P.PB(), P.Wpp_t(), MROWS, DM, DPLE}; pg8::StaticOrder S; S.init(MROWS, DM, G, bx); pg8::EpiBf16P E{P.ACT(), DM};
        pg8::gemm_phase<pg8::EpiBf16P, pg8::StaticOrder, true, true>(lds + RING_OFF, g, S, E); if (BOTH(9)) GRID_BAR(); }
    if (IN(10)) { PHASE_PTRS(); pg8::Gemm g{P.XN(), P.Wpg_t(), MROWS, DM, DM}; pg8::StaticOrder S; S.init(MROWS, DM, G, bx); pg8::EpiPle E{P.out(), P.ACT(), P.SSQ3()};
        pg8::gemm_phase<pg8::EpiPle, pg8::StaticOrder, true, true>(lds + RING_OFF, g, S, E); if (BOTH(10)) GRID_BAR(); }
    if (IN(11)) { PHASE_PTRS(); p_final_norm(P, gw, NGW, lane); }
#undef IN
#undef BOTH
}

extern "C" void kernel_launch(void* const* d_in, const int* in_sizes, int n_in, void* d_out, int out_size, void* d_ws, size_t ws_size, hipStream_t stream) {
    static int grid = 0;
    if (grid == 0) {
        if (n_in != 34 || in_sizes[0] != MP * DM || (size_t)out_size != O_END || ws_size < WS_END) { fprintf(stderr, "kernel_launch: unexpected shapes: n_in %d in0 %d out %d ws %zu (need %zu)\n", n_in, n_in > 0 ? in_sizes[0] : -1, out_size, ws_size, (size_t)WS_END); grid = -1; return; }
        int dev = 0, cus = 0, per_cu = 0;
        if (hipGetDevice(&dev) != hipSuccess || hipDeviceGetAttribute(&cus, hipDeviceAttributeMultiprocessorCount, dev) != hipSuccess) { grid = -1; return; }
        if (hipFuncSetAttribute((const void*)hybrid_fwd, hipFuncAttributeMaxDynamicSharedMemorySize, LDS_BYTES) != hipSuccess) { fprintf(stderr, "kernel_launch: hipFuncSetAttribute failed\n"); grid = -1; return; }
        if (hipOccupancyMaxActiveBlocksPerMultiprocessor(&per_cu, (const void*)hybrid_fwd, NWAVES * 64, LDS_BYTES) != hipSuccess || per_cu < 1) fprintf(stderr, "kernel_launch: occupancy query reports %d\n", per_cu);
        (void)hipGetLastError();
        grid = cus;
    }
    if (grid < 0) return;
    if (hipMemsetAsync((char*)d_ws + WS_CTL, 0, CTL_ZERO_BYTES, stream) != hipSuccess) { fprintf(stderr, "kernel_launch: memset failed\n"); return; }
    Args a{};
    for (int i = 0; i < 34; ++i) a.in[i] = (const float*)d_in[i];
    a.out = (float*)d_out; a.ws = (unsigned char*)d_ws;
    for (int li = 0; li < N_LAUNCHES; ++li) {
        a.ph_lo = (N_LAUNCHES == PER_PHASE) ? li : 0; a.ph_hi = (N_LAUNCHES == PER_PHASE) ? li + 1 : PER_PHASE;
        hipLaunchKernelGGL(hybrid_fwd, dim3(grid), dim3(NWAVES * 64), LDS_BYTES, stream, a);
        const hipError_t le = hipPeekAtLastError();
        if (le != hipSuccess) { fprintf(stderr, "kernel_launch: launch %d failed: %s\n", li, hipGetErrorName(le)); break; }
    }
}
```

```cpp
#include <hip/hip_runtime.h>
#include <cstdio>
#include <cstdint>
namespace pg8 {
#define PG8_LAS __attribute__((address_space(3)))
typedef unsigned short bf16_t;
typedef short bf16x8 __attribute__((ext_vector_type(8)));
typedef float f32x4 __attribute__((ext_vector_type(4)));
typedef unsigned u32x4 __attribute__((ext_vector_type(4)));
constexpr int BM = 256, BK = 64, HALF = 128, HTB = HALF * BK * 2  , STAGE_BYTES = 8 * HTB, NXCD = 8, WGM = 8;

__host__ __device__ __forceinline__ int lds_byte(int r, int c) { const int st = (r >> 4) * 2 + (c >> 5), rr = r & 15, cc = c & 31, ob = rr * 64 + cc * 2; return st * 1024 + (ob ^ (((ob >> 9) & 1) << 5)); }
__host__ __device__ __forceinline__ void stage_rc(int b, int& R, int& C) { const int st = b / 1024, sb = b % 1024, swz = sb ^ (((sb >> 9) & 1) << 5); R = (st >> 1) * 16 + swz / 64; C = (st & 1) * 32 + (swz % 64) / 2; }
__host__ __device__ __forceinline__ int perm32(int rho) { const int n = rho >> 4, i = rho & 15; return 8 * (i >> 2) + 4 * n + (i & 3); }

struct Unit { int pm, pn; };
struct Gemm { const bf16_t* A; const bf16_t* Bt; int M, N, K; };

struct StaticOrder {
    int nM, nN, nwg, G, c;
    __host__ __device__ void init(int M, int N, int G_, int c_) { nM = M / BM; nN = N / BM; nwg = nM * nN; G = G_; c = c_; }
    __host__ __device__ bool next(int i, Unit& u) const {
        const long L = (long)i * G + c; if (L >= nwg) return false;
        int wgid = (int)L; { const int q = nwg / NXCD, r = nwg % NXCD, xcd = wgid % NXCD, off = wgid / NXCD; wgid = (xcd < r ? xcd * (q + 1) : r * (q + 1) + (xcd - r) * q) + off; }
        const int nig = WGM * nN, gid = wgid / nig, fm = gid * WGM, gsz = (nM - fm) < WGM ? (nM - fm) : WGM;
        u.pm = fm + ((wgid % nig) % gsz); u.pn = (wgid % nig) / gsz; return true;
    }
    __device__ __forceinline__ void a_ready(const Unit&) const {}
    __device__ __forceinline__ void done(const Unit&) const {}
};

__device__ __forceinline__ unsigned cvt_pk_bf16(float lo, float hi) { unsigned r; asm volatile("v_cvt_pk_bf16_f32 %0, %1, %2" : "=v"(r) : "v"(lo), "v"(hi)); return r; }
typedef float f32x2 __attribute__((ext_vector_type(2)));
__device__ __forceinline__ float fsigmoid(float x) { return __builtin_amdgcn_rcpf(1.f + __builtin_amdgcn_exp2f(-1.44269504f * x)); }
struct EpiBf16P {
    static constexpr bool PERM = true, AFTER_DRAIN = false;
    bf16_t* O; int ldc;
    __device__ __forceinline__ void operator()(const f32x4 (&acc)[2][2][4][2], const Unit& u, int wr, int wc, int fr, int fq) const {
        const int row0 = u.pm * BM + wr * 64 + fr, col0 = u.pn * BM + wc * 32 + 8 * fq;
#pragma unroll
        for (int ai = 0; ai < 2; ++ai)
#pragma unroll
            for (int m = 0; m < 4; ++m) { bf16_t* rowp = O + (size_t)(row0 + ai * HALF + m * 16) * ldc + col0;
#pragma unroll
                for (int bj = 0; bj < 2; ++bj) { const f32x4 v0 = acc[ai][bj][m][0], v1 = acc[ai][bj][m][1];
                    u32x4 w; w.x = cvt_pk_bf16(v0[0], v0[1]); w.y = cvt_pk_bf16(v0[2], v0[3]); w.z = cvt_pk_bf16(v1[0], v1[1]); w.w = cvt_pk_bf16(v1[2], v1[3]);
                    *(u32x4*)(rowp + bj * HALF) = w; } }
    }
};
struct EpiRes {
    static constexpr bool PERM = true, AFTER_DRAIN = false;
    const float* base_p; const float* base_s; float* out; bf16_t* ob; float* ssq; int msplit;
    __device__ __forceinline__ void operator()(const f32x4 (&acc)[2][2][4][2], const Unit& u, int wr, int wc, int fr, int fq) const {
        const int row0 = u.pm * BM + wr * 64 + fr, col0 = u.pn * BM + wc * 32 + 8 * fq;
#pragma unroll
        for (int ai = 0; ai < 2; ++ai)
#pragma unroll
            for (int m = 0; m < 4; ++m) { const int r = row0 + ai * HALF + m * 16;
                const float* bp = (r < msplit ? base_p + (size_t)r * 1024 : base_s + (size_t)(r - msplit) * 1024) + col0;
                float* op = out + (size_t)r * 1024 + col0; bf16_t* obp = ob + (size_t)r * 1024 + col0; float s = 0.f;
#pragma unroll
                for (int bj = 0; bj < 2; ++bj) { const f32x4 b0 = *(const f32x4*)(bp + bj * HALF), b1 = *(const f32x4*)(bp + bj * HALF + 4);
                    const f32x4 v0 = acc[ai][bj][m][0] + b0, v1 = acc[ai][bj][m][1] + b1;
                    *(f32x4*)(op + bj * HALF) = v0; *(f32x4*)(op + bj * HALF + 4) = v1;
                    u32x4 w; w.x = cvt_pk_bf16(v0[0], v0[1]); w.y = cvt_pk_bf16(v0[2], v0[3]); w.z = cvt_pk_bf16(v1[0], v1[1]); w.w = cvt_pk_bf16(v1[2], v1[3]);
                    *(u32x4*)(obp + bj * HALF) = w;
                    s += (v0[0] * v0[0] + v0[1] * v0[1]) + (v0[2] * v0[2] + v0[3] * v0[3]) + (v1[0] * v1[0] + v1[1] * v1[1]) + (v1[2] * v1[2] + v1[3] * v1[3]); }
                s += __shfl_xor(s, 16); s += __shfl_xor(s, 32);
                if (fq == 0) ssq[(size_t)r * 16 + u.pn * 4 + wc] = s; }
    }
};
__device__ __forceinline__ float row_rstd16(const float* ssq, int r, int fq) {
    const f32x4 p = *(const f32x4*)(ssq + (size_t)r * 16 + 4 * fq); float s = (p[0] + p[1]) + (p[2] + p[3]);
    s += __shfl_xor(s, 16); s += __shfl_xor(s, 32); return __builtin_amdgcn_rsqf(s * (1.0f / 1024.0f) + 1e-6f);
}
struct EpiSwiGLU {
    static constexpr bool PERM = false, AFTER_DRAIN = false;
    bf16_t* O; const float* ssq;
    __device__ __forceinline__ void operator()(const f32x4 (&acc)[2][2][4][2], const Unit& u, int wr, int wc, int fr, int fq) const {
        const int row0 = u.pm * BM + wr * 64 + fr, col0 = u.pn * 128 + wc * 32 + 8 * fq;
#pragma unroll
        for (int ai = 0; ai < 2; ++ai)
#pragma unroll
            for (int m = 0; m < 4; ++m) { const int r = row0 + ai * HALF + m * 16; const float rs = row_rstd16(ssq, r, fq);
                float o[8];
#pragma unroll
                for (int bj = 0; bj < 2; ++bj)
#pragma unroll
                    for (int j = 0; j < 4; ++j) { const float g = acc[ai][bj][m][0][j] * rs, up = acc[ai][bj][m][1][j] * rs; o[4 * bj + j] = g * fsigmoid(g) * up; }
                u32x4 w; w.x = cvt_pk_bf16(o[0], o[1]); w.y = cvt_pk_bf16(o[2], o[3]); w.z = cvt_pk_bf16(o[4], o[5]); w.w = cvt_pk_bf16(o[6], o[7]);
                *(u32x4*)(O + (size_t)r * 2816 + col0) = w; }
    }
};
struct EpiPle {
    static constexpr bool PERM = true, AFTER_DRAIN = false;
    float* io; const bf16_t* pp; const float* ssq;
    __device__ __forceinline__ void operator()(const f32x4 (&acc)[2][2][4][2], const Unit& u, int wr, int wc, int fr, int fq) const {
        const int row0 = u.pm * BM + wr * 64 + fr, col0 = u.pn * BM + wc * 32 + 8 * fq;
#pragma unroll
        for (int ai = 0; ai < 2; ++ai)
#pragma unroll
            for (int m = 0; m < 4; ++m) { const int r = row0 + ai * HALF + m * 16; const float rs = row_rstd16(ssq, r, fq);
                float* op = io + (size_t)r * 1024 + col0; const bf16_t* ppp = pp + (size_t)r * 1024 + col0;
#pragma unroll
                for (int bj = 0; bj < 2; ++bj) { const f32x4 b0 = *(const f32x4*)(op + bj * HALF), b1 = *(const f32x4*)(op + bj * HALF + 4); const u32x4 pw = *(const u32x4*)(ppp + bj * HALF);
                    f32x4 v0, v1;
                    v0[0] = b0[0] + fsigmoid(acc[ai][bj][m][0][0] * rs) * __uint_as_float(pw.x << 16); v0[1] = b0[1] + fsigmoid(acc[ai][bj][m][0][1] * rs) * __uint_as_float(pw.x & 0xffff0000u);
                    v0[2] = b0[2] + fsigmoid(acc[ai][bj][m][0][2] * rs) * __uint_as_float(pw.y << 16); v0[3] = b0[3] + fsigmoid(acc[ai][bj][m][0][3] * rs) * __uint_as_float(pw.y & 0xffff0000u);
                    v1[0] = b1[0] + fsigmoid(acc[ai][bj][m][1][0] * rs) * __uint_as_float(pw.z << 16); v1[1] = b1[1] + fsigmoid(acc[ai][bj][m][1][1] * rs) * __uint_as_float(pw.z & 0xffff0000u);
                    v1[2] = b1[2] + fsigmoid(acc[ai][bj][m][1][2] * rs) * __uint_as_float(pw.w << 16); v1[3] = b1[3] + fsigmoid(acc[ai][bj][m][1][3] * rs) * __uint_as_float(pw.w & 0xffff0000u);
                    *(f32x4*)(op + bj * HALF) = v0; *(f32x4*)(op + bj * HALF + 4) = v1; } }
    }
};
struct EpiLora {
    static constexpr bool PERM = true, AFTER_DRAIN = false;
    bf16_t* XA; size_t part_stride; const float* w0; const float* a0;
    __device__ __forceinline__ void operator()(const f32x4 (&acc)[2][2][4][2], const Unit& u, int wr, int wc, int fr, int fq) const {
        const int row0 = u.pm * BM + wr * 64 + fr; const int part = u.pn >> 1; const int col0 = (u.pn & 1) * BM + wc * 32 + 8 * fq;
        bf16_t* O = XA + (size_t)part * part_stride; const float* bias = part == 0 ? w0 : a0;
        f32x4 bv[2][2];
#pragma unroll
        for (int bj = 0; bj < 2; ++bj)
#pragma unroll
            for (int n = 0; n < 2; ++n) bv[bj][n] = part < 2 ? *(const f32x4*)(bias + col0 + bj * HALF + 4 * n) : (f32x4){0.f, 0.f, 0.f, 0.f};
#pragma unroll
        for (int ai = 0; ai < 2; ++ai)
#pragma unroll
            for (int m = 0; m < 4; ++m) { bf16_t* rowp = O + (size_t)(row0 + ai * HALF + m * 16) * 512 + col0;
#pragma unroll
                for (int bj = 0; bj < 2; ++bj) { const f32x4 v0 = acc[ai][bj][m][0] + bv[bj][0], v1 = acc[ai][bj][m][1] + bv[bj][1];
                    float o[8] = {v0[0], v0[1], v0[2], v0[3], v1[0], v1[1], v1[2], v1[3]};
                    if (part == 0) {
#pragma unroll
                        for (int j = 0; j < 8; ++j) { const float z = -o[j]; const float sp = fmaxf(z, 0.f) + __logf(1.f + __expf(-fabsf(z))); o[j] = __expf(-sp - 0.5f); } }
                    else if (part == 1) {
#pragma unroll
                        for (int j = 0; j < 8; ++j) o[j] = fsigmoid(o[j]); }
                    u32x4 w; w.x = cvt_pk_bf16(o[0], o[1]); w.y = cvt_pk_bf16(o[2], o[3]); w.z = cvt_pk_bf16(o[4], o[5]); w.w = cvt_pk_bf16(o[6], o[7]);
                    *(u32x4*)(rowp + bj * HALF) = w; }
                __builtin_amdgcn_sched_barrier(0); }
    }
};

template <class Epi, class Sched, bool ALIGN_EPI = false, bool SP2 = false>
__device__ __forceinline__ void gemm_phase(PG8_LAS unsigned char* lds, const Gemm g, const Sched& S, const Epi& E) {
    const int tid = threadIdx.x, wid = __builtin_amdgcn_readfirstlane(tid >> 6), lane = tid & 63, wr = wid >> 2, wc = wid & 3, fr = lane & 15, fq = lane >> 4;
    int K_ = g.K; asm volatile("" : "+s"(K_)); const int K = K_, nt = K / BK;
    unsigned voffA[2], voffB[2];
#pragma unroll
    for (int i = 0; i < 2; ++i) { int R, C; stage_rc(tid * 16 + i * 8192, R, C); const int Rb = Epi::PERM ? ((R & ~31) + perm32(R & 31)) : R;
        voffA[i] = (unsigned)(R * K + C) * 2u; voffB[i] = (unsigned)(Rb * K + C) * 2u; }
    const size_t kstep = (size_t)(BK * 2);
    const size_t hstep = (size_t)HALF * K * 2;
    const size_t tstep = 2 * hstep;
    const unsigned ldsw = (unsigned)wid * 1024u;
    const int aoff = lds_byte(wr * 64 + fr, fq * 8), boff = lds_byte(wc * 32 + fr, fq * 8);
#define PG8_SA(b, h) (((b) * 2 + (h)) * HTB)
#define PG8_SB(b, h) ((4 + (b) * 2 + (h)) * HTB)
#define PG8_STAGE(bufoff, gbase, voff) do { _Pragma("unroll") for (int _i = 0; _i < 2; ++_i) \
        __builtin_amdgcn_global_load_lds((const unsigned*)((const char*)(gbase) + (voff)[_i]), (PG8_LAS unsigned*)(lds + (bufoff) + ldsw + _i * 8192), 16, 0, 0); } while (0)
#define PG8_LDA(dst, b, h) do { _Pragma("unroll") for (int m = 0; m < 4; ++m) _Pragma("unroll") for (int k = 0; k < 2; ++k) dst[m][k] = *(const PG8_LAS bf16x8*)(lds + PG8_SA(b, h) + aoff + m * 2048 + k * 1024); } while (0)
#define PG8_LDB(dst, b, h) do { _Pragma("unroll") for (int n = 0; n < 2; ++n) _Pragma("unroll") for (int k = 0; k < 2; ++k) dst[n][k] = *(const PG8_LAS bf16x8*)(lds + PG8_SB(b, h) + boff + n * 2048 + k * 1024); } while (0)
#define PG8_MMA(ai, bj, At, Bt) do { __builtin_amdgcn_s_setprio(1); _Pragma("unroll") for (int m = 0; m < 4; ++m) _Pragma("unroll") for (int n = 0; n < 2; ++n) _Pragma("unroll") for (int k = 0; k < 2; ++k) \
        acc[ai][bj][m][n] = __builtin_amdgcn_mfma_f32_16x16x32_bf16(Bt[n][k], At[m][k], acc[ai][bj][m][n], 0, 0, 0); __builtin_amdgcn_s_setprio(0); } while (0)
#define PG8_WAIT_V(n) asm volatile("s_waitcnt vmcnt(" #n ")" ::: "memory")
#define PG8_WAIT_L(n) asm volatile("s_waitcnt lgkmcnt(" #n ")" ::: "memory")
#define PG8_BAR __builtin_amdgcn_s_barrier()
#define PG8_SCHED __builtin_amdgcn_sched_barrier(0)
    Unit cur, nxt; int ui = 0;
    if (!S.next(0, cur)) return;
    f32x4 acc[2][2][4][2];
#pragma unroll
    for (int a = 0; a < 2; ++a)
#pragma unroll
        for (int b = 0; b < 2; ++b)
#pragma unroll
            for (int m = 0; m < 4; ++m)
#pragma unroll
                for (int n = 0; n < 2; ++n) acc[a][b][m][n] = (f32x4){0.f, 0.f, 0.f, 0.f};
    bf16x8 At[4][2], B0[2][2], B1[2][2];
    const char* cA = (const char*)g.A + (size_t)cur.pm * tstep; const char* cB = (const char*)g.Bt + (size_t)cur.pn * tstep;
    S.a_ready(cur);
    if constexpr (SP2) {
        PG8_STAGE(PG8_SB(0, 0), cB, voffB); PG8_STAGE(PG8_SB(0, 1), cB + hstep, voffB); PG8_STAGE(PG8_SA(0, 0), cA, voffA); PG8_STAGE(PG8_SA(0, 1), cA + hstep, voffA);
        if (wr == 1) PG8_BAR;
        PG8_WAIT_V(2); PG8_BAR;
        PG8_STAGE(PG8_SB(1, 0), cB + kstep, voffB); PG8_STAGE(PG8_SA(1, 0), cA + kstep, voffA); PG8_STAGE(PG8_SB(1, 1), cB + hstep + kstep, voffB);
        PG8_WAIT_V(6); PG8_BAR;
    } else {
        PG8_STAGE(PG8_SB(0, 0), cB, voffB); PG8_STAGE(PG8_SA(0, 0), cA, voffA); PG8_STAGE(PG8_SB(0, 1), cB + hstep, voffB); PG8_STAGE(PG8_SA(0, 1), cA + hstep, voffA);
        if (wr == 1) PG8_BAR;
        PG8_WAIT_V(4); PG8_BAR;
        PG8_STAGE(PG8_SB(1, 0), cB + kstep, voffB); PG8_STAGE(PG8_SA(1, 0), cA + kstep, voffA); PG8_STAGE(PG8_SB(1, 1), cB + hstep + kstep, voffB);
        PG8_WAIT_V(6); PG8_BAR;
    }
    for (;;) {
        const bool has_next = S.next(ui + 1, nxt);
        const char* nA = has_next ? (const char*)g.A + (size_t)nxt.pm * tstep : cA; const char* nB = has_next ? (const char*)g.Bt + (size_t)nxt.pn * tstep : cB;
        for (int t = 0; t < nt; t += 2) {
            const bool last = (t == nt - 2);
            const char* a1 = cA + (size_t)(t + 1) * kstep;
            const char* a2 = last ? nA : cA + (size_t)(t + 2) * kstep; const char* b2 = last ? nB : cB + (size_t)(t + 2) * kstep;
            const char* a3 = a2 + kstep; const char* b3 = b2 + kstep;
            if (last && has_next) S.a_ready(nxt);
            if constexpr (SP2) {
            PG8_LDB(B0, 0, 0); PG8_LDB(B1, 0, 1); PG8_SCHED; PG8_LDA(At, 0, 0); PG8_STAGE(PG8_SA(1, 1), a1 + hstep, voffA);
            PG8_WAIT_V(8); PG8_WAIT_L(0); PG8_BAR; PG8_MMA(0, 0, At, B0); PG8_MMA(0, 1, At, B1); PG8_BAR; PG8_SCHED;
            PG8_LDA(At, 0, 1); PG8_STAGE(PG8_SB(0, 0), b2, voffB); PG8_STAGE(PG8_SB(0, 1), b2 + hstep, voffB); PG8_STAGE(PG8_SA(0, 0), a2, voffA);
            PG8_WAIT_V(8); PG8_WAIT_L(0); PG8_BAR; PG8_MMA(1, 0, At, B0); PG8_MMA(1, 1, At, B1); PG8_BAR; PG8_SCHED;
            PG8_LDB(B0, 1, 0); PG8_LDB(B1, 1, 1); PG8_SCHED; PG8_LDA(At, 1, 0); PG8_STAGE(PG8_SA(0, 1), a2 + hstep, voffA);
            PG8_WAIT_V(8); PG8_WAIT_L(0); PG8_BAR; PG8_MMA(0, 0, At, B0); PG8_MMA(0, 1, At, B1); PG8_BAR; PG8_SCHED;
            PG8_LDA(At, 1, 1); PG8_STAGE(PG8_SB(1, 0), b3, voffB); PG8_STAGE(PG8_SB(1, 1), b3 + hstep, voffB); PG8_STAGE(PG8_SA(1, 0), a3, voffA);
            PG8_WAIT_V(8); PG8_WAIT_L(0); PG8_BAR; PG8_MMA(1, 0, At, B0); PG8_MMA(1, 1, At, B1); PG8_BAR; PG8_SCHED;
            } else {
            PG8_LDB(B0, 0, 0); PG8_SCHED; PG8_LDA(At, 0, 0); PG8_STAGE(PG8_SA(1, 1), a1 + hstep, voffA);
            PG8_WAIT_L(8); PG8_BAR; PG8_WAIT_L(0); PG8_MMA(0, 0, At, B0); PG8_BAR; PG8_SCHED;
            PG8_LDB(B1, 0, 1); PG8_STAGE(PG8_SB(0, 0), b2, voffB);
            PG8_BAR; PG8_WAIT_L(0); PG8_MMA(0, 1, At, B1); PG8_BAR;
            PG8_LDA(At, 0, 1); PG8_STAGE(PG8_SA(0, 0), a2, voffA);
            PG8_BAR; PG8_WAIT_L(0); PG8_MMA(1, 0, At, B0); PG8_BAR; PG8_SCHED;
            PG8_STAGE(PG8_SB(0, 1), b2 + hstep, voffB);
            PG8_WAIT_V(6); PG8_BAR; PG8_MMA(1, 1, At, B1); PG8_BAR;
            PG8_LDB(B0, 1, 0); PG8_SCHED; PG8_LDA(At, 1, 0); PG8_STAGE(PG8_SA(0, 1), a2 + hstep, voffA);
            PG8_WAIT_L(8); PG8_BAR; PG8_WAIT_L(0); PG8_MMA(0, 0, At, B0); PG8_BAR; PG8_SCHED;
            PG8_LDB(B1, 1, 1); PG8_STAGE(PG8_SB(1, 0), b3, voffB);
            PG8_BAR; PG8_WAIT_L(0); PG8_MMA(0, 1, At, B1); PG8_BAR;
            PG8_LDA(At, 1, 1); PG8_STAGE(PG8_SA(1, 0), a3, voffA);
            PG8_BAR; PG8_WAIT_L(0); PG8_MMA(1, 0, At, B0); PG8_BAR; PG8_SCHED;
            PG8_STAGE(PG8_SB(1, 1), b3 + hstep, voffB);
            PG8_WAIT_V(6); PG8_BAR; PG8_MMA(1, 1, At, B1); PG8_BAR;
            }
        }
        if constexpr (ALIGN_EPI) { if (wr == 0) PG8_BAR; }
        if constexpr (!Epi::AFTER_DRAIN) { E(acc, cur, wr, wc, fr, fq); S.done(cur); }
        if (!has_next) break;
#pragma unroll
        for (int a = 0; a < 2; ++a)
#pragma unroll
            for (int b = 0; b < 2; ++b)
#pragma unroll
                for (int m = 0; m < 4; ++m)
#pragma unroll
                    for (int n = 0; n < 2; ++n) acc[a][b][m][n] = (f32x4){0.f, 0.f, 0.f, 0.f};
        cur = nxt; cA = nA; cB = nB; ++ui;
        if constexpr (ALIGN_EPI) { if (wr == 1) PG8_BAR; }
    }
    PG8_WAIT_V(0);
    if constexpr (!ALIGN_EPI) { if (wr == 0) PG8_BAR; }
    PG8_BAR;
    if constexpr (Epi::AFTER_DRAIN) { E.fused(acc, cur, wr, wc, fr, fq, lds, wid, lane); S.done(cur); }
#undef PG8_SA
#undef PG8_SB
#undef PG8_STAGE
#undef PG8_LDA
#undef PG8_LDB
#undef PG8_MMA
#undef PG8_WAIT_V
#undef PG8_WAIT_L
#undef PG8_BAR
#undef PG8_SCHED
}
}
using bf16 = unsigned short;
constexpr int NWAVES = 8;
constexpr int DM = 1024, MP = 32768, MS = 256, MROWS = MP + MS, SEQL = 8192, SSL = 16;
constexpr int NPROJ = 3840, DIN = 3848, RPROJ = 1792, OFF_QKV = 1792, OFF_Z = 3328, DFF = 2816, NGU = 5632, DPLE = 256, NLORA = 1536, KLORA = 256;
constexpr int GQ = 1536;
constexpr float RMS_EPS = 1e-6f, GN_EPS = 64e-5f;
constexpr size_t O_Y = 0, O_SHIFT_P = (size_t)MROWS * DM, O_WKV_P = O_SHIFT_P + 4 * 1792, O_CONV_P = O_WKV_P + 4 * 8 * 4096, O_GDN_P = O_CONV_P + 4 * 3 * 1536,
                 O_SHIFT_S = O_GDN_P + 4 * 4 * 16384, O_WKV_S = O_SHIFT_S + 16 * 1792, O_CONV_S = O_WKV_S + 16 * 8 * 4096, O_GDN_S = O_CONV_S + 16 * 3 * 1536, O_END = O_GDN_S + 16 * 4 * 16384;
static_assert(O_END == 35910656, "d_out size");
constexpr size_t MiB = 1u << 20;
constexpr size_t WS_CTL = 0, CTL_ZERO_BYTES = 1 * MiB;
constexpr size_t WS_WIN = 2 * MiB, WS_WOUT = 10 * MiB, WS_WGU = 12 * MiB, WS_WDOWN = 23 * MiB, WS_WPG = 29 * MiB, WS_WPP = 31 * MiB, WS_WLORA = 31 * MiB + 512 * 1024;
constexpr size_t WS_XN = 33 * MiB;
constexpr size_t WS_PROJ = 98 * MiB;
constexpr size_t WS_ACT = 163 * MiB;
constexpr size_t WS_BIG = 340 * MiB;
constexpr size_t WS_XA = WS_BIG, WS_AA = WS_BIG + 33 * MiB, WS_GA = WS_BIG + 66 * MiB;
constexpr size_t WS_LIN = WS_BIG + 99 * MiB;
constexpr size_t WS_RYI = WS_BIG + 99 * MiB, WS_RS = WS_BIG + 132 * MiB;
constexpr size_t WS_RN = WS_BIG + 166 * MiB, WS_BA = WS_BIG + 168 * MiB;
constexpr size_t WS_GNT = WS_BIG, WS_GOI = WS_BIG + 66 * MiB, WS_GS = WS_BIG + 99 * MiB;
constexpr size_t WS_PB = WS_BIG + 1 * MiB;
constexpr size_t WS_SSQ2 = WS_BIG + 20 * MiB, WS_SSQ3 = WS_BIG + 23 * MiB, WS_PP = WS_BIG + 30 * MiB;
constexpr size_t WS_END = 512 * MiB;
static_assert(WS_PROJ + (size_t)MROWS * NPROJ * 2 <= WS_BIG && WS_ACT + (size_t)MROWS * DFF * 2 <= WS_PB && WS_XN + (size_t)MROWS * DM * 2 <= WS_PROJ && WS_PROJ + (size_t)MROWS * DM * 2 <= WS_ACT, "ws map");
static_assert(WS_RS + (size_t)4224 * 8192 <= WS_RN && WS_RYI + (size_t)4224 * 8192 <= WS_RS && WS_LIN + (size_t)MROWS * 256 * 2 <= WS_RN && (size_t)3 * 4224 * 8192 <= (size_t)MROWS * DM * 4 && WS_XA + (size_t)MROWS * 512 * 2 <= WS_AA && WS_GA + (size_t)MROWS * 512 * 2 <= WS_LIN && WS_BA + (size_t)MROWS * 32 <= WS_END, "ws map 2");
static_assert(WS_GS + (size_t)2112 * 32768 <= WS_RN && WS_GNT + (size_t)2112 * 32768 <= WS_GOI && WS_GOI + (size_t)2112 * 16384 <= WS_GS && WS_PP + (size_t)MROWS * DM * 2 <= WS_END && WS_PB + (size_t)MROWS * 512 <= WS_SSQ2, "ws map 3");
static_assert((size_t)2112 * (32768 + 16384) <= (size_t)MROWS * DM * 4, "GM + GQH fit in the y region of d_out");
constexpr int CW_BAR = 4096;
constexpr int RING_OFF = 0, RING_BYTES = 131072;
constexpr int LDS_BYTES = 147456;
constexpr int LDSCTL_OFF = LDS_BYTES - 512, MISC_OFF = LDSCTL_OFF + 320;
#define GAS __attribute__((address_space(1)))
#define LAS __attribute__((address_space(3)))
typedef unsigned v4u __attribute__((ext_vector_type(4)));
typedef float f32x4 __attribute__((ext_vector_type(4)));
typedef short bf16x8 __attribute__((ext_vector_type(8)));
typedef GAS unsigned gu32;
typedef GAS unsigned long long gu64;
#define RLX_AGENT __ATOMIC_RELAXED, __HIP_MEMORY_SCOPE_AGENT
#define LDS_WAIT() asm volatile("s_waitcnt lgkmcnt(0)" ::: "memory")
#define VM_WAIT() asm volatile("s_waitcnt vmcnt(0)" ::: "memory")
__device__ __forceinline__ unsigned long long rt() { return __builtin_amdgcn_s_memrealtime(); }
__device__ __forceinline__ unsigned f2bf(float f) { unsigned u = __builtin_bit_cast(unsigned, f); return (u + 0x7fffu + ((u >> 16) & 1u)) >> 16; }
__device__ __forceinline__ unsigned pk2(float lo, float hi) { return f2bf(lo) | (f2bf(hi) << 16); }

#define XB_TMO      128
#define XB_XCNT(j)  (256  + 64 * (j))
#define XB_XSUB(j)  (1280 + 64 * (j))
#define XB_XGEN(j)  (2304 + 64 * (j))
#define XB_TOP      3328
#define XB_TOPGEN   3392
#define XCD_BAR_WORDS 3456
#define XB_SPIN_CAP (1u << 18)

__device__ __forceinline__ unsigned xb_ld(unsigned* p)              { return __hip_atomic_load(p, __ATOMIC_RELAXED, __HIP_MEMORY_SCOPE_AGENT); }
__device__ __forceinline__ unsigned xb_add(unsigned* p, unsigned v) { return __hip_atomic_fetch_add(p, v, __ATOMIC_RELAXED, __HIP_MEMORY_SCOPE_AGENT); }
__device__ __forceinline__ unsigned xb_xcc_id() { return (unsigned)__builtin_amdgcn_s_getreg((3 << 11) | 20) & 0xFu; }
#define XB_SPIN(cond, bar) do { unsigned _sp = 0; while (cond) { __builtin_amdgcn_s_sleep(1); \
    if ((++_sp & 255u) == 0u) { if (xb_ld(&(bar)[XB_TMO])) break; if (_sp > XB_SPIN_CAP) { atomicAdd(&(bar)[XB_TMO], 1u); break; } } } } while (0)

struct XcdBarrier {
    unsigned* bar; unsigned x;
    volatile LAS unsigned* st;
};

__device__ __forceinline__ XcdBarrier xcd_barrier_post(unsigned* bar, volatile LAS unsigned* st) {
    XcdBarrier b; b.bar = bar; b.x = xb_xcc_id(); b.st = st;
    if (threadIdx.x == 0) (void)xb_add(&bar[XB_XCNT(b.x)], 1u);
    return b;
}
__device__ __forceinline__ void xcd_barrier_complete(unsigned* bar, unsigned x, unsigned& nloc, unsigned& nx) {
    const unsigned G = gridDim.x * gridDim.y * gridDim.z;
    unsigned sum, cnt, mine, sp = 0u;
    for (;;) {
        sum = 0u; cnt = 0u; mine = 0u;
#pragma unroll
        for (unsigned j = 0; j < 16; ++j) { const unsigned c = xb_ld(&bar[XB_XCNT(j)]); sum += c; cnt += (c > 0u) ? 1u : 0u; mine = (j == x) ? c : mine; }
        if (sum == G) break;
        __builtin_amdgcn_s_sleep(1);
        if ((++sp & 255u) == 0u) { if (xb_ld(&bar[XB_TMO])) break; if (sp > XB_SPIN_CAP) { atomicAdd(&bar[XB_TMO], 1u); break; } }
    }
    nloc = mine > 0u ? mine : 1u; nx = cnt > 0u ? cnt : 1u;
}

__device__ __forceinline__ void xcd_barrier(const XcdBarrier& b) {
    asm volatile("s_waitcnt vmcnt(0)" ::: "memory");
    __syncthreads();
    if (threadIdx.x == 0) {
        unsigned* bar = b.bar;
        __builtin_amdgcn_s_waitcnt(0);
        unsigned nloc = b.st[0], nx = b.st[1];
        if (nloc == 0u) { xcd_barrier_complete(bar, b.x, nloc, nx); b.st[0] = nloc; b.st[1] = nx; }
        const unsigned old = xb_add(&bar[XB_XSUB(b.x)], 1u);
        const unsigned gen = old / nloc;
        if (old + 1u == (gen + 1u) * nloc) {
            __builtin_amdgcn_fence(__ATOMIC_RELEASE, "agent");
            asm volatile("s_waitcnt vmcnt(0)" ::: "memory");
            const unsigned og = xb_add(&bar[XB_TOP], 1u);
            const unsigned tg = og / nx;
            if (og + 1u == (tg + 1u) * nx) xb_add(&bar[XB_TOPGEN], 1u);
            else XB_SPIN(xb_ld(&bar[XB_TOPGEN]) == tg, bar);
            __builtin_amdgcn_fence(__ATOMIC_ACQUIRE, "agent");
            xb_add(&bar[XB_XGEN(b.x)], 1u);
            asm volatile("s_waitcnt vmcnt(0)" ::: "memory");
        } else {
            XB_SPIN(xb_ld(&bar[XB_XGEN(b.x)]) == gen, bar);
            __builtin_amdgcn_fence(__ATOMIC_ACQUIRE, "agent");
            asm volatile("s_waitcnt vmcnt(0)" ::: "memory");
        }
    }
    __syncthreads();
}
__device__ __forceinline__ float wave_sum(float v) {
#pragma unroll
    for (int o = 1; o < 64; o <<= 1) v += __shfl_xor(v, o);
    return v;
}
__device__ __forceinline__ float bflo(unsigned w) { return __uint_as_float(w << 16); }
__device__ __forceinline__ float bfhi(unsigned w) { return __uint_as_float(w & 0xffff0000u); }
__device__ __forceinline__ void unpack8(const v4u w, float (&o)[8]) { o[0] = bflo(w.x); o[1] = bfhi(w.x); o[2] = bflo(w.y); o[3] = bfhi(w.y); o[4] = bflo(w.z); o[5] = bfhi(w.z); o[6] = bflo(w.w); o[7] = bfhi(w.w); }
__device__ __forceinline__ v4u pack8(const float (&o)[8]) { v4u w; w.x = pk2(o[0], o[1]); w.y = pk2(o[2], o[3]); w.z = pk2(o[4], o[5]); w.w = pk2(o[6], o[7]); return w; }
__device__ __forceinline__ float fsig(float x) { return __builtin_amdgcn_rcpf(1.f + __builtin_amdgcn_exp2f(-1.44269504f * x)); }
__device__ __forceinline__ float ftanh(float x) { return 1.f - 2.f * __builtin_amdgcn_rcpf(1.f + __builtin_amdgcn_exp2f(2.88539008f * x)); }
__device__ __forceinline__ float fsoftplus(float z) { return fmaxf(z, 0.f) + __logf(1.f + __expf(-fabsf(z))); }

__device__ __forceinline__ int gu_row(int c, int ty) { const int pn = c >> 7, cc = c & 127, wc = cc >> 5, rem = cc & 31, fq = rem >> 3, bj = (rem >> 2) & 1, j = rem & 3; return 256 * pn + 128 * bj + 32 * wc + 16 * ty + 4 * fq + j; }
__device__ __forceinline__ void p0_tr(const float* W, int ldw, int sk0, int sn0, bf16* WT, int ldt, int dk0, int dn0, LAS float* scr, int lane, const float* kscale, int mode) {
#pragma unroll 8
    for (int i = 0; i < 32; ++i) { const int kk = 2 * i + (lane >> 5); float w = W[(size_t)(sk0 + kk) * ldw + sn0 + (lane & 31)]; if (kscale) w *= kscale[sk0 + kk]; scr[kk * 33 + (lane & 31)] = w; }
    LDS_WAIT(); asm volatile("" ::: "memory");
    const int c = lane & 7;
#pragma unroll
    for (int j = 0; j < 4; ++j) { const int n = (lane >> 3) + 8 * j; const LAS float* s = scr + (8 * c) * 33 + n;
        v4u o; o.x = pk2(s[0 * 33], s[1 * 33]); o.y = pk2(s[2 * 33], s[3 * 33]); o.z = pk2(s[4 * 33], s[5 * 33]); o.w = pk2(s[6 * 33], s[7 * 33]);
        const int drow = mode == 0 ? dn0 + n : gu_row(sn0 + n, mode - 1);
        *(GAS v4u*)(WT + (size_t)drow * ldt + dk0 + 8 * c) = o; }
    LDS_WAIT(); asm volatile("" ::: "memory");
}
struct Args { const float* in[34]; float* out; unsigned char* ws; int ph_lo, ph_hi; };
struct Ptrs {
    const __attribute__((address_space(4))) Args* Ap;
    __device__ __forceinline__ const float* xp() const { return Ap->in[0]; }
    __device__ __forceinline__ const float* xs() const { return Ap->in[1]; }
    __device__ __forceinline__ const float* sshift() const { return Ap->in[2]; }
    __device__ __forceinline__ const float* swkv() const { return Ap->in[3]; }
    __device__ __forceinline__ const float* sconv() const { return Ap->in[4]; }
    __device__ __forceinline__ const float* sgdn() const { return Ap->in[5]; }
    __device__ __forceinline__ const float* pp_() const { return Ap->in[6]; }
    __device__ __forceinline__ const float* ps_() const { return Ap->in[7]; }
    __device__ __forceinline__ const float* ln_mix_g() const { return Ap->in[8]; }
    __device__ __forceinline__ const float* w_in() const { return Ap->in[9]; }
    __device__ __forceinline__ const float* mu() const { return Ap->in[10]; }
    __device__ __forceinline__ const float* w0() const { return Ap->in[11]; }
    __device__ __forceinline__ const float* wl_up() const { return Ap->in[12]; }
    __device__ __forceinline__ const float* a0() const { return Ap->in[13]; }
    __device__ __forceinline__ const float* al_up() const { return Ap->in[14]; }
    __device__ __forceinline__ const float* gl_up() const { return Ap->in[15]; }
    __device__ __forceinline__ const float* k_k() const { return Ap->in[16]; }
    __device__ __forceinline__ const float* k_a() const { return Ap->in[17]; }
    __device__ __forceinline__ const float* r_k() const { return Ap->in[18]; }
    __device__ __forceinline__ const float* lnx_w() const { return Ap->in[19]; }
    __device__ __forceinline__ const float* lnx_b() const { return Ap->in[20]; }
    __device__ __forceinline__ const float* conv_w() const { return Ap->in[21]; }
    __device__ __forceinline__ const float* a_log() const { return Ap->in[22]; }
    __device__ __forceinline__ const float* dt_bias() const { return Ap->in[23]; }
    __device__ __forceinline__ const float* gdn_g() const { return Ap->in[24]; }
    __device__ __forceinline__ const float* w_out() const { return Ap->in[25]; }
    __device__ __forceinline__ const float* ln_ffn_g() const { return Ap->in[26]; }
    __device__ __forceinline__ const float* w_gate() const { return Ap->in[27]; }
    __device__ __forceinline__ const float* w_up() const { return Ap->in[28]; }
    __device__ __forceinline__ const float* w_down() const { return Ap->in[29]; }
    __device__ __forceinline__ const float* ln_ple_g() const { return Ap->in[30]; }
    __device__ __forceinline__ const float* w_pg() const { return Ap->in[31]; }
    __device__ __forceinline__ const float* w_pp() const { return Ap->in[32]; }
    __device__ __forceinline__ const float* fin_g() const { return Ap->in[33]; }
    __device__ __forceinline__ float* out() const { return Ap->out; }
    __device__ __forceinline__ bf16* Win_t() const { return (bf16*)(Ap->ws + WS_WIN); }
    __device__ __forceinline__ bf16* Wout_t() const { return (bf16*)(Ap->ws + WS_WOUT); }
    __device__ __forceinline__ bf16* Wgu_t() const { return (bf16*)(Ap->ws + WS_WGU); }
    __device__ __forceinline__ bf16* Wdown_t() const { return (bf16*)(Ap->ws + WS_WDOWN); }
    __device__ __forceinline__ bf16* Wpg_t() const { return (bf16*)(Ap->ws + WS_WPG); }
    __device__ __forceinline__ bf16* Wpp_t() const { return (bf16*)(Ap->ws + WS_WPP); }
    __device__ __forceinline__ bf16* Wlora_t() const { return (bf16*)(Ap->ws + WS_WLORA); }
    __device__ __forceinline__ bf16* XN() const { return (bf16*)(Ap->ws + WS_XN); }
    __device__ __forceinline__ bf16* PROJ() const { return (bf16*)(Ap->ws + WS_PROJ); }
    __device__ __forceinline__ bf16* ACT() const { return (bf16*)(Ap->ws + WS_ACT); }
    __device__ __forceinline__ bf16* XA() const { return (bf16*)(Ap->ws + WS_XA); }
    __device__ __forceinline__ bf16* AA() const { return (bf16*)(Ap->ws + WS_AA); }
    __device__ __forceinline__ bf16* GA() const { return (bf16*)(Ap->ws + WS_GA); }
    __device__ __forceinline__ bf16* PB() const { return (bf16*)(Ap->ws + WS_PB); }
    __device__ __forceinline__ bf16* LIN() const { return (bf16*)(Ap->ws + WS_LIN); }
    __device__ __forceinline__ float* RN() const { return (float*)(Ap->ws + WS_RN); }
    __device__ __forceinline__ float* BA() const { return (float*)(Ap->ws + WS_BA); }
    __device__ __forceinline__ float* SSQ2() const { return (float*)(Ap->ws + WS_SSQ2); }
    __device__ __forceinline__ float* SSQ3() const { return (float*)(Ap->ws + WS_SSQ3); }
    __device__ __forceinline__ bf16* RPHI() const { return (bf16*)Ap->out; }
    __device__ __forceinline__ bf16* RPSI() const { return (bf16*)Ap->out + (size_t)4224 * 4096; }
    __device__ __forceinline__ bf16* RRH() const { return (bf16*)Ap->out + (size_t)2 * 4224 * 4096; }
    __device__ __forceinline__ bf16* RYI() const { return (bf16*)(Ap->ws + WS_RYI); }
    __device__ __forceinline__ bf16* RS() const { return (bf16*)(Ap->ws + WS_RS); }
    __device__ __forceinline__ bf16* GM() const { return (bf16*)Ap->out; }
    __device__ __forceinline__ bf16* GQH() const { return (bf16*)Ap->out + (size_t)2112 * 16384; }
    __device__ __forceinline__ bf16* GNT() const { return (bf16*)(Ap->ws + WS_GNT); }
    __device__ __forceinline__ bf16* GOI() const { return (bf16*)(Ap->ws + WS_GOI); }
    __device__ __forceinline__ bf16* GS() const { return (bf16*)(Ap->ws + WS_GS); }
    __device__ __forceinline__ bf16* PP() const { return (bf16*)(Ap->ws + WS_PP); }
};
__device__ __forceinline__ void p0_prologue(const Ptrs& P, LAS unsigned char* lds, int gw, int NGW, int wave, int lane) {
    LAS float* scr = (LAS float*)(lds + RING_OFF + wave * 16384);
    constexpr int I_IN = 16 * 120, I_OUT = 16 * 32, I_G = 16 * 88, I_DN = 44 * 32, I_PG = 16 * 32, I_PP = 4 * 32, I_LO = 4 * 48;
    constexpr int NITEMS = I_IN + I_OUT + 2 * I_G + I_DN + I_PG + I_PP + I_LO;
    for (int it = gw; it < NITEMS; it += NGW) {
        int r = it;
        if (r < I_IN) { p0_tr(P.w_in(), DIN, 64 * (r / 120), 32 * (r % 120), P.Win_t(), 1024, 64 * (r / 120), 32 * (r % 120), scr, lane, nullptr, 0); continue; } r -= I_IN;
        if (r < I_OUT) { p0_tr(P.w_out(), 1024, 64 * (r / 32), 32 * (r % 32), P.Wout_t(), 1024, 64 * (r / 32), 32 * (r % 32), scr, lane, nullptr, 0); continue; } r -= I_OUT;
        if (r < I_G) { p0_tr(P.w_gate(), DFF, 64 * (r / 88), 32 * (r % 88), P.Wgu_t(), 1024, 64 * (r / 88), 0, scr, lane, P.ln_ffn_g(), 1); continue; } r -= I_G;
        if (r < I_G) { p0_tr(P.w_up(), DFF, 64 * (r / 88), 32 * (r % 88), P.Wgu_t(), 1024, 64 * (r / 88), 0, scr, lane, P.ln_ffn_g(), 2); continue; } r -= I_G;
        if (r < I_DN) { p0_tr(P.w_down(), 1024, 64 * (r / 32), 32 * (r % 32), P.Wdown_t(), DFF, 64 * (r / 32), 32 * (r % 32), scr, lane, nullptr, 0); continue; } r -= I_DN;
        if (r < I_PG) { p0_tr(P.w_pg(), 1024, 64 * (r / 32), 32 * (r % 32), P.Wpg_t(), 1024, 64 * (r / 32), 32 * (r % 32), scr, lane, P.ln_ple_g(), 0); continue; } r -= I_PG;
        if (r < I_PP) { p0_tr(P.w_pp(), 1024, 64 * (r / 32), 32 * (r % 32), P.Wpp_t(), 256, 64 * (r / 32), 32 * (r % 32), scr, lane, nullptr, 0); continue; } r -= I_PP;
        {
            const int kb = r / 48, nb = r % 48, part = nb / 16, n0 = 32 * (nb % 16);
            const bool nz = (part == 0 && kb == 0) || (part == 1 && kb == 1) || (part == 2 && kb >= 2);
            if (nz) { const float* W = part == 0 ? P.wl_up() : (part == 1 ? P.al_up() : P.gl_up()); p0_tr(W, 512, part == 2 ? 64 * (kb - 2) : 0, n0, P.Wlora_t(), 256, 64 * kb, 512 * part + n0, scr, lane, nullptr, 0); }
            else { const int c = lane & 7;
#pragma unroll
                for (int j = 0; j < 4; ++j) { const int n = (lane >> 3) + 8 * j; *(GAS v4u*)(P.Wlora_t() + (size_t)(512 * part + n0 + n) * 256 + 64 * kb + 8 * c) = (v4u){0u, 0u, 0u, 0u}; } }
        }
    }
    f32x4 gv[4];
#pragma unroll
    for (int j = 0; j < 4; ++j) gv[j] = *(const f32x4*)(P.ln_mix_g() + 4 * lane + 256 * j);
    f32x4 wq[16][2];
#pragma unroll
    for (int j = 0; j < 4; ++j)
#pragma unroll
        for (int i = 0; i < 4; ++i) { const float* wr_ = P.w_in() + (size_t)(256 * j + 4 * lane + i) * DIN + NPROJ; wq[4 * j + i][0] = *(const f32x4*)wr_; wq[4 * j + i][1] = *(const f32x4*)(wr_ + 4); }
    for (int m = gw; m < MROWS; m += NGW) {
        const float* xr = m < MP ? P.xp() + (size_t)m * DM : P.xs() + (size_t)(m - MP) * DM;
        const GAS f32x4* x4 = (const GAS f32x4*)xr + lane;
        f32x4 v[4]; float ss = 0.f;
#pragma unroll
        for (int j = 0; j < 4; ++j) { v[j] = x4[64 * j]; ss += (v[j].x * v[j].x + v[j].y * v[j].y) + (v[j].z * v[j].z + v[j].w * v[j].w); }
        const float rstd = 1.0f / sqrtf(wave_sum(ss) * (1.f / DM) + RMS_EPS);
        GAS unsigned long long* o8 = (GAS unsigned long long*)(P.XN() + (size_t)m * DM) + lane;
        f32x4 d0 = {0.f, 0.f, 0.f, 0.f}, d1 = {0.f, 0.f, 0.f, 0.f};
#pragma unroll
        for (int j = 0; j < 4; ++j) { const f32x4 h = v[j] * rstd * gv[j];
            o8[64 * j] = (unsigned long long)pk2(h.x, h.y) | ((unsigned long long)pk2(h.z, h.w) << 32);
#pragma unroll
            for (int i = 0; i < 4; ++i) { d0 += wq[4 * j + i][0] * h[i]; d1 += wq[4 * j + i][1] * h[i]; } }
#pragma unroll
        for (int c = 0; c < 4; ++c) { d0[c] = wave_sum(d0[c]); d1[c] = wave_sum(d1[c]); }
        if (lane == 0) { *(f32x4*)(P.BA() + (size_t)m * 8) = d0; *(f32x4*)(P.BA() + (size_t)m * 8 + 4) = d1; }
    }
}
__device__ __forceinline__ void row_info(int m, int& t, int& sb) { if (m < MP) { t = m & (SEQL - 1); sb = -1; } else { t = (m - MP) & (SSL - 1); sb = (m - MP) >> 4; } }
__device__ __forceinline__ void load_fm8(const Ptrs& P, int m, int t, int sb, int c0, float (&o)[8]) {
    float f[8], p[8];
    unpack8(*(const GAS v4u*)(P.PROJ() + (size_t)m * NPROJ + c0), f);
    if (t > 0) unpack8(*(const GAS v4u*)(P.PROJ() + (size_t)(m - 1) * NPROJ + c0), p);
    else if (sb >= 0) { const f32x4 a = *(const f32x4*)(P.sshift() + (size_t)sb * RPROJ + c0), b = *(const f32x4*)(P.sshift() + (size_t)sb * RPROJ + c0 + 4); p[0] = a.x; p[1] = a.y; p[2] = a.z; p[3] = a.w; p[4] = b.x; p[5] = b.y; p[6] = b.z; p[7] = b.w; }
    else {
#pragma unroll
        for (int i = 0; i < 8; ++i) p[i] = 0.f; }
    const f32x4 m0 = *(const f32x4*)(P.mu() + c0), m1 = *(const f32x4*)(P.mu() + c0 + 4);
#pragma unroll
    for (int i = 0; i < 8; ++i) o[i] = f[i] + (p[i] - f[i]) * (i < 4 ? m0[i] : m1[i - 4]);
}
__device__ __forceinline__ float load_fm1(const Ptrs& P, int m, int t, int sb, int c) {
    const float f = __uint_as_float((unsigned)P.PROJ()[(size_t)m * NPROJ + c] << 16);
    float p = 0.f;
    if (t > 0) p = __uint_as_float((unsigned)P.PROJ()[(size_t)(m - 1) * NPROJ + c] << 16); else if (sb >= 0) p = P.sshift()[(size_t)sb * RPROJ + c];
    return f + (p - f) * P.mu()[c];
}
__device__ __forceinline__ void p2_token_prep(const Ptrs& P, int gw, int NGW, int lane) {
    for (int m = gw; m < MROWS; m += NGW) {
        int t, sb; row_info(m, t, sb);
        {
            const float fw = load_fm1(P, m, t, sb, 1536 + lane), fa = load_fm1(P, m, t, sb, 1600 + lane), fg0 = load_fm1(P, m, t, sb, 1664 + lane), fg1 = load_fm1(P, m, t, sb, 1728 + lane);
            bf16* lr = P.LIN() + (size_t)m * KLORA;
            lr[lane] = (bf16)f2bf(ftanh(fw)); lr[64 + lane] = (bf16)f2bf(fa); lr[128 + lane] = (bf16)f2bf(fsig(fg0)); lr[192 + lane] = (bf16)f2bf(fsig(fg1));
        }
        {
            float k[8]; load_fm8(P, m, t, sb, 512 + 8 * lane, k);
            const f32x4 kk0 = *(const f32x4*)(P.k_k() + 8 * lane), kk1 = *(const f32x4*)(P.k_k() + 8 * lane + 4); float s = 0.f;
#pragma unroll
            for (int i = 0; i < 8; ++i) { const float q = k[i] * (i < 4 ? kk0[i] : kk1[i - 4]); s += q * q; }
            s += __shfl_xor(s, 1); s += __shfl_xor(s, 2); s += __shfl_xor(s, 4);
            if ((lane & 7) == 0) P.RN()[(size_t)m * 8 + (lane >> 3)] = 1.0f / sqrtf(s + 1e-12f);
        }
    }
}
__device__ __forceinline__ void copy_state_rows(const Ptrs& P, int gw, int NGW, int lane) {
    for (int s = gw; s < 20; s += NGW) { const int sb = s - 4; const int mlast = s < 4 ? s * SEQL + SEQL - 1 : MP + sb * SSL + SSL - 1;
        float* dsh = s < 4 ? P.out() + O_SHIFT_P + (size_t)s * RPROJ : P.out() + O_SHIFT_S + (size_t)sb * RPROJ;
        for (int c = lane; c < RPROJ; c += 64) dsh[c] = __uint_as_float((unsigned)P.PROJ()[(size_t)mlast * NPROJ + c] << 16);
        float* dcv = s < 4 ? P.out() + O_CONV_P + (size_t)s * 3 * GQ : P.out() + O_CONV_S + (size_t)sb * 3 * GQ;
        for (int r = 0; r < 3; ++r) for (int c = lane; c < GQ; c += 64) dcv[(size_t)r * GQ + c] = __uint_as_float((unsigned)P.PROJ()[(size_t)(mlast - 2 + r) * NPROJ + OFF_QKV + c] << 16); }
}
__device__ __forceinline__ void p_final_norm(const Ptrs& P, int gw, int NGW, int lane) {
    f32x4 gv[4];
#pragma unroll
    for (int j = 0; j < 4; ++j) gv[j] = *(const f32x4*)(P.fin_g() + 4 * lane + 256 * j);
    for (int m = gw; m < MROWS; m += NGW) {
        GAS f32x4* x4 = (GAS f32x4*)(P.out() + (size_t)m * DM) + lane; f32x4 v[4]; float ss = 0.f;
#pragma unroll
        for (int j = 0; j < 4; ++j) { v[j] = x4[64 * j]; ss += (v[j].x * v[j].x + v[j].y * v[j].y) + (v[j].z * v[j].z + v[j].w * v[j].w); }
        const float rstd = 1.0f / sqrtf(wave_sum(ss) * (1.f / DM) + RMS_EPS);
#pragma unroll
        for (int j = 0; j < 4; ++j) x4[64 * j] = v[j] * rstd * gv[j];
    }
}
typedef float f32x16 __attribute__((ext_vector_type(16)));
typedef unsigned v2u __attribute__((ext_vector_type(2)));
constexpr int NCID = 528, NITEM_G = NCID * 4, NITEM_R = NCID * 8;
constexpr int GL_VEC = 0, GL_AT = 512, GL_QK = 17920, GL_QH = 27136, GL_KH = 44544, GL_VH = 61952, GL_UT = 79360, GL_WT = 97792, GL_KD = 116224;
struct ChunkInfo { int m0, ntok, sb, n; };
__device__ __forceinline__ ChunkInfo chunk_info(int cid) { ChunkInfo c; if (cid < 512) { c.m0 = (cid >> 7) * SEQL + (cid & 127) * 64; c.ntok = 64; c.sb = -1; c.n = cid & 127; } else { c.sb = cid - 512; c.m0 = MP + c.sb * SSL; c.ntok = SSL; c.n = 0; } return c; }
__device__ __forceinline__ f32x16 mfma32(bf16x8 a, bf16x8 b, f32x16 c) { return __builtin_amdgcn_mfma_f32_32x32x16_bf16(a, b, c, 0, 0, 0); }
__device__ __forceinline__ bf16x8 ldfrag(LAS unsigned char* lds, int byteoff) { return *(const LAS bf16x8*)(lds + byteoff); }
__device__ __forceinline__ f32x16 zero16() { f32x16 z;
#pragma unroll
    for (int i = 0; i < 16; ++i) z[i] = 0.f; return z; }

__device__ __forceinline__ void gdn_prep_item(const Ptrs& P, LAS unsigned char* lds, int cid, int h, int tid) {
    const ChunkInfo ci = chunk_info(cid); const int item = cid * 4 + h;
    int lane = tid & 63, wave = __builtin_amdgcn_readfirstlane(tid >> 6), c32 = lane & 31, hh = lane >> 5;
#define OPAQUE_LANE() do { asm volatile("" : "+v"(lane)); asm volatile("" : "+s"(wave)); c32 = lane & 31; hh = lane >> 5; } while (0)
    LAS float* vec = (LAS float*)(lds + GL_VEC);
#ifndef NO_S1
    {   const int tok = tid >> 3, sub = tid & 7, ch0 = 16 * sub; const bool valid = tok < ci.ntok; const int m = ci.m0 + tok; const int tseq = ci.n * 64 + tok;
#pragma unroll 1
        for (int part = 0; part < 3; ++part) {
            float acc[16];
#pragma unroll
            for (int i = 0; i < 16; ++i) acc[i] = 0.f;
            const int col = part * 512 + h * 128 + ch0;
            if (valid) {
#pragma unroll
                for (int j = 0; j < 4; ++j) { const int tt = tseq - 3 + j; float v[16];
                    if (tt >= 0) { const bf16* pr = P.PROJ() + (size_t)(m - 3 + j) * NPROJ + OFF_QKV + col; float a[8], b[8]; unpack8(*(const GAS v4u*)pr, a); unpack8(*(const GAS v4u*)(pr + 8), b);
#pragma unroll
                        for (int i = 0; i < 8; ++i) { v[i] = a[i]; v[8 + i] = b[i]; } }
                    else if (ci.sb >= 0) { const float* sp = P.sconv() + ((size_t)ci.sb * 3 + (3 + tt)) * GQ + col;
#pragma unroll
                        for (int q4 = 0; q4 < 4; ++q4) { const f32x4 a = *(const f32x4*)(sp + 4 * q4); v[4 * q4] = a.x; v[4 * q4 + 1] = a.y; v[4 * q4 + 2] = a.z; v[4 * q4 + 3] = a.w; } }
                    else {
#pragma unroll
                        for (int i = 0; i < 16; ++i) v[i] = 0.f; }
                    const float* cw = P.conv_w() + (size_t)j * GQ + col;
#pragma unroll
                    for (int q4 = 0; q4 < 4; ++q4) { const f32x4 w4 = *(const f32x4*)(cw + 4 * q4); acc[4 * q4] += v[4 * q4] * w4.x; acc[4 * q4 + 1] += v[4 * q4 + 1] * w4.y; acc[4 * q4 + 2] += v[4 * q4 + 2] * w4.z; acc[4 * q4 + 3] += v[4 * q4 + 3] * w4.w; }
                }
            }
            float s = 0.f;
#pragma unroll
            for (int i = 0; i < 16; ++i) { acc[i] = acc[i] * fsig(acc[i]); s += acc[i] * acc[i]; }
            if (part < 2) { s += __shfl_xor(s, 1); s += __shfl_xor(s, 2); s += __shfl_xor(s, 4);
                const float sc = (1.0f / sqrtf(s + 1e-6f)) * (part == 0 ? 0.08838834764831845f : 1.0f);
#pragma unroll
                for (int i = 0; i < 16; ++i) acc[i] *= sc; }
            LAS unsigned char* dst = lds + GL_QH + part * 17408 + tok * 272 + ch0 * 2;
            v4u w0, w1; w0.x = pk2(acc[0], acc[1]); w0.y = pk2(acc[2], acc[3]); w0.z = pk2(acc[4], acc[5]); w0.w = pk2(acc[6], acc[7]); w1.x = pk2(acc[8], acc[9]); w1.y = pk2(acc[10], acc[11]); w1.z = pk2(acc[12], acc[13]); w1.w = pk2(acc[14], acc[15]);
            *(LAS v4u*)dst = w0; *(LAS v4u*)(dst + 16) = w1;
        }
        if (tid < 64) { const int tk = tid; float beta = 0.f, gl = 0.f;
            if (tk < ci.ntok) { const float* ba = P.BA() + (size_t)(ci.m0 + tk) * 8; beta = fsig(ba[h]); gl = -__expf(P.a_log()[h]) * fsoftplus(ba[4 + h] + P.dt_bias()[h]); }
#pragma unroll
            for (int o = 1; o < 64; o <<= 1) { const float t = __shfl_up(gl, o); if (lane >= o) gl += t; }
            vec[tk] = beta; vec[64 + tk] = gl; }
    }
#endif
    __syncthreads();
    const float Glast = vec[64 + 63];
    OPAQUE_LANE();
    if (wave < 6) {
        const int type = wave / 3, tl = wave % 3, ti = tl == 0 ? 0 : 1, tj = tl == 2 ? 1 : 0;
        f32x16 acc = zero16();
        if (type == 0) {
#pragma unroll
            for (int s = 0; s < 8; ++s) acc = mfma32(ldfrag(lds, GL_KH + (32 * ti + c32) * 272 + (16 * s + 8 * hh) * 2), ldfrag(lds, GL_KH + (32 * tj + c32) * 272 + (16 * s + 8 * hh) * 2), acc);
            const int j = 32 * tj + c32; const float Gj = vec[64 + j];
#pragma unroll
            for (int q = 0; q < 4; ++q) { f32x4 o;
#pragma unroll
                for (int e = 0; e < 4; ++e) { const int i = 32 * ti + 8 * q + 4 * hh + e; o[e] = i > j ? vec[i] * acc[4 * q + e] * __expf(vec[64 + i] - Gj) : 0.f; }
                *(LAS f32x4*)(lds + GL_AT + j * 272 + (32 * ti + 8 * q + 4 * hh) * 4) = o; }
        } else {
#pragma unroll
            for (int s = 0; s < 8; ++s) acc = mfma32(ldfrag(lds, GL_KH + (32 * tj + c32) * 272 + (16 * s + 8 * hh) * 2), ldfrag(lds, GL_QH + (32 * ti + c32) * 272 + (16 * s + 8 * hh) * 2), acc);
            const int i = 32 * ti + c32; const float Gi = vec[64 + i];
#pragma unroll
            for (int q = 0; q < 4; ++q) { float o[4];
#pragma unroll
                for (int e = 0; e < 4; ++e) { const int j = 32 * tj + 8 * q + 4 * hh + e; o[e] = i >= j ? acc[4 * q + e] * __expf(Gi - vec[64 + j]) : 0.f; }
                v2u w; w.x = pk2(o[0], o[1]); w.y = pk2(o[2], o[3]);
                *(LAS v2u*)(lds + GL_QK + i * 144 + (32 * tj + 8 * q + 4 * hh) * 2) = w; }
        }
    } else if (wave == 6) {
        LAS unsigned char* dst = lds + GL_QK + (lane >> 1) * 144 + 64 + (lane & 1) * 32;
        *(LAS v4u*)dst = (v4u){0u, 0u, 0u, 0u}; *(LAS v4u*)(dst + 16) = (v4u){0u, 0u, 0u, 0u};
    }
    __syncthreads();
#ifndef NO_S3
    OPAQUE_LANE();
    if (wave < 4) {
        const bool isU = wave < 2; const int col = 64 * (wave & 1) + lane;
        LAS unsigned char* xout = lds + (isU ? GL_UT : GL_WT) + col * 144;
        const LAS unsigned char* src = lds + (isU ? GL_VH : GL_KH) + col * 2;
#pragma unroll 1
        for (int bb = 0; bb < 4; ++bb) {
            float X[16];
            {   float kd[16];
#pragma unroll
                for (int i = 0; i < 16; ++i) { const int r = 16 * bb + i; const float xv = __uint_as_float((unsigned)(*(const LAS unsigned short*)(src + r * 272)) << 16); const float Gr = vec[64 + r];
                    X[i] = vec[r] * xv * (isU ? 1.f : __expf(Gr)); kd[i] = xv * __expf(Glast - Gr); }
                if (!isU) { float o[8];
#pragma unroll
                    for (int i = 0; i < 8; ++i) o[i] = kd[i];
                    *(LAS v4u*)(lds + GL_KD + col * 144 + bb * 32) = pack8(o);
#pragma unroll
                    for (int i = 0; i < 8; ++i) o[i] = kd[8 + i];
                    *(LAS v4u*)(lds + GL_KD + col * 144 + bb * 32 + 16) = pack8(o); }
            }
#pragma unroll 1
            for (int jb = 0; jb < 2 * bb; ++jb) {
                float xj[8]; unpack8(*(const LAS v4u*)(xout + jb * 16), xj);
#pragma unroll
                for (int jj = 0; jj < 8; ++jj) { const LAS unsigned char* ar = lds + GL_AT + (8 * jb + jj) * 272 + bb * 64;
#pragma unroll
                    for (int g4 = 0; g4 < 4; ++g4) { const f32x4 a4 = *(const LAS f32x4*)(ar + g4 * 16);
#pragma unroll
                        for (int e = 0; e < 4; ++e) X[4 * g4 + e] = fmaf(-a4[e], xj[jj], X[4 * g4 + e]); } }
            }
#pragma unroll
            for (int j = 0; j < 15; ++j) { const LAS unsigned char* ar = lds + GL_AT + (16 * bb + j) * 272 + bb * 64;
#pragma unroll
                for (int g4 = (j + 1) >> 2; g4 < 4; ++g4) { const f32x4 a4 = *(const LAS f32x4*)(ar + g4 * 16);
#pragma unroll
                    for (int e = 0; e < 4; ++e) { const int i = 4 * g4 + e; if (i > j) X[i] = fmaf(-a4[e], X[j], X[i]); } } }
            {   float o[8];
#pragma unroll
                for (int i = 0; i < 8; ++i) o[i] = X[i];
                *(LAS v4u*)(xout + bb * 32) = pack8(o);
#pragma unroll
                for (int i = 0; i < 8; ++i) o[i] = X[8 + i];
                *(LAS v4u*)(xout + bb * 32 + 16) = pack8(o); }
            LDS_WAIT(); asm volatile("" ::: "memory");
        }
    }
#endif
    __syncthreads();
#ifndef NO_S4
    {   bf16* GM = P.GM() + (size_t)item * 16384; bf16* GNT = P.GNT() + (size_t)item * 16384; bf16* GQH = P.GQH() + (size_t)item * 8192; bf16* GOI = P.GOI() + (size_t)item * 8192;
        const float eGl = __expf(Glast);
        OPAQUE_LANE();
        {   const int dpt = wave & 3; const int dp = 32 * dpt + c32;
#pragma unroll
            for (int u = 0; u < 2; ++u) { const int dt = 2 * (wave >> 2) + u; f32x16 acc = zero16();
#pragma unroll
                for (int s = 0; s < 4; ++s) acc = mfma32(ldfrag(lds, GL_WT + (32 * dt + c32) * 144 + (16 * s + 8 * hh) * 2), ldfrag(lds, GL_KD + dp * 144 + (16 * s + 8 * hh) * 2), acc);
#pragma unroll
                for (int q = 0; q < 4; ++q) { float o[4];
#pragma unroll
                    for (int e = 0; e < 4; ++e) { const int d = 32 * dt + 8 * q + 4 * hh + e; o[e] = (d == dp ? eGl : 0.f) - acc[4 * q + e]; }
                    const int chunk = (2 * (2 * dt + (q >> 1)) + hh) ^ (dp & 15);
                    v2u w; w.x = pk2(o[0], o[1]); w.y = pk2(o[2], o[3]);
                    *(GAS v2u*)((unsigned char*)GM + dp * 256 + chunk * 16 + (q & 1) * 8) = w; } }
        }
        OPAQUE_LANE();
        {   const int et = wave & 3; const int e_ = 32 * et + c32;
#pragma unroll
            for (int u = 0; u < 2; ++u) { const int dpt = 2 * (wave >> 2) + u; f32x16 acc = zero16();
#pragma unroll
                for (int s = 0; s < 4; ++s) acc = mfma32(ldfrag(lds, GL_KD + (32 * dpt + c32) * 144 + (16 * s + 8 * hh) * 2), ldfrag(lds, GL_UT + e_ * 144 + (16 * s + 8 * hh) * 2), acc);
#pragma unroll
                for (int q = 0; q < 4; ++q) { v2u w; w.x = pk2(acc[4 * q], acc[4 * q + 1]); w.y = pk2(acc[4 * q + 2], acc[4 * q + 3]);
                    *(GAS v2u*)(GNT + (size_t)e_ * 128 + 32 * dpt + 8 * q + 4 * hh) = w; } }
        }
        OPAQUE_LANE();
        {   const int xt = wave & 3, it = wave >> 2; const int i = 32 * it + c32; const float eGi = __expf(vec[64 + i]); const int ns = it == 0 ? 2 : 4;
            f32x16 acc = zero16(), acc2 = zero16();
            for (int s = 0; s < ns; ++s) { const bf16x8 b = ldfrag(lds, GL_QK + i * 144 + (16 * s + 8 * hh) * 2);
                acc = mfma32(ldfrag(lds, GL_WT + (32 * xt + c32) * 144 + (16 * s + 8 * hh) * 2), b, acc);
                acc2 = mfma32(ldfrag(lds, GL_UT + (32 * xt + c32) * 144 + (16 * s + 8 * hh) * 2), b, acc2); }
#pragma unroll
            for (int q = 0; q < 4; ++q) { const int d = 32 * xt + 8 * q + 4 * hh; const v2u qq = *(const LAS v2u*)(lds + GL_QH + i * 272 + d * 2);
                v2u w; w.x = pk2(bflo(qq.x) * eGi - acc[4 * q], bfhi(qq.x) * eGi - acc[4 * q + 1]); w.y = pk2(bflo(qq.y) * eGi - acc[4 * q + 2], bfhi(qq.y) * eGi - acc[4 * q + 3]);
                *(GAS v2u*)(GQH + (size_t)i * 128 + d) = w;
                v2u w2; w2.x = pk2(acc2[4 * q], acc2[4 * q + 1]); w2.y = pk2(acc2[4 * q + 2], acc2[4 * q + 3]);
                *(GAS v2u*)(GOI + (size_t)i * 128 + d) = w2; }
        }
    }
#endif
    __syncthreads();
#undef OPAQUE_LANE
}
__device__ __forceinline__ void gdn_serial_job(const Ptrs& P, LAS unsigned char* lds, int item0, int istride, int nch, const float* s0, float* sfinal, int tid) {
    const int lane = tid & 63, wave = tid >> 6, c32 = lane & 31, hh = lane >> 5; const int e_ = 32 * (wave & 3) + c32;
    f32x16 acc[4];
#pragma unroll
    for (int mt = 0; mt < 4; ++mt)
#pragma unroll
        for (int r = 0; r < 16; ++r) acc[mt][r] = s0 ? s0[(size_t)(32 * mt + (r & 3) + 8 * (r >> 2) + 4 * hh) * 128 + e_] : 0.f;
    v4u st[4];
    {   const GAS v4u* src = (const GAS v4u*)(P.GM() + (size_t)item0 * 16384) + tid;
#pragma unroll
        for (int k = 0; k < 4; ++k) st[k] = src[512 * k];
#pragma unroll
        for (int k = 0; k < 4; ++k) *(LAS v4u*)(lds + (tid + 512 * k) * 16) = st[k]; }
    __syncthreads();
    for (int n = 0; n < nch; ++n) {
        const int item = item0 + n * istride; LAS unsigned char* mb = lds + (n & 1) * 32768;
        if (n + 1 < nch) { const GAS v4u* src = (const GAS v4u*)(P.GM() + (size_t)(item + istride) * 16384) + tid;
#pragma unroll
            for (int k = 0; k < 4; ++k) st[k] = src[512 * k]; }
        if (wave < 4) {
            bf16x8 sf[8];
            bf16* gs = P.GS() + (size_t)item * 16384 + (size_t)e_ * 128; const bf16* gn = P.GNT() + (size_t)item * 16384 + (size_t)e_ * 128;
#pragma unroll
            for (int mt = 0; mt < 4; ++mt) {
#pragma unroll
                for (int s2 = 0; s2 < 2; ++s2) { v4u w; w.x = pk2(acc[mt][8 * s2], acc[mt][8 * s2 + 1]); w.y = pk2(acc[mt][8 * s2 + 2], acc[mt][8 * s2 + 3]); w.z = pk2(acc[mt][8 * s2 + 4], acc[mt][8 * s2 + 5]); w.w = pk2(acc[mt][8 * s2 + 6], acc[mt][8 * s2 + 7]);
                    sf[2 * mt + s2] = __builtin_bit_cast(bf16x8, w);
                    *(GAS v2u*)(gs + 32 * mt + 16 * s2 + 4 * hh) = (v2u){w.x, w.y}; *(GAS v2u*)(gs + 32 * mt + 16 * s2 + 8 + 4 * hh) = (v2u){w.z, w.w}; } }
#pragma unroll
            for (int mt = 0; mt < 4; ++mt) {
#pragma unroll
                for (int q = 0; q < 4; ++q) { const v2u w = *(const GAS v2u*)(gn + 32 * mt + 8 * q + 4 * hh); acc[mt][4 * q] = bflo(w.x); acc[mt][4 * q + 1] = bfhi(w.x); acc[mt][4 * q + 2] = bflo(w.y); acc[mt][4 * q + 3] = bfhi(w.y); }
                const int dp = 32 * mt + c32;
#pragma unroll
                for (int s = 0; s < 8; ++s) acc[mt] = mfma32(ldfrag(mb, dp * 256 + (((2 * s + hh) ^ (dp & 15)) * 16)), sf[s], acc[mt]);
            }
        }
        if (n + 1 < nch) {
#pragma unroll
            for (int k = 0; k < 4; ++k) *(LAS v4u*)(lds + ((n + 1) & 1) * 32768 + (tid + 512 * k) * 16) = st[k]; }
        __syncthreads();
    }
    if (wave < 4) {
#pragma unroll
        for (int mt = 0; mt < 4; ++mt)
#pragma unroll
            for (int r = 0; r < 16; ++r) sfinal[(size_t)(32 * mt + (r & 3) + 8 * (r >> 2) + 4 * hh) * 128 + e_] = acc[mt][r];
    }
}
__device__ __forceinline__ void gdn_out_item(const Ptrs& P, LAS unsigned char* wl, int cid, int h, int lane) {
    const ChunkInfo ci = chunk_info(cid); const int item = cid * 4 + h; const int c32 = lane & 31, hh = lane >> 5;
    const bf16* gs = P.GS() + (size_t)item * 16384; const bf16* gq = P.GQH() + (size_t)item * 8192; const bf16* go = P.GOI() + (size_t)item * 8192;
#pragma unroll 1
    for (int it = 0; it < 2; ++it) { const int i = 32 * it + c32;
        bf16x8 bq[8];
#pragma unroll
        for (int s = 0; s < 8; ++s) bq[s] = *(const GAS bf16x8*)(gq + (size_t)i * 128 + 16 * s + 8 * hh);
        f32x16 acc[4]; float ss = 0.f;
#pragma unroll
        for (int et = 0; et < 4; ++et) {
#pragma unroll
            for (int q = 0; q < 4; ++q) { const v2u w = *(const GAS v2u*)(go + (size_t)i * 128 + 32 * et + 8 * q + 4 * hh); acc[et][4 * q] = bflo(w.x); acc[et][4 * q + 1] = bfhi(w.x); acc[et][4 * q + 2] = bflo(w.y); acc[et][4 * q + 3] = bfhi(w.y); }
#pragma unroll
            for (int s = 0; s < 8; ++s) acc[et] = mfma32(*(const GAS bf16x8*)(gs + (size_t)(32 * et + c32) * 128 + 16 * s + 8 * hh), bq[s], acc[et]);
#pragma unroll
            for (int r = 0; r < 16; ++r) ss += acc[et][r] * acc[et][r];
        }
        ss += __shfl_xor(ss, 32);
        const float rstd = 1.0f / sqrtf(ss * (1.f / 128.f) + RMS_EPS);
#pragma unroll
        for (int et = 0; et < 4; ++et)
#pragma unroll
            for (int q = 0; q < 4; ++q) { v2u w; w.x = pk2(acc[et][4 * q] * rstd, acc[et][4 * q + 1] * rstd); w.y = pk2(acc[et][4 * q + 2] * rstd, acc[et][4 * q + 3] * rstd);
                *(LAS v2u*)(wl + i * 272 + (32 * et + 8 * q + 4 * hh) * 2) = w; }
    }
    LDS_WAIT(); asm volatile("" ::: "memory");
    {   const int e8 = (lane & 15) * 8; const f32x4 g0 = *(const f32x4*)(P.gdn_g() + e8), g1 = *(const f32x4*)(P.gdn_g() + e8 + 4);
#pragma unroll 4
        for (int k = 0; k < 16; ++k) { const int row = 4 * k + (lane >> 4);
            if (row < ci.ntok) { const int m = ci.m0 + row; float o[8], z[8];
                unpack8(*(const LAS v4u*)(wl + row * 272 + e8 * 2), o); unpack8(*(const GAS v4u*)(P.PROJ() + (size_t)m * NPROJ + OFF_Z + h * 128 + e8), z);
#pragma unroll
                for (int e = 0; e < 8; ++e) o[e] = o[e] * (e < 4 ? g0[e] : g1[e - 4]) * (z[e] * fsig(z[e]));
                *(GAS v4u*)(P.XN() + (size_t)m * DM + 512 + h * 128 + e8) = pack8(o); } }
    }
    LDS_WAIT(); asm volatile("" ::: "memory");
}
constexpr int RL_LT = 0, RL_VEC = 17408, RL_SCR = 17664, RL_IMG = 19712;
enum { RI_AL = 0, RI_BE, RI_KT, RI_RT, RI_BET, RI_KTT, RI_VT, RI_LK, RI_QRB, RI_OMT, RI_XT, RI_CM, RI_KHT };
__device__ __forceinline__ int rimg(int i) { return RL_IMG + i * 9216; }
static_assert(RL_IMG + 13 * 9216 <= LDSCTL_OFF, "rwkv prep LDS");
__device__ __forceinline__ f32x16 tile_mm(LAS unsigned char* lds, int a_img, int at, int b_img, int bt, int s0, int s1, int c32, int hh, f32x16 acc) {
    const int ao = a_img + (32 * at + c32) * 144 + hh * 16, bo = b_img + (32 * bt + c32) * 144 + hh * 16;
#pragma unroll
    for (int s = 0; s < 4; ++s) if (s >= s0 && s < s1) acc = mfma32(ldfrag(lds, ao + s * 32), ldfrag(lds, bo + s * 32), acc);
    return acc;
}
__device__ __forceinline__ void rwkv_prep_item(const Ptrs& P, LAS unsigned char* lds, int cid, int h, int tid) {
    const ChunkInfo ci = chunk_info(cid); const int item = cid * 8 + h;
    int lane = tid & 63, wave = __builtin_amdgcn_readfirstlane(tid >> 6), c32 = lane & 31, hh = lane >> 5;
#define OPAQUE_LANE() do { asm volatile("" : "+v"(lane)); asm volatile("" : "+s"(wave)); c32 = lane & 31; hh = lane >> 5; } while (0)
    LAS float* pc = (LAS float*)(lds + RL_VEC); LAS float* scr = (LAS float*)(lds + RL_SCR);
    {   const int ch = lane, col = h * 64 + ch; const int tk0 = 8 * wave;
        const float mur = P.mu()[col], muk = P.mu()[512 + col], muv = P.mu()[1024 + col], kkc = P.k_k()[col], kac = P.k_a()[col];
        float fr[9], fk[9], fv[9];
#pragma unroll
        for (int i = 0; i < 9; ++i) { const int tk = tk0 - 1 + i; const int tseq = ci.n * 64 + tk; float a = 0.f, b = 0.f, c = 0.f;
            if (tk < ci.ntok) {
                if (tseq >= 0) { const bf16* pr = P.PROJ() + (size_t)(ci.m0 + tk) * NPROJ + col; a = __uint_as_float((unsigned)pr[0] << 16); b = __uint_as_float((unsigned)pr[512] << 16); c = __uint_as_float((unsigned)pr[1024] << 16); }
                else if (ci.sb >= 0) { const float* sp = P.sshift() + (size_t)ci.sb * RPROJ + col; a = sp[0]; b = sp[512]; c = sp[1024]; } }
            fr[i] = a; fk[i] = b; fv[i] = c; }
        float xs[8], av[8], rnv[8];
#pragma unroll
        for (int i = 0; i < 8; ++i) { const int tk = tk0 + i; xs[i] = 0.f; av[i] = 0.f; rnv[i] = 0.f;
            if (tk < ci.ntok) { const size_t m = (size_t)(ci.m0 + tk); xs[i] = __uint_as_float((unsigned)P.XA()[m * 512 + col] << 16); av[i] = __uint_as_float((unsigned)P.AA()[m * 512 + col] << 16); rnv[i] = P.RN()[m * 8 + h]; } }
        float cum[8]; float run = 0.f;
#pragma unroll
        for (int i = 0; i < 8; ++i) { run += xs[i]; cum[i] = run; }
        scr[wave * 64 + ch] = run;
        __syncthreads();
        float off = 0.f;
#pragma unroll
        for (int w2 = 0; w2 < 8; ++w2) if (w2 < wave) off += scr[w2 * 64 + ch];
        float be[8], kt[8], vv[8];
#pragma unroll
        for (int i = 0; i < 8; ++i) { const int tk = tk0 + i; const bool valid = tk < ci.ntok;
            const float r = fr[i + 1] + (fr[i] - fr[i + 1]) * mur, k = fk[i + 1] + (fk[i] - fk[i + 1]) * muk, v = fv[i + 1] + (fv[i] - fv[i + 1]) * muv;
            const float c1 = off + cum[i], c0 = c1 - xs[i]; const float kap = k * kkc * rnv[i], keff = k * (1.f + (av[i] - 1.f) * kac);
            const float ec = __expf(c1);
            const float al = valid ? kap * __expf(-c0) : 0.f, b_ = valid ? kap * av[i] * ec : 0.f, kt_ = valid ? keff * ec : 0.f, rt = valid ? r * __expf(-c1) : 0.f;
            be[i] = b_; kt[i] = kt_; vv[i] = valid ? v : 0.f;
            *(LAS unsigned short*)(lds + rimg(RI_AL) + tk * 144 + ch * 2) = (unsigned short)f2bf(al);
            *(LAS unsigned short*)(lds + rimg(RI_BE) + tk * 144 + ch * 2) = (unsigned short)f2bf(b_);
            *(LAS unsigned short*)(lds + rimg(RI_KT) + tk * 144 + ch * 2) = (unsigned short)f2bf(kt_);
            *(LAS unsigned short*)(lds + rimg(RI_RT) + tk * 144 + ch * 2) = (unsigned short)f2bf(rt);
            if (tk == 63) pc[ch] = __expf(-c1); }
        *(LAS v4u*)(lds + rimg(RI_BET) + ch * 144 + tk0 * 2) = pack8(be);
        *(LAS v4u*)(lds + rimg(RI_KTT) + ch * 144 + tk0 * 2) = pack8(kt);
        *(LAS v4u*)(lds + rimg(RI_VT) + ch * 144 + tk0 * 2) = pack8(vv);
    }
    __syncthreads();
    OPAQUE_LANE();
#pragma unroll 1
    for (int task = wave; task < 11; task += 8) {
        if (task < 9) { const int type = task / 3, tl = task % 3, ti = tl == 1 ? 0 : 1, tj = tl == 2 ? 1 : 0;
            if (type == 0) { const f32x16 acc = tile_mm(lds, rimg(RI_AL), ti, rimg(RI_BE), tj, 0, 4, c32, hh, zero16()); const int j = 32 * tj + c32;
#pragma unroll
                for (int q = 0; q < 4; ++q) { f32x4 o;
#pragma unroll
                    for (int e = 0; e < 4; ++e) { const int t = 32 * ti + 8 * q + 4 * hh + e; o[e] = t > j ? acc[4 * q + e] : 0.f; }
                    *(LAS f32x4*)(lds + RL_LT + j * 272 + (32 * ti + 8 * q + 4 * hh) * 4) = o; } }
            else if (type == 1) { const f32x16 acc = tile_mm(lds, rimg(RI_AL), ti, rimg(RI_KT), tj, 0, 4, c32, hh, zero16()); const int j = 32 * tj + c32;
#pragma unroll
                for (int r = 0; r < 16; ++r) { const int t = 32 * ti + (r & 3) + 8 * (r >> 2) + 4 * hh; *(LAS unsigned short*)(lds + rimg(RI_LK) + t * 144 + j * 2) = (unsigned short)f2bf(t > j ? acc[r] : 0.f); } }
            else { const f32x16 acc = tile_mm(lds, rimg(RI_BE), tj, rimg(RI_RT), ti, 0, 4, c32, hh, zero16()); const int t = 32 * ti + c32;
#pragma unroll
                for (int q = 0; q < 4; ++q) { float o[4];
#pragma unroll
                    for (int e = 0; e < 4; ++e) { const int j = 32 * tj + 8 * q + 4 * hh + e; o[e] = j <= t ? acc[4 * q + e] : 0.f; }
                    v2u w; w.x = pk2(o[0], o[1]); w.y = pk2(o[2], o[3]); *(LAS v2u*)(lds + rimg(RI_QRB) + t * 144 + (32 * tj + 8 * q + 4 * hh) * 2) = w; } }
        } else { const int img = task == 9 ? RI_LK : RI_QRB;
            LAS unsigned char* dst = lds + rimg(img) + (lane >> 1) * 144 + 64 + (lane & 1) * 32;
            *(LAS v4u*)dst = (v4u){0u, 0u, 0u, 0u}; *(LAS v4u*)(dst + 16) = (v4u){0u, 0u, 0u, 0u}; }
    }
    __syncthreads();
    OPAQUE_LANE();
    if (wave < 2) {
        const int col = lane; LAS unsigned char* xout = lds + rimg(wave == 0 ? RI_OMT : RI_XT) + col * 144; const LAS unsigned char* src = lds + rimg(wave == 0 ? RI_AL : RI_LK) + col * 2;
#pragma unroll 1
        for (int bb = 0; bb < 4; ++bb) {
            float X[16];
#pragma unroll
            for (int i = 0; i < 16; ++i) X[i] = __uint_as_float((unsigned)(*(const LAS unsigned short*)(src + (16 * bb + i) * 144)) << 16);
#pragma unroll 1
            for (int jb = 0; jb < 2 * bb; ++jb) { float xj[8]; unpack8(*(const LAS v4u*)(xout + jb * 16), xj);
#pragma unroll
                for (int jj = 0; jj < 8; ++jj) { const LAS unsigned char* ar = lds + RL_LT + (8 * jb + jj) * 272 + bb * 64;
#pragma unroll
                    for (int g4 = 0; g4 < 4; ++g4) { const f32x4 a4 = *(const LAS f32x4*)(ar + g4 * 16);
#pragma unroll
                        for (int e = 0; e < 4; ++e) X[4 * g4 + e] = fmaf(-a4[e], xj[jj], X[4 * g4 + e]); } } }
#pragma unroll
            for (int j = 0; j < 15; ++j) { const LAS unsigned char* ar = lds + RL_LT + (16 * bb + j) * 272 + bb * 64;
#pragma unroll
                for (int g4 = (j + 1) >> 2; g4 < 4; ++g4) { const f32x4 a4 = *(const LAS f32x4*)(ar + g4 * 16);
#pragma unroll
                    for (int e = 0; e < 4; ++e) { const int i = 4 * g4 + e; if (i > j) X[i] = fmaf(-a4[e], X[j], X[i]); } } }
            {   float o[8];
#pragma unroll
                for (int i = 0; i < 8; ++i) o[i] = X[i];
                *(LAS v4u*)(xout + bb * 32) = pack8(o);
#pragma unroll
                for (int i = 0; i < 8; ++i) o[i] = X[8 + i];
                *(LAS v4u*)(xout + bb * 32 + 16) = pack8(o); }
            LDS_WAIT(); asm volatile("" ::: "memory");
        }
    }
    __syncthreads();
    OPAQUE_LANE();
    {   bf16* RRH = P.RRH() + (size_t)item * 4096; bf16* RPHI = P.RPHI() + (size_t)item * 4096;
#pragma unroll 1
        for (int task = wave; task < 16; task += 8) { const int type = task >> 2, ta = (task >> 1) & 1, tb = task & 1;
            if (type == 0) {
                const int t = 32 * tb + c32; v2u w[4];
                if (ta <= tb) { const f32x16 acc = tile_mm(lds, rimg(RI_KT), ta, rimg(RI_RT), tb, 0, 4, c32, hh, zero16());
                    const f32x16 acx = tile_mm(lds, rimg(RI_XT), ta, rimg(RI_QRB), tb, 0, 4, c32, hh, zero16());
#pragma unroll
                    for (int q = 0; q < 4; ++q) { float o[4];
#pragma unroll
                        for (int e = 0; e < 4; ++e) { const int j = 32 * ta + 8 * q + 4 * hh + e; o[e] = (j <= t ? acc[4 * q + e] : 0.f) - acx[4 * q + e]; }
                        w[q].x = pk2(o[0], o[1]); w[q].y = pk2(o[2], o[3]); } }
                else {
#pragma unroll
                    for (int q = 0; q < 4; ++q) w[q] = (v2u){0u, 0u}; }
#pragma unroll
                for (int q = 0; q < 4; ++q) *(LAS v2u*)(lds + rimg(RI_CM) + t * 144 + (32 * ta + 8 * q + 4 * hh) * 2) = w[q]; }
            else if (type == 1) {
                const int t = 32 * tb + c32; const f32x16 acc = tile_mm(lds, rimg(RI_OMT), ta, rimg(RI_QRB), tb, 0, 4, c32, hh, zero16());
#pragma unroll
                for (int q = 0; q < 4; ++q) { const int k = 32 * ta + 8 * q + 4 * hh; const v2u rr = *(const LAS v2u*)(lds + rimg(RI_RT) + t * 144 + k * 2);
                    v2u w; w.x = pk2(bflo(rr.x) - acc[4 * q], bfhi(rr.x) - acc[4 * q + 1]); w.y = pk2(bflo(rr.y) - acc[4 * q + 2], bfhi(rr.y) - acc[4 * q + 3]);
                    *(GAS v2u*)(RRH + (size_t)t * 64 + k) = w; } }
            else if (type == 2) {
                const int k = 32 * tb + c32; const float pk = pc[k]; const f32x16 acc = tile_mm(lds, rimg(RI_XT), ta, rimg(RI_BET), tb, 0, 4, c32, hh, zero16());
#pragma unroll
                for (int q = 0; q < 4; ++q) { const int j = 32 * ta + 8 * q + 4 * hh; const v2u kk = *(const LAS v2u*)(lds + rimg(RI_KTT) + k * 144 + j * 2);
                    v2u w; w.x = pk2((bflo(kk.x) - acc[4 * q]) * pk, (bfhi(kk.x) - acc[4 * q + 1]) * pk); w.y = pk2((bflo(kk.y) - acc[4 * q + 2]) * pk, (bfhi(kk.y) - acc[4 * q + 3]) * pk);
                    *(LAS v2u*)(lds + rimg(RI_KHT) + k * 144 + j * 2) = w; } }
            else {
                const int k = 32 * tb + c32; const float pk = pc[k]; const f32x16 acc = tile_mm(lds, rimg(RI_OMT), ta, rimg(RI_BET), tb, 0, 4, c32, hh, zero16());
#pragma unroll
                for (int q = 0; q < 4; ++q) { float o[4];
#pragma unroll
                    for (int e = 0; e < 4; ++e) { const int kp = 32 * ta + 8 * q + 4 * hh + e; o[e] = ((kp == k ? 1.f : 0.f) - acc[4 * q + e]) * pk; }
                    v2u w; w.x = pk2(o[0], o[1]); w.y = pk2(o[2], o[3]);
                    *(GAS v2u*)(RPHI + (size_t)k * 64 + 16 * (2 * ta + (q >> 1)) + 8 * hh + 4 * (q & 1)) = w; } }
        }
    }
    __syncthreads();
    OPAQUE_LANE();
    {   const int type = wave >> 2, ta = (wave >> 1) & 1, tb = wave & 1;
        if (type == 0) {
            const int v = 32 * tb + c32; const f32x16 acc = tile_mm(lds, rimg(RI_KHT), ta, rimg(RI_VT), tb, 0, 4, c32, hh, zero16()); bf16* RPSI = P.RPSI() + (size_t)item * 4096;
#pragma unroll
            for (int q = 0; q < 4; ++q) { v2u w; w.x = pk2(acc[4 * q], acc[4 * q + 1]); w.y = pk2(acc[4 * q + 2], acc[4 * q + 3]); *(GAS v2u*)(RPSI + (size_t)v * 64 + 32 * ta + 8 * q + 4 * hh) = w; } }
        else {
            const int t = 32 * tb + c32; const f32x16 acc = tile_mm(lds, rimg(RI_VT), ta, rimg(RI_CM), tb, 0, 4, c32, hh, zero16()); bf16* RYI = P.RYI() + (size_t)item * 4096;
#pragma unroll
            for (int q = 0; q < 4; ++q) { v2u w; w.x = pk2(acc[4 * q], acc[4 * q + 1]); w.y = pk2(acc[4 * q + 2], acc[4 * q + 3]); *(GAS v2u*)(RYI + (size_t)t * 64 + 32 * ta + 8 * q + 4 * hh) = w; } }
    }
    __syncthreads();
#undef OPAQUE_LANE
}
__device__ __forceinline__ void rwkv_serial_job(const Ptrs& P, int item0, int istride, int nch, const float* s0, float* sfinal, int wsel, int lane) {
    const int c32 = lane & 31, hh = lane >> 5, v = 32 * wsel + c32;
    f32x16 acc[2];
#pragma unroll
    for (int mt = 0; mt < 2; ++mt)
#pragma unroll
        for (int r = 0; r < 16; ++r) acc[mt][r] = s0 ? s0[(size_t)v * 64 + 32 * mt + (r & 3) + 8 * (r >> 2) + 4 * hh] : 0.f;
    bf16x8 af[2][4]; v2u pf[2][4];
    {   const bf16* ph = P.RPHI() + (size_t)item0 * 4096; const bf16* ps = P.RPSI() + (size_t)item0 * 4096 + (size_t)v * 64;
#pragma unroll
        for (int mt = 0; mt < 2; ++mt)
#pragma unroll
            for (int s = 0; s < 4; ++s) { af[mt][s] = *(const GAS bf16x8*)(ph + (size_t)(32 * mt + c32) * 64 + 16 * s + 8 * hh); pf[mt][s] = *(const GAS v2u*)(ps + 32 * mt + 8 * s + 4 * hh); } }
    for (int n = 0; n < nch; ++n) {
        const int item = item0 + n * istride;
        bf16x8 an[2][4]; v2u pn[2][4];
        if (n + 1 < nch) { const bf16* ph = P.RPHI() + (size_t)(item + istride) * 4096; const bf16* ps = P.RPSI() + (size_t)(item + istride) * 4096 + (size_t)v * 64;
#pragma unroll
            for (int mt = 0; mt < 2; ++mt)
#pragma unroll
                for (int s = 0; s < 4; ++s) { an[mt][s] = *(const GAS bf16x8*)(ph + (size_t)(32 * mt + c32) * 64 + 16 * s + 8 * hh); pn[mt][s] = *(const GAS v2u*)(ps + 32 * mt + 8 * s + 4 * hh); } }
        else {
#pragma unroll
            for (int mt = 0; mt < 2; ++mt)
#pragma unroll
                for (int s = 0; s < 4; ++s) { an[mt][s] = af[mt][s]; pn[mt][s] = pf[mt][s]; } }
        bf16x8 sf[4]; bf16* rs = P.RS() + (size_t)item * 4096 + (size_t)v * 64;
#pragma unroll
        for (int mt = 0; mt < 2; ++mt)
#pragma unroll
            for (int s2 = 0; s2 < 2; ++s2) { v4u w; w.x = pk2(acc[mt][8 * s2], acc[mt][8 * s2 + 1]); w.y = pk2(acc[mt][8 * s2 + 2], acc[mt][8 * s2 + 3]); w.z = pk2(acc[mt][8 * s2 + 4], acc[mt][8 * s2 + 5]); w.w = pk2(acc[mt][8 * s2 + 6], acc[mt][8 * s2 + 7]);
                sf[2 * mt + s2] = __builtin_bit_cast(bf16x8, w);
                *(GAS v2u*)(rs + 32 * mt + 16 * s2 + 4 * hh) = (v2u){w.x, w.y}; *(GAS v2u*)(rs + 32 * mt + 16 * s2 + 8 + 4 * hh) = (v2u){w.z, w.w}; }
#pragma unroll
        for (int mt = 0; mt < 2; ++mt) {
#pragma unroll
            for (int q = 0; q < 4; ++q) { const v2u w = pf[mt][q]; acc[mt][4 * q] = bflo(w.x); acc[mt][4 * q + 1] = bfhi(w.x); acc[mt][4 * q + 2] = bflo(w.y); acc[mt][4 * q + 3] = bfhi(w.y); }
#pragma unroll
            for (int s = 0; s < 4; ++s) acc[mt] = mfma32(af[mt][s], sf[s], acc[mt]);
        }
#pragma unroll
        for (int mt = 0; mt < 2; ++mt)
#pragma unroll
            for (int s = 0; s < 4; ++s) { af[mt][s] = an[mt][s]; pf[mt][s] = pn[mt][s]; }
    }
#pragma unroll
    for (int mt = 0; mt < 2; ++mt)
#pragma unroll
        for (int q = 0; q < 4; ++q) *(f32x4*)(sfinal + (size_t)v * 64 + 32 * mt + 8 * q + 4 * hh) = (f32x4){acc[mt][4 * q], acc[mt][4 * q + 1], acc[mt][4 * q + 2], acc[mt][4 * q + 3]};
}
__device__ __forceinline__ void rwkv_out_item(const Ptrs& P, LAS unsigned char* wl, int cid, int h, int lane) {
    const ChunkInfo ci = chunk_info(cid); const int item = cid * 8 + h; const int c32 = lane & 31, hh = lane >> 5;
    const bf16* rs = P.RS() + (size_t)item * 4096; const bf16* rh = P.RRH() + (size_t)item * 4096; const bf16* yi = P.RYI() + (size_t)item * 4096;
#pragma unroll 1
    for (int tb = 0; tb < 2; ++tb) { const int t = 32 * tb + c32;
        bf16x8 bq[4];
#pragma unroll
        for (int s = 0; s < 4; ++s) bq[s] = *(const GAS bf16x8*)(rh + (size_t)t * 64 + 16 * s + 8 * hh);
        f32x16 acc[2]; float sm = 0.f;
#pragma unroll
        for (int vt = 0; vt < 2; ++vt) {
#pragma unroll
            for (int q = 0; q < 4; ++q) { const v2u w = *(const GAS v2u*)(yi + (size_t)t * 64 + 32 * vt + 8 * q + 4 * hh); acc[vt][4 * q] = bflo(w.x); acc[vt][4 * q + 1] = bfhi(w.x); acc[vt][4 * q + 2] = bflo(w.y); acc[vt][4 * q + 3] = bfhi(w.y); }
#pragma unroll
            for (int s = 0; s < 4; ++s) acc[vt] = mfma32(*(const GAS bf16x8*)(rs + (size_t)(32 * vt + c32) * 64 + 16 * s + 8 * hh), bq[s], acc[vt]);
#pragma unroll
            for (int r = 0; r < 16; ++r) sm += acc[vt][r];
        }
        sm += __shfl_xor(sm, 32); const float mean = sm * (1.f / 64.f); float sq = 0.f;
#pragma unroll
        for (int vt = 0; vt < 2; ++vt)
#pragma unroll
            for (int r = 0; r < 16; ++r) { acc[vt][r] -= mean; sq += acc[vt][r] * acc[vt][r]; }
        sq += __shfl_xor(sq, 32); const float rstd = 1.0f / sqrtf(sq * (1.f / 64.f) + GN_EPS);
#pragma unroll
        for (int vt = 0; vt < 2; ++vt)
#pragma unroll
            for (int q = 0; q < 4; ++q) { v2u w; w.x = pk2(acc[vt][4 * q] * rstd, acc[vt][4 * q + 1] * rstd); w.y = pk2(acc[vt][4 * q + 2] * rstd, acc[vt][4 * q + 3] * rstd);
                *(LAS v2u*)(wl + t * 144 + (32 * vt + 8 * q + 4 * hh) * 2) = w; }
    }
    LDS_WAIT(); asm volatile("" ::: "memory");
    {   const int c0 = h * 64 + (lane & 7) * 8;
#pragma unroll 2
        for (int kk = 0; kk < 8; ++kk) { const int row = 8 * kk + (lane >> 3);
            if (row < ci.ntok) { const int m = ci.m0 + row; int t, sb; row_info(m, t, sb);
                float y[8], r[8], k[8], v[8], a[8], g[8];
                unpack8(*(const LAS v4u*)(wl + row * 144 + (lane & 7) * 16), y);
                load_fm8(P, m, t, sb, c0, r); load_fm8(P, m, t, sb, 512 + c0, k); load_fm8(P, m, t, sb, 1024 + c0, v);
                unpack8(*(const GAS v4u*)(P.AA() + (size_t)m * 512 + c0), a); unpack8(*(const GAS v4u*)(P.GA() + (size_t)m * 512 + c0), g);
                float rk = 0.f;
#pragma unroll
                for (int i = 0; i < 8; ++i) rk += r[i] * k[i] * (1.f + (a[i] - 1.f) * P.k_a()[c0 + i]) * P.r_k()[c0 + i];
                rk += __shfl_xor(rk, 1); rk += __shfl_xor(rk, 2); rk += __shfl_xor(rk, 4);
                float o[8];
#pragma unroll
                for (int i = 0; i < 8; ++i) o[i] = (y[i] * P.lnx_w()[c0 + i] + P.lnx_b()[c0 + i] + rk * v[i]) * g[i];
                *(GAS v4u*)(P.XN() + (size_t)m * DM + c0) = pack8(o); } }
    }
    LDS_WAIT(); asm volatile("" ::: "memory");
}
#ifndef MK_N_LAUNCHES
#define MK_N_LAUNCHES 1
#endif
constexpr int PER_PHASE = 16;
constexpr int N_LAUNCHES = MK_N_LAUNCHES;
__global__ void __launch_bounds__(NWAVES * 64, 2) hybrid_fwd(Args args) {
    extern __shared__ __attribute__((aligned(16))) unsigned char lds_raw[];
    LAS unsigned char* lds = (LAS unsigned char*)lds_raw;
    volatile LAS unsigned* MISC = (volatile LAS unsigned*)(lds + MISC_OFF);
    const int tid = threadIdx.x, lane = tid & 63, wave = __builtin_amdgcn_readfirstlane(tid >> 6);
    const int G = gridDim.x; const int bx = blockIdx.x; const int vcu = (G % 8 == 0) ? (bx % 8) * (G / 8) + bx / 8 : bx;
    const int gw = vcu * NWAVES + wave, NGW = G * NWAVES;
    gu32* ctl = (gu32*)(args.ws + WS_CTL);
    for (int u = tid; u < (LDS_BYTES - LDSCTL_OFF) / 4; u += NWAVES * 64) ((LAS unsigned*)(lds + LDSCTL_OFF))[u] = 0u;
    __syncthreads();
    XcdBarrier bar; bar.bar = (unsigned*)(ctl + CW_BAR); bar.x = 0; bar.st = nullptr;
    if (N_LAUNCHES != PER_PHASE) bar = xcd_barrier_post((unsigned*)(ctl + CW_BAR), MISC + 8);
#define GRID_BAR() do { if (N_LAUNCHES != PER_PHASE) xcd_barrier(bar); } while (0)
    const int lo = args.ph_lo, hi = args.ph_hi;
#ifndef PHASE_MASK
#define PHASE_MASK 0xFFFF
#endif
#define IN(k) (((PHASE_MASK >> (k)) & 1) && lo <= (k) && (k) < hi)
#define BOTH(k) (IN(k) && IN((k) + 1))
#define PHASE_PTRS() const __attribute__((address_space(4))) Args* ap_ = (const __attribute__((address_space(4))) Args*)__builtin_amdgcn_kernarg_segment_ptr(); asm volatile("" : "+s"(ap_)); const Ptrs P{ap_}
    if (IN(0)) { PHASE_PTRS(); p0_prologue(P, lds, gw, NGW, wave, lane); if (BOTH(0)) GRID_BAR(); }
    if (IN(1)) { PHASE_PTRS(); pg8::Gemm g{P.XN(), P.Win_t(), MROWS, NPROJ, DM}; pg8::StaticOrder S; S.init(MROWS, NPROJ, G, bx); pg8::EpiBf16P E{P.PROJ(), NPROJ};
        pg8::gemm_phase<pg8::EpiBf16P, pg8::StaticOrder, true, true>(lds + RING_OFF, g, S, E); if (BOTH(1)) GRID_BAR(); }
    if (IN(2)) { PHASE_PTRS(); p2_token_prep(P, gw, NGW, lane); if (BOTH(2)) GRID_BAR(); }
    if (IN(3)) { PHASE_PTRS(); pg8::Gemm g{P.LIN(), P.Wlora_t(), MROWS, NLORA, KLORA}; pg8::StaticOrder S; S.init(MROWS, NLORA, G, bx); pg8::EpiLora E{P.XA(), (WS_AA - WS_XA) / 2, P.w0(), P.a0()}; static_assert(WS_GA - WS_AA == WS_AA - WS_XA, "x|a|g spacing");
        pg8::gemm_phase<pg8::EpiLora, pg8::StaticOrder, true, true>(lds + RING_OFF, g, S, E); if (BOTH(3)) GRID_BAR(); }
    if (IN(4)) { PHASE_PTRS(); for (int it = vcu; it < NITEM_R; it += G) rwkv_prep_item(P, lds, it >> 3, it & 7, tid); if (BOTH(4)) GRID_BAR(); }
    if (IN(5)) { PHASE_PTRS();
        if (vcu < 32) { if (wave < 2) { const int b = vcu >> 3, h = vcu & 7; rwkv_serial_job(P, b * 128 * 8 + h, 8, 128, nullptr, P.out() + O_WKV_P + ((size_t)b * 8 + h) * 4096, wave, lane); } }
        else if (vcu < 64) { const int j = (vcu - 32) * 4 + (wave >> 1), sb = j >> 3, h = j & 7; rwkv_serial_job(P, (512 + sb) * 8 + h, 8, 1, P.swkv() + ((size_t)sb * 8 + h) * 4096, P.out() + O_WKV_S + ((size_t)sb * 8 + h) * 4096, wave & 1, lane); }
        if (BOTH(5)) GRID_BAR(); }
    if (IN(6)) { PHASE_PTRS(); for (int it = gw; it < NITEM_R; it += NGW) rwkv_out_item(P, lds + wave * 9216, it >> 3, it & 7, lane); copy_state_rows(P, gw, NGW, lane); if (BOTH(6)) GRID_BAR(); }
    if (IN(7)) { PHASE_PTRS(); for (int it = vcu; it < NITEM_G; it += G) gdn_prep_item(P, lds, it >> 2, it & 3, tid); if (BOTH(7)) GRID_BAR(); }
    if (IN(8)) { PHASE_PTRS(); const int j = vcu;
        if (j < 16) { const int b = j >> 2, h = j & 3; gdn_serial_job(P, lds, b * 128 * 4 + h, 4, 128, nullptr, P.out() + O_GDN_P + ((size_t)b * 4 + h) * 16384, tid); }
        else if (j < 80) { const int sb = (j - 16) >> 2, h = (j - 16) & 3; gdn_serial_job(P, lds, (512 + sb) * 4 + h, 4, 1, P.sgdn() + ((size_t)sb * 4 + h) * 16384, P.out() + O_GDN_S + ((size_t)sb * 4 + h) * 16384, tid); }
        if (BOTH(8)) GRID_BAR(); }
    if (IN(9)) { PHASE_PTRS(); for (int it = gw; it < NITEM_G; it += NGW) gdn_out_item(P, lds + wave * 17408, it >> 2, it & 3, lane);
        for (int m = gw; m < MROWS; m += NGW) { const float* pr = m < MP ? P.pp_() + (size_t)m * DPLE : P.ps_() + (size_t)(m - MP) * DPLE; const f32x4 pv = *(const f32x4*)(pr + 4 * lane);
            *(GAS unsigned long long*)(P.PB() + (size_t)m * DPLE + 4 * lane) = (unsigned long long)pk2(pv.x, pv.y) | ((unsigned long long)pk2(pv.z, pv.w) << 32); }
        if (BOTH(9)) GRID_BAR(); }
    if (IN(10)) { PHASE_PTRS(); pg8::Gemm g{P.XN(), P.Wout_t(), MROWS, DM, DM}; pg8::StaticOrder S; S.init(MROWS, DM, G, bx); pg8::EpiRes E{P.xp(), P.xs(), P.out(), P.PROJ(), P.SSQ2(), MP};
        pg8::gemm_phase<pg8::EpiRes, pg8::StaticOrder, true, true>(lds + RING_OFF, g, S, E); if (BOTH(10)) GRID_BAR(); }
    if (IN(11)) { PHASE_PTRS(); pg8::Gemm g{P.PROJ(), P.Wgu_t(), MROWS, NGU, DM}; pg8::StaticOrder S; S.init(MROWS, NGU, G, bx); pg8::EpiSwiGLU E{P.ACT(), P.SSQ2()};
        pg8::gemm_phase<pg8::EpiSwiGLU, pg8::StaticOrder, true, true>(lds + RING_OFF, g, S, E); if (BOTH(11)) GRID_BAR(); }
    if (IN(12)) { PHASE_PTRS(); pg8::Gemm g{P.ACT(), P.Wdown_t(), MROWS, DM, DFF}; pg8::StaticOrder S; S.init(MROWS, DM, G, bx); pg8::EpiRes E{P.out(), P.out() + (size_t)MP * DM, P.out(), P.XN(), P.SSQ3(), MP};
        pg8::gemm_phase<pg8::EpiRes, pg8::StaticOrder, true, true>(lds + RING_OFF, g, S, E); if (BOTH(12)) GRID_BAR(); }
    if (IN(13)) { PHASE_PTRS(); pg8::Gemm g{P.PB(), P.Wpp_t(), MROWS, DM, DPLE}; pg8::StaticOrder S; S.init(MROWS, DM, G, bx); pg8::EpiBf16P E{P.PP(), DM};
        pg8::gemm_phase<pg8::EpiBf16P, pg8::StaticOrder, true, true>(lds + RING_OFF, g, S, E); if (BOTH(13)) GRID_BAR(); }
    if (IN(14)) { PHASE_PTRS(); pg8::Gemm g{P.XN(), P.Wpg_t(), MROWS, DM, DM}; pg8::StaticOrder S; S.init(MROWS, DM, G, bx); pg8::EpiPle E{P.out(), P.PP(), P.SSQ3()};
        pg8::gemm_phase<pg8::EpiPle, pg8::StaticOrder, true, true>(lds + RING_OFF, g, S, E); if (BOTH(14)) GRID_BAR(); }
    if (IN(15)) { PHASE_PTRS(); p_final_norm(P, gw, NGW, lane); }
#undef IN
#undef BOTH
}

extern "C" void kernel_launch(void* const* d_in, const int* in_sizes, int n_in, void* d_out, int out_size, void* d_ws, size_t ws_size, hipStream_t stream) {
    static int grid = 0;
    if (grid == 0) {
        if (n_in != 34 || in_sizes[0] != MP * DM || (size_t)out_size != O_END || ws_size < WS_END) { fprintf(stderr, "kernel_launch: unexpected shapes: n_in %d in0 %d out %d ws %zu (need %zu)\n", n_in, n_in > 0 ? in_sizes[0] : -1, out_size, ws_size, (size_t)WS_END); grid = -1; return; }
        int dev = 0, cus = 0, per_cu = 0;
        if (hipGetDevice(&dev) != hipSuccess || hipDeviceGetAttribute(&cus, hipDeviceAttributeMultiprocessorCount, dev) != hipSuccess) { grid = -1; return; }
        if (hipFuncSetAttribute((const void*)hybrid_fwd, hipFuncAttributeMaxDynamicSharedMemorySize, LDS_BYTES) != hipSuccess) { fprintf(stderr, "kernel_launch: hipFuncSetAttribute failed\n"); grid = -1; return; }
        if (hipOccupancyMaxActiveBlocksPerMultiprocessor(&per_cu, (const void*)hybrid_fwd, NWAVES * 64, LDS_BYTES) != hipSuccess || per_cu < 1) fprintf(stderr, "kernel_launch: occupancy query reports %d\n", per_cu);
        (void)hipGetLastError();
        grid = cus;
    }
    if (grid < 0) return;
    if (hipMemsetAsync((char*)d_ws + WS_CTL, 0, CTL_ZERO_BYTES, stream) != hipSuccess) { fprintf(stderr, "kernel_launch: memset failed\n"); return; }
    Args a{};
    for (int i = 0; i < 34; ++i) a.in[i] = (const float*)d_in[i];
    a.out = (float*)d_out; a.ws = (unsigned char*)d_ws;
    for (int li = 0; li < N_LAUNCHES; ++li) {
        a.ph_lo = (N_LAUNCHES == PER_PHASE) ? li : 0; a.ph_hi = (N_LAUNCHES == PER_PHASE) ? li + 1 : PER_PHASE;
        hipLaunchKernelGGL(hybrid_fwd, dim3(grid), dim3(NWAVES * 64), LDS_BYTES, stream, a);
        const hipError_t le = hipPeekAtLastError();
        if (le != hipSuccess) { fprintf(stderr, "kernel_launch: launch %d failed: %s\n", li, hipGetErrorName(le)); break; }
    }
}
```

```cpp
#include <hip/hip_runtime.h>
#include <cstdio>
#include <cstdint>
namespace pg8 {
#define PG8_LAS __attribute__((address_space(3)))
typedef unsigned short bf16_t;
typedef short bf16x8 __attribute__((ext_vector_type(8)));
typedef float f32x4 __attribute__((ext_vector_type(4)));
typedef unsigned u32x4 __attribute__((ext_vector_type(4)));
constexpr int BM = 256, BK = 64, HALF = 128, HTB = HALF * BK * 2  , STAGE_BYTES = 8 * HTB, NXCD = 8, WGM = 8;

__host__ __device__ __forceinline__ int lds_byte(int r, int c) { const int st = (r >> 4) * 2 + (c >> 5), rr = r & 15, cc = c & 31, ob = rr * 64 + cc * 2; return st * 1024 + (ob ^ (((ob >> 9) & 1) << 5)); }
__host__ __device__ __forceinline__ void stage_rc(int b, int& R, int& C) { const int st = b / 1024, sb = b % 1024, swz = sb ^ (((sb >> 9) & 1) << 5); R = (st >> 1) * 16 + swz / 64; C = (st & 1) * 32 + (swz % 64) / 2; }
__host__ __device__ __forceinline__ int perm32(int rho) { const int n = rho >> 4, i = rho & 15; return 8 * (i >> 2) + 4 * n + (i & 3); }

struct Unit { int pm, pn; };
struct Gemm { const bf16_t* A; const bf16_t* Bt; int M, N, K; };

struct StaticOrder {
    int nM, nN, nwg, G, c;
    __host__ __device__ void init(int M, int N, int G_, int c_) { nM = M / BM; nN = N / BM; nwg = nM * nN; G = G_; c = c_; }
    __host__ __device__ bool next(int i, Unit& u) const {
        const long L = (long)i * G + c; if (L >= nwg) return false;
        int wgid = (int)L; { const int q = nwg / NXCD, r = nwg % NXCD, xcd = wgid % NXCD, off = wgid / NXCD; wgid = (xcd < r ? xcd * (q + 1) : r * (q + 1) + (xcd - r) * q) + off; }
        const int nig = WGM * nN, gid = wgid / nig, fm = gid * WGM, gsz = (nM - fm) < WGM ? (nM - fm) : WGM;
        u.pm = fm + ((wgid % nig) % gsz); u.pn = (wgid % nig) / gsz; return true;
    }
    __device__ __forceinline__ void a_ready(const Unit&) const {}
    __device__ __forceinline__ void done(const Unit&) const {}
};

__device__ __forceinline__ unsigned cvt_pk_bf16(float lo, float hi) { unsigned r; asm volatile("v_cvt_pk_bf16_f32 %0, %1, %2" : "=v"(r) : "v"(lo), "v"(hi)); return r; }
typedef float f32x2 __attribute__((ext_vector_type(2)));
__device__ __forceinline__ float fsigmoid(float x) { return __builtin_amdgcn_rcpf(1.f + __builtin_amdgcn_exp2f(-1.44269504f * x)); }
struct EpiBf16P {
    static constexpr bool PERM = true, AFTER_DRAIN = false;
    bf16_t* O; int ldc;
    __device__ __forceinline__ void operator()(const f32x4 (&acc)[2][2][4][2], const Unit& u, int wr, int wc, int fr, int fq) const {
        const int row0 = u.pm * BM + wr * 64 + fr, col0 = u.pn * BM + wc * 32 + 8 * fq;
#pragma unroll
        for (int ai = 0; ai < 2; ++ai)
#pragma unroll
            for (int m = 0; m < 4; ++m) { bf16_t* rowp = O + (size_t)(row0 + ai * HALF + m * 16) * ldc + col0;
#pragma unroll
                for (int bj = 0; bj < 2; ++bj) { const f32x4 v0 = acc[ai][bj][m][0], v1 = acc[ai][bj][m][1];
                    u32x4 w; w.x = cvt_pk_bf16(v0[0], v0[1]); w.y = cvt_pk_bf16(v0[2], v0[3]); w.z = cvt_pk_bf16(v1[0], v1[1]); w.w = cvt_pk_bf16(v1[2], v1[3]);
                    *(u32x4*)(rowp + bj * HALF) = w; } }
    }
};
struct EpiRes {
    static constexpr bool PERM = true, AFTER_DRAIN = false;
    const float* base_p; const float* base_s; float* out; bf16_t* ob; float* ssq; int msplit;
    __device__ __forceinline__ void operator()(const f32x4 (&acc)[2][2][4][2], const Unit& u, int wr, int wc, int fr, int fq) const {
        const int row0 = u.pm * BM + wr * 64 + fr, col0 = u.pn * BM + wc * 32 + 8 * fq;
#pragma unroll
        for (int ai = 0; ai < 2; ++ai)
#pragma unroll
            for (int m = 0; m < 4; ++m) { const int r = row0 + ai * HALF + m * 16;
                const float* bp = (r < msplit ? base_p + (size_t)r * 1024 : base_s + (size_t)(r - msplit) * 1024) + col0;
                float* op = out + (size_t)r * 1024 + col0; bf16_t* obp = ob + (size_t)r * 1024 + col0; float s = 0.f;
#pragma unroll
                for (int bj = 0; bj < 2; ++bj) { const f32x4 b0 = *(const f32x4*)(bp + bj * HALF), b1 = *(const f32x4*)(bp + bj * HALF + 4);
                    const f32x4 v0 = acc[ai][bj][m][0] + b0, v1 = acc[ai][bj][m][1] + b1;
                    *(f32x4*)(op + bj * HALF) = v0; *(f32x4*)(op + bj * HALF + 4) = v1;
                    u32x4 w; w.x = cvt_pk_bf16(v0[0], v0[1]); w.y = cvt_pk_bf16(v0[2], v0[3]); w.z = cvt_pk_bf16(v1[0], v1[1]); w.w = cvt_pk_bf16(v1[2], v1[3]);
                    *(u32x4*)(obp + bj * HALF) = w;
                    s += (v0[0] * v0[0] + v0[1] * v0[1]) + (v0[2] * v0[2] + v0[3] * v0[3]) + (v1[0] * v1[0] + v1[1] * v1[1]) + (v1[2] * v1[2] + v1[3] * v1[3]); }
                s += __shfl_xor(s, 16); s += __shfl_xor(s, 32);
                if (fq == 0) ssq[(size_t)r * 16 + u.pn * 4 + wc] = s; }
    }
};
__device__ __forceinline__ float row_rstd16(const float* ssq, int r, int fq) {
    const f32x4 p = *(const f32x4*)(ssq + (size_t)r * 16 + 4 * fq); float s = (p[0] + p[1]) + (p[2] + p[3]);
    s += __shfl_xor(s, 16); s += __shfl_xor(s, 32); return __builtin_amdgcn_rsqf(s * (1.0f / 1024.0f) + 1e-6f);
}
struct EpiSwiGLU {
    static constexpr bool PERM = false, AFTER_DRAIN = false;
    bf16_t* O; const float* ssq;
    __device__ __forceinline__ void operator()(const f32x4 (&acc)[2][2][4][2], const Unit& u, int wr, int wc, int fr, int fq) const {
        const int row0 = u.pm * BM + wr * 64 + fr, col0 = u.pn * 128 + wc * 32 + 8 * fq;
#pragma unroll
        for (int ai = 0; ai < 2; ++ai)
#pragma unroll
            for (int m = 0; m < 4; ++m) { const int r = row0 + ai * HALF + m * 16; const float rs = row_rstd16(ssq, r, fq);
                float o[8];
#pragma unroll
                for (int bj = 0; bj < 2; ++bj)
#pragma unroll
                    for (int j = 0; j < 4; ++j) { const float g = acc[ai][bj][m][0][j] * rs, up = acc[ai][bj][m][1][j] * rs; o[4 * bj + j] = g * fsigmoid(g) * up; }
                u32x4 w; w.x = cvt_pk_bf16(o[0], o[1]); w.y = cvt_pk_bf16(o[2], o[3]); w.z = cvt_pk_bf16(o[4], o[5]); w.w = cvt_pk_bf16(o[6], o[7]);
                *(u32x4*)(O + (size_t)r * 2816 + col0) = w; }
    }
};
struct EpiPle {
    static constexpr bool PERM = true, AFTER_DRAIN = false;
    float* io; const bf16_t* pp; const float* ssq;
    __device__ __forceinline__ void operator()(const f32x4 (&acc)[2][2][4][2], const Unit& u, int wr, int wc, int fr, int fq) const {
        const int row0 = u.pm * BM + wr * 64 + fr, col0 = u.pn * BM + wc * 32 + 8 * fq;
#pragma unroll
        for (int ai = 0; ai < 2; ++ai)
#pragma unroll
            for (int m = 0; m < 4; ++m) { const int r = row0 + ai * HALF + m * 16; const float rs = row_rstd16(ssq, r, fq);
                float* op = io + (size_t)r * 1024 + col0; const bf16_t* ppp = pp + (size_t)r * 1024 + col0;
#pragma unroll
                for (int bj = 0; bj < 2; ++bj) { const f32x4 b0 = *(const f32x4*)(op + bj * HALF), b1 = *(const f32x4*)(op + bj * HALF + 4); const u32x4 pw = *(const u32x4*)(ppp + bj * HALF);
                    f32x4 v0, v1;
                    v0[0] = b0[0] + fsigmoid(acc[ai][bj][m][0][0] * rs) * __uint_as_float(pw.x << 16); v0[1] = b0[1] + fsigmoid(acc[ai][bj][m][0][1] * rs) * __uint_as_float(pw.x & 0xffff0000u);
                    v0[2] = b0[2] + fsigmoid(acc[ai][bj][m][0][2] * rs) * __uint_as_float(pw.y << 16); v0[3] = b0[3] + fsigmoid(acc[ai][bj][m][0][3] * rs) * __uint_as_float(pw.y & 0xffff0000u);
                    v1[0] = b1[0] + fsigmoid(acc[ai][bj][m][1][0] * rs) * __uint_as_float(pw.z << 16); v1[1] = b1[1] + fsigmoid(acc[ai][bj][m][1][1] * rs) * __uint_as_float(pw.z & 0xffff0000u);
                    v1[2] = b1[2] + fsigmoid(acc[ai][bj][m][1][2] * rs) * __uint_as_float(pw.w << 16); v1[3] = b1[3] + fsigmoid(acc[ai][bj][m][1][3] * rs) * __uint_as_float(pw.w & 0xffff0000u);
                    *(f32x4*)(op + bj * HALF) = v0; *(f32x4*)(op + bj * HALF + 4) = v1; } }
    }
};
struct EpiLora {
    static constexpr bool PERM = true, AFTER_DRAIN = false;
    bf16_t* XA; size_t part_stride; const float* w0; const float* a0;
    __device__ __forceinline__ void operator()(const f32x4 (&acc)[2][2][4][2], const Unit& u, int wr, int wc, int fr, int fq) const {
        const int row0 = u.pm * BM + wr * 64 + fr; const int part = u.pn >> 1; const int col0 = (u.pn & 1) * BM + wc * 32 + 8 * fq;
        bf16_t* O = XA + (size_t)part * part_stride; const float* bias = part == 0 ? w0 : a0;
        f32x4 bv[2][2];
#pragma unroll
        for (int bj = 0; bj < 2; ++bj)
#pragma unroll
            for (int n = 0; n < 2; ++n) bv[bj][n] = part < 2 ? *(const f32x4*)(bias + col0 + bj * HALF + 4 * n) : (f32x4){0.f, 0.f, 0.f, 0.f};
#pragma unroll
        for (int ai = 0; ai < 2; ++ai)
#pragma unroll
            for (int m = 0; m < 4; ++m) { bf16_t* rowp = O + (size_t)(row0 + ai * HALF + m * 16) * 512 + col0;
#pragma unroll
                for (int bj = 0; bj < 2; ++bj) { const f32x4 v0 = acc[ai][bj][m][0] + bv[bj][0], v1 = acc[ai][bj][m][1] + bv[bj][1];
                    float o[8] = {v0[0], v0[1], v0[2], v0[3], v1[0], v1[1], v1[2], v1[3]};
                    if (part == 0) {
#pragma unroll
                        for (int j = 0; j < 8; ++j) { const float z = -o[j]; const float sp = fmaxf(z, 0.f) + __logf(1.f + __expf(-fabsf(z))); o[j] = __expf(-sp - 0.5f); } }
                    else if (part == 1) {
#pragma unroll
                        for (int j = 0; j < 8; ++j) o[j] = fsigmoid(o[j]); }
                    u32x4 w; w.x = cvt_pk_bf16(o[0], o[1]); w.y = cvt_pk_bf16(o[2], o[3]); w.z = cvt_pk_bf16(o[4], o[5]); w.w = cvt_pk_bf16(o[6], o[7]);
                    *(u32x4*)(rowp + bj * HALF) = w; }
                __builtin_amdgcn_sched_barrier(0); }
    }
};

template <class Epi, class Sched, bool ALIGN_EPI = false, bool SP2 = false>
__device__ __forceinline__ void gemm_phase(PG8_LAS unsigned char* lds, const Gemm g, const Sched& S, const Epi& E) {
    const int tid = threadIdx.x, wid = __builtin_amdgcn_readfirstlane(tid >> 6), lane = tid & 63, wr = wid >> 2, wc = wid & 3, fr = lane & 15, fq = lane >> 4;
    int K_ = g.K; asm volatile("" : "+s"(K_)); const int K = K_, nt = K / BK;
    unsigned voffA[2], voffB[2];
#pragma unroll
    for (int i = 0; i < 2; ++i) { int R, C; stage_rc(tid * 16 + i * 8192, R, C); const int Rb = Epi::PERM ? ((R & ~31) + perm32(R & 31)) : R;
        voffA[i] = (unsigned)(R * K + C) * 2u; voffB[i] = (unsigned)(Rb * K + C) * 2u; }
    const size_t kstep = (size_t)(BK * 2);
    const size_t hstep = (size_t)HALF * K * 2;
    const size_t tstep = 2 * hstep;
    const unsigned ldsw = (unsigned)wid * 1024u;
    const int aoff = lds_byte(wr * 64 + fr, fq * 8), boff = lds_byte(wc * 32 + fr, fq * 8);
#define PG8_SA(b, h) (((b) * 2 + (h)) * HTB)
#define PG8_SB(b, h) ((4 + (b) * 2 + (h)) * HTB)
#define PG8_STAGE(bufoff, gbase, voff) do { _Pragma("unroll") for (int _i = 0; _i < 2; ++_i) \
        __builtin_amdgcn_global_load_lds((const unsigned*)((const char*)(gbase) + (voff)[_i]), (PG8_LAS unsigned*)(lds + (bufoff) + ldsw + _i * 8192), 16, 0, 0); } while (0)
#define PG8_LDA(dst, b, h) do { _Pragma("unroll") for (int m = 0; m < 4; ++m) _Pragma("unroll") for (int k = 0; k < 2; ++k) dst[m][k] = *(const PG8_LAS bf16x8*)(lds + PG8_SA(b, h) + aoff + m * 2048 + k * 1024); } while (0)
#define PG8_LDB(dst, b, h) do { _Pragma("unroll") for (int n = 0; n < 2; ++n) _Pragma("unroll") for (int k = 0; k < 2; ++k) dst[n][k] = *(const PG8_LAS bf16x8*)(lds + PG8_SB(b, h) + boff + n * 2048 + k * 1024); } while (0)
#define PG8_MMA(ai, bj, At, Bt) do { __builtin_amdgcn_s_setprio(1); _Pragma("unroll") for (int m = 0; m < 4; ++m) _Pragma("unroll") for (int n = 0; n < 2; ++n) _Pragma("unroll") for (int k = 0; k < 2; ++k) \
        acc[ai][bj][m][n] = __builtin_amdgcn_mfma_f32_16x16x32_bf16(Bt[n][k], At[m][k], acc[ai][bj][m][n], 0, 0, 0); __builtin_amdgcn_s_setprio(0); } while (0)
#define PG8_WAIT_V(n) asm volatile("s_waitcnt vmcnt(" #n ")" ::: "memory")
#define PG8_WAIT_L(n) asm volatile("s_waitcnt lgkmcnt(" #n ")" ::: "memory")
#define PG8_BAR __builtin_amdgcn_s_barrier()
#define PG8_SCHED __builtin_amdgcn_sched_barrier(0)
    Unit cur, nxt; int ui = 0;
    if (!S.next(0, cur)) return;
    f32x4 acc[2][2][4][2];
#pragma unroll
    for (int a = 0; a < 2; ++a)
#pragma unroll
        for (int b = 0; b < 2; ++b)
#pragma unroll
            for (int m = 0; m < 4; ++m)
#pragma unroll
                for (int n = 0; n < 2; ++n) acc[a][b][m][n] = (f32x4){0.f, 0.f, 0.f, 0.f};
    bf16x8 At[4][2], B0[2][2], B1[2][2];
    const char* cA = (const char*)g.A + (size_t)cur.pm * tstep; const char* cB = (const char*)g.Bt + (size_t)cur.pn * tstep;
    S.a_ready(cur);
    if constexpr (SP2) {
        PG8_STAGE(PG8_SB(0, 0), cB, voffB); PG8_STAGE(PG8_SB(0, 1), cB + hstep, voffB); PG8_STAGE(PG8_SA(0, 0), cA, voffA); PG8_STAGE(PG8_SA(0, 1), cA + hstep, voffA);
        if (wr == 1) PG8_BAR;
        PG8_WAIT_V(2); PG8_BAR;
        PG8_STAGE(PG8_SB(1, 0), cB + kstep, voffB); PG8_STAGE(PG8_SA(1, 0), cA + kstep, voffA); PG8_STAGE(PG8_SB(1, 1), cB + hstep + kstep, voffB);
        PG8_WAIT_V(6); PG8_BAR;
    } else {
        PG8_STAGE(PG8_SB(0, 0), cB, voffB); PG8_STAGE(PG8_SA(0, 0), cA, voffA); PG8_STAGE(PG8_SB(0, 1), cB + hstep, voffB); PG8_STAGE(PG8_SA(0, 1), cA + hstep, voffA);
        if (wr == 1) PG8_BAR;
        PG8_WAIT_V(4); PG8_BAR;
        PG8_STAGE(PG8_SB(1, 0), cB + kstep, voffB); PG8_STAGE(PG8_SA(1, 0), cA + kstep, voffA); PG8_STAGE(PG8_SB(1, 1), cB + hstep + kstep, voffB);
        PG8_WAIT_V(6); PG8_BAR;
    }
    for (;;) {
        const bool has_next = S.next(ui + 1, nxt);
        const char* nA = has_next ? (const char*)g.A + (size_t)nxt.pm * tstep : cA; const char* nB = has_next ? (const char*)g.Bt + (size_t)nxt.pn * tstep : cB;
        for (int t = 0; t < nt; t += 2) {
            const bool last = (t == nt - 2);
            const char* a1 = cA + (size_t)(t + 1) * kstep;
            const char* a2 = last ? nA : cA + (size_t)(t + 2) * kstep; const char* b2 = last ? nB : cB + (size_t)(t + 2) * kstep;
            const char* a3 = a2 + kstep; const char* b3 = b2 + kstep;
            if (last && has_next) S.a_ready(nxt);
            if constexpr (SP2) {
            PG8_LDB(B0, 0, 0); PG8_LDB(B1, 0, 1); PG8_SCHED; PG8_LDA(At, 0, 0); PG8_STAGE(PG8_SA(1, 1), a1 + hstep, voffA);
            PG8_WAIT_V(8); PG8_WAIT_L(0); PG8_BAR; PG8_MMA(0, 0, At, B0); PG8_MMA(0, 1, At, B1); PG8_BAR; PG8_SCHED;
            PG8_LDA(At, 0, 1); PG8_STAGE(PG8_SB(0, 0), b2, voffB); PG8_STAGE(PG8_SB(0, 1), b2 + hstep, voffB); PG8_STAGE(PG8_SA(0, 0), a2, voffA);
            PG8_WAIT_V(8); PG8_WAIT_L(0); PG8_BAR; PG8_MMA(1, 0, At, B0); PG8_MMA(1, 1, At, B1); PG8_BAR; PG8_SCHED;
            PG8_LDB(B0, 1, 0); PG8_LDB(B1, 1, 1); PG8_SCHED; PG8_LDA(At, 1, 0); PG8_STAGE(PG8_SA(0, 1), a2 + hstep, voffA);
            PG8_WAIT_V(8); PG8_WAIT_L(0); PG8_BAR; PG8_MMA(0, 0, At, B0); PG8_MMA(0, 1, At, B1); PG8_BAR; PG8_SCHED;
            PG8_LDA(At, 1, 1); PG8_STAGE(PG8_SB(1, 0), b3, voffB); PG8_STAGE(PG8_SB(1, 1), b3 + hstep, voffB); PG8_STAGE(PG8_SA(1, 0), a3, voffA);
            PG8_WAIT_V(8); PG8_WAIT_L(0); PG8_BAR; PG8_MMA(1, 0, At, B0); PG8_MMA(1, 1, At, B1); PG8_BAR; PG8_SCHED;
            } else {
            PG8_LDB(B0, 0, 0); PG8_SCHED; PG8_LDA(At, 0, 0); PG8_STAGE(PG8_SA(1, 1), a1 + hstep, voffA);
            PG8_WAIT_L(8); PG8_BAR; PG8_WAIT_L(0); PG8_MMA(0, 0, At, B0); PG8_BAR; PG8_SCHED;
            PG8_LDB(B1, 0, 1); PG8_STAGE(PG8_SB(0, 0), b2, voffB);
            PG8_BAR; PG8_WAIT_L(0); PG8_MMA(0, 1, At, B1); PG8_BAR;
            PG8_LDA(At, 0, 1); PG8_STAGE(PG8_SA(0, 0), a2, voffA);
            PG8_BAR; PG8_WAIT_L(0); PG8_MMA(1, 0, At, B0); PG8_BAR; PG8_SCHED;
            PG8_STAGE(PG8_SB(0, 1), b2 + hstep, voffB);
            PG8_WAIT_V(6); PG8_BAR; PG8_MMA(1, 1, At, B1); PG8_BAR;
            PG8_LDB(B0, 1, 0); PG8_SCHED; PG8_LDA(At, 1, 0); PG8_STAGE(PG8_SA(0, 1), a2 + hstep, voffA);
            PG8_WAIT_L(8); PG8_BAR; PG8_WAIT_L(0); PG8_MMA(0, 0, At, B0); PG8_BAR; PG8_SCHED;
            PG8_LDB(B1, 1, 1); PG8_STAGE(PG8_SB(1, 0), b3, voffB);
            PG8_BAR; PG8_WAIT_L(0); PG8_MMA(0, 1, At, B1); PG8_BAR;
            PG8_LDA(At, 1, 1); PG8_STAGE(PG8_SA(1, 0), a3, voffA);
            PG8_BAR; PG8_WAIT_L(0); PG8_MMA(1, 0, At, B0); PG8_BAR; PG8_SCHED;
            PG8_STAGE(PG8_SB(1, 1), b3 + hstep, voffB);
            PG8_WAIT_V(6); PG8_BAR; PG8_MMA(1, 1, At, B1); PG8_BAR;
            }
        }
        if constexpr (ALIGN_EPI) { if (wr == 0) PG8_BAR; }
        if constexpr (!Epi::AFTER_DRAIN) { E(acc, cur, wr, wc, fr, fq); S.done(cur); }
        if (!has_next) break;
#pragma unroll
        for (int a = 0; a < 2; ++a)
#pragma unroll
            for (int b = 0; b < 2; ++b)
#pragma unroll
                for (int m = 0; m < 4; ++m)
#pragma unroll
                    for (int n = 0; n < 2; ++n) acc[a][b][m][n] = (f32x4){0.f, 0.f, 0.f, 0.f};
        cur = nxt; cA = nA; cB = nB; ++ui;
        if constexpr (ALIGN_EPI) { if (wr == 1) PG8_BAR; }
    }
    PG8_WAIT_V(0);
    if constexpr (!ALIGN_EPI) { if (wr == 0) PG8_BAR; }
    PG8_BAR;
    if constexpr (Epi::AFTER_DRAIN) { E.fused(acc, cur, wr, wc, fr, fq, lds, wid, lane); S.done(cur); }
#undef PG8_SA
#undef PG8_SB
#undef PG8_STAGE
#undef PG8_LDA
#undef PG8_LDB
#undef PG8_MMA
#undef PG8_WAIT_V
#undef PG8_WAIT_L
#undef PG8_BAR
#undef PG8_SCHED
}
}
using bf16 = unsigned short;
constexpr int NWAVES = 8;
constexpr int DM = 1024, MP = 32768, MS = 256, MROWS = MP + MS, SEQL = 8192, SSL = 16;
constexpr int NPROJ = 3840, DIN = 3848, RPROJ = 1792, OFF_QKV = 1792, OFF_Z = 3328, DFF = 2816, NGU = 5632, DPLE = 256, NLORA = 1536, KLORA = 256;
constexpr int GQ = 1536;
constexpr float RMS_EPS = 1e-6f, GN_EPS = 64e-5f;
constexpr size_t O_Y = 0, O_SHIFT_P = (size_t)MROWS * DM, O_WKV_P = O_SHIFT_P + 4 * 1792, O_CONV_P = O_WKV_P + 4 * 8 * 4096, O_GDN_P = O_CONV_P + 4 * 3 * 1536,
                 O_SHIFT_S = O_GDN_P + 4 * 4 * 16384, O_WKV_S = O_SHIFT_S + 16 * 1792, O_CONV_S = O_WKV_S + 16 * 8 * 4096, O_GDN_S = O_CONV_S + 16 * 3 * 1536, O_END = O_GDN_S + 16 * 4 * 16384;
static_assert(O_END == 35910656, "d_out size");
constexpr size_t MiB = 1u << 20;
constexpr size_t WS_CTL = 0, CTL_ZERO_BYTES = 1 * MiB;
constexpr size_t WS_WIN = 2 * MiB, WS_WOUT = 10 * MiB, WS_WGU = 12 * MiB, WS_WDOWN = 23 * MiB, WS_WPG = 29 * MiB, WS_WPP = 31 * MiB, WS_WLORA = 31 * MiB + 512 * 1024;
constexpr size_t WS_XN = 33 * MiB;
constexpr size_t WS_PROJ = 98 * MiB;
constexpr size_t WS_ACT = 163 * MiB;
constexpr size_t WS_BIG = 340 * MiB;
constexpr size_t WS_XA = WS_BIG, WS_AA = WS_BIG + 33 * MiB, WS_GA = WS_BIG + 66 * MiB;
constexpr size_t WS_LIN = WS_BIG + 99 * MiB;
constexpr size_t WS_RYI = WS_BIG + 99 * MiB, WS_RS = WS_BIG + 132 * MiB;
constexpr size_t WS_RN = WS_BIG + 166 * MiB, WS_BA = WS_BIG + 168 * MiB;
constexpr size_t WS_GNT = WS_BIG, WS_GOI = WS_BIG + 66 * MiB, WS_GS = WS_BIG + 99 * MiB;
constexpr size_t WS_PB = WS_BIG + 1 * MiB;
constexpr size_t WS_SSQ2 = WS_BIG + 20 * MiB, WS_SSQ3 = WS_BIG + 23 * MiB, WS_SSQS2 = WS_BIG + 26 * MiB, WS_SSQS3 = WS_BIG + 27 * MiB, WS_PP = WS_BIG + 30 * MiB;
constexpr size_t WS_END = 512 * MiB;
static_assert(WS_PROJ + (size_t)MROWS * NPROJ * 2 <= WS_BIG && WS_ACT + (size_t)MROWS * DFF * 2 <= WS_PB && WS_XN + (size_t)MROWS * DM * 2 <= WS_PROJ && WS_PROJ + (size_t)MROWS * DM * 2 <= WS_ACT, "ws map");
static_assert(WS_RS + (size_t)4224 * 8192 <= WS_RN && WS_RYI + (size_t)4224 * 8192 <= WS_RS && WS_LIN + (size_t)MROWS * 256 * 2 <= WS_RN && (size_t)3 * 4224 * 8192 <= (size_t)MROWS * DM * 4 && WS_XA + (size_t)MROWS * 512 * 2 <= WS_AA && WS_GA + (size_t)MROWS * 512 * 2 <= WS_LIN && WS_BA + (size_t)MROWS * 32 <= WS_END, "ws map 2");
static_assert(WS_GS + (size_t)2112 * 32768 <= WS_RN && WS_GNT + (size_t)2112 * 32768 <= WS_GOI && WS_GOI + (size_t)2112 * 16384 <= WS_GS && WS_PP + (size_t)MROWS * DM * 2 <= WS_END && WS_PB + (size_t)MROWS * 512 <= WS_SSQ2, "ws map 3");
static_assert((size_t)2112 * (32768 + 16384) <= (size_t)MROWS * DM * 4, "GM + GQH fit in the y region of d_out");
constexpr int CW_BAR = 4096;
constexpr int RING_OFF = 0, RING_BYTES = 131072;
constexpr int LDS_BYTES = 147456;
constexpr int LDSCTL_OFF = LDS_BYTES - 512, MISC_OFF = LDSCTL_OFF + 320;
#define GAS __attribute__((address_space(1)))
#define LAS __attribute__((address_space(3)))
typedef unsigned v4u __attribute__((ext_vector_type(4)));
typedef float f32x4 __attribute__((ext_vector_type(4)));
typedef short bf16x8 __attribute__((ext_vector_type(8)));
typedef GAS unsigned gu32;
typedef GAS unsigned long long gu64;
#define RLX_AGENT __ATOMIC_RELAXED, __HIP_MEMORY_SCOPE_AGENT
#define LDS_WAIT() asm volatile("s_waitcnt lgkmcnt(0)" ::: "memory")
#define VM_WAIT() asm volatile("s_waitcnt vmcnt(0)" ::: "memory")
__device__ __forceinline__ unsigned long long rt() { return __builtin_amdgcn_s_memrealtime(); }
__device__ __forceinline__ unsigned f2bf(float f) { return (unsigned)__builtin_bit_cast(unsigned short, (__bf16)f); }
typedef __bf16 bf16x2_t __attribute__((ext_vector_type(2)));
__device__ __forceinline__ unsigned pk2(float lo, float hi) { bf16x2_t v; v[0] = (__bf16)lo; v[1] = (__bf16)hi; return __builtin_bit_cast(unsigned, v); }

#define XB_TMO      128
#define XB_XCNT(j)  (256  + 64 * (j))
#define XB_XSUB(j)  (1280 + 64 * (j))
#define XB_XGEN(j)  (2304 + 64 * (j))
#define XB_TOP      3328
#define XB_TOPGEN   3392
#define XCD_BAR_WORDS 3456
#define XB_SPIN_CAP (1u << 18)

__device__ __forceinline__ unsigned xb_ld(unsigned* p)              { return __hip_atomic_load(p, __ATOMIC_RELAXED, __HIP_MEMORY_SCOPE_AGENT); }
__device__ __forceinline__ unsigned xb_add(unsigned* p, unsigned v) { return __hip_atomic_fetch_add(p, v, __ATOMIC_RELAXED, __HIP_MEMORY_SCOPE_AGENT); }
__device__ __forceinline__ unsigned xb_xcc_id() { return (unsigned)__builtin_amdgcn_s_getreg((3 << 11) | 20) & 0xFu; }
#define XB_SPIN(cond, bar) do { unsigned _sp = 0; while (cond) { __builtin_amdgcn_s_sleep(1); \
    if ((++_sp & 255u) == 0u) { if (xb_ld(&(bar)[XB_TMO])) break; if (_sp > XB_SPIN_CAP) { atomicAdd(&(bar)[XB_TMO], 1u); break; } } } } while (0)

struct XcdBarrier {
    unsigned* bar; unsigned x;
    volatile LAS unsigned* st;
};

__device__ __forceinline__ XcdBarrier xcd_barrier_post(unsigned* bar, volatile LAS unsigned* st) {
    XcdBarrier b; b.bar = bar; b.x = xb_xcc_id(); b.st = st;
    if (threadIdx.x == 0) (void)xb_add(&bar[XB_XCNT(b.x)], 1u);
    return b;
}
__device__ __forceinline__ void xcd_barrier_complete(unsigned* bar, unsigned x, unsigned& nloc, unsigned& nx) {
    const unsigned G = gridDim.x * gridDim.y * gridDim.z;
    unsigned sum, cnt, mine, sp = 0u;
    for (;;) {
        sum = 0u; cnt = 0u; mine = 0u;
#pragma unroll
        for (unsigned j = 0; j < 16; ++j) { const unsigned c = xb_ld(&bar[XB_XCNT(j)]); sum += c; cnt += (c > 0u) ? 1u : 0u; mine = (j == x) ? c : mine; }
        if (sum == G) break;
        __builtin_amdgcn_s_sleep(1);
        if ((++sp & 255u) == 0u) { if (xb_ld(&bar[XB_TMO])) break; if (sp > XB_SPIN_CAP) { atomicAdd(&bar[XB_TMO], 1u); break; } }
    }
    nloc = mine > 0u ? mine : 1u; nx = cnt > 0u ? cnt : 1u;
}

__device__ __forceinline__ void xcd_barrier(const XcdBarrier& b) {
    asm volatile("s_waitcnt vmcnt(0)" ::: "memory");
    __syncthreads();
    if (threadIdx.x == 0) {
        unsigned* bar = b.bar;
        __builtin_amdgcn_s_waitcnt(0);
        unsigned nloc = b.st[0], nx = b.st[1];
        if (nloc == 0u) { xcd_barrier_complete(bar, b.x, nloc, nx); b.st[0] = nloc; b.st[1] = nx; }
        const unsigned old = xb_add(&bar[XB_XSUB(b.x)], 1u);
        const unsigned gen = old / nloc;
        if (old + 1u == (gen + 1u) * nloc) {
            __builtin_amdgcn_fence(__ATOMIC_RELEASE, "agent");
            asm volatile("s_waitcnt vmcnt(0)" ::: "memory");
            const unsigned og = xb_add(&bar[XB_TOP], 1u);
            const unsigned tg = og / nx;
            if (og + 1u == (tg + 1u) * nx) xb_add(&bar[XB_TOPGEN], 1u);
            else XB_SPIN(xb_ld(&bar[XB_TOPGEN]) == tg, bar);
            __builtin_amdgcn_fence(__ATOMIC_ACQUIRE, "agent");
            xb_add(&bar[XB_XGEN(b.x)], 1u);
            asm volatile("s_waitcnt vmcnt(0)" ::: "memory");
        } else {
            XB_SPIN(xb_ld(&bar[XB_XGEN(b.x)]) == gen, bar);
            __builtin_amdgcn_fence(__ATOMIC_ACQUIRE, "agent");
            asm volatile("s_waitcnt vmcnt(0)" ::: "memory");
        }
    }
    __syncthreads();
}
__device__ __forceinline__ float wave_sum(float v) {
#pragma unroll
    for (int o = 1; o < 64; o <<= 1) v += __shfl_xor(v, o);
    return v;
}
__device__ __forceinline__ float bflo(unsigned w) { return __uint_as_float(w << 16); }
__device__ __forceinline__ float bfhi(unsigned w) { return __uint_as_float(w & 0xffff0000u); }
__device__ __forceinline__ void unpack8(const v4u w, float (&o)[8]) { o[0] = bflo(w.x); o[1] = bfhi(w.x); o[2] = bflo(w.y); o[3] = bfhi(w.y); o[4] = bflo(w.z); o[5] = bfhi(w.z); o[6] = bflo(w.w); o[7] = bfhi(w.w); }
__device__ __forceinline__ v4u pack8(const float (&o)[8]) { v4u w; w.x = pk2(o[0], o[1]); w.y = pk2(o[2], o[3]); w.z = pk2(o[4], o[5]); w.w = pk2(o[6], o[7]); return w; }
__device__ __forceinline__ float fsig(float x) { return __builtin_amdgcn_rcpf(1.f + __builtin_amdgcn_exp2f(-1.44269504f * x)); }
__device__ __forceinline__ float ftanh(float x) { return 1.f - 2.f * __builtin_amdgcn_rcpf(1.f + __builtin_amdgcn_exp2f(2.88539008f * x)); }
__device__ __forceinline__ float fsoftplus(float z) { return fmaxf(z, 0.f) + __logf(1.f + __expf(-fabsf(z))); }

__device__ __forceinline__ int gu_row(int c, int ty) { const int pn = c >> 7, cc = c & 127, wc = cc >> 5, rem = cc & 31, fq = rem >> 3, bj = (rem >> 2) & 1, j = rem & 3; return 256 * pn + 128 * bj + 32 * wc + 16 * ty + 4 * fq + j; }
__device__ __forceinline__ void p0_tr(const float* W, int ldw, int sk0, int sn0, bf16* WT, int ldt, int dk0, int dn0, LAS float* scr, int lane, const float* kscale, int mode) {
#pragma unroll 8
    for (int i = 0; i < 32; ++i) { const int kk = 2 * i + (lane >> 5); float w = W[(size_t)(sk0 + kk) * ldw + sn0 + (lane & 31)]; if (kscale) w *= kscale[sk0 + kk]; scr[kk * 33 + (lane & 31)] = w; }
    LDS_WAIT(); asm volatile("" ::: "memory");
    const int c = lane & 7;
#pragma unroll
    for (int j = 0; j < 4; ++j) { const int n = (lane >> 3) + 8 * j; const LAS float* s = scr + (8 * c) * 33 + n;
        v4u o; o.x = pk2(s[0 * 33], s[1 * 33]); o.y = pk2(s[2 * 33], s[3 * 33]); o.z = pk2(s[4 * 33], s[5 * 33]); o.w = pk2(s[6 * 33], s[7 * 33]);
        const int drow = mode == 0 ? dn0 + n : gu_row(sn0 + n, mode - 1);
        *(GAS v4u*)(WT + (size_t)drow * ldt + dk0 + 8 * c) = o; }
    LDS_WAIT(); asm volatile("" ::: "memory");
}
struct Args { const float* in[34]; float* out; unsigned char* ws; int ph_lo, ph_hi; };
struct Ptrs {
    const __attribute__((address_space(4))) Args* Ap;
    __device__ __forceinline__ const float* xp() const { return Ap->in[0]; }
    __device__ __forceinline__ const float* xs() const { return Ap->in[1]; }
    __device__ __forceinline__ const float* sshift() const { return Ap->in[2]; }
    __device__ __forceinline__ const float* swkv() const { return Ap->in[3]; }
    __device__ __forceinline__ const float* sconv() const { return Ap->in[4]; }
    __device__ __forceinline__ const float* sgdn() const { return Ap->in[5]; }
    __device__ __forceinline__ const float* pp_() const { return Ap->in[6]; }
    __device__ __forceinline__ const float* ps_() const { return Ap->in[7]; }
    __device__ __forceinline__ const float* ln_mix_g() const { return Ap->in[8]; }
    __device__ __forceinline__ const float* w_in() const { return Ap->in[9]; }
    __device__ __forceinline__ const float* mu() const { return Ap->in[10]; }
    __device__ __forceinline__ const float* w0() const { return Ap->in[11]; }
    __device__ __forceinline__ const float* wl_up() const { return Ap->in[12]; }
    __device__ __forceinline__ const float* a0() const { return Ap->in[13]; }
    __device__ __forceinline__ const float* al_up() const { return Ap->in[14]; }
    __device__ __forceinline__ const float* gl_up() const { return Ap->in[15]; }
    __device__ __forceinline__ const float* k_k() const { return Ap->in[16]; }
    __device__ __forceinline__ const float* k_a() const { return Ap->in[17]; }
    __device__ __forceinline__ const float* r_k() const { return Ap->in[18]; }
    __device__ __forceinline__ const float* lnx_w() const { return Ap->in[19]; }
    __device__ __forceinline__ const float* lnx_b() const { return Ap->in[20]; }
    __device__ __forceinline__ const float* conv_w() const { return Ap->in[21]; }
    __device__ __forceinline__ const float* a_log() const { return Ap->in[22]; }
    __device__ __forceinline__ const float* dt_bias() const { return Ap->in[23]; }
    __device__ __forceinline__ const float* gdn_g() const { return Ap->in[24]; }
    __device__ __forceinline__ const float* w_out() const { return Ap->in[25]; }
    __device__ __forceinline__ const float* ln_ffn_g() const { return Ap->in[26]; }
    __device__ __forceinline__ const float* w_gate() const { return Ap->in[27]; }
    __device__ __forceinline__ const float* w_up() const { return Ap->in[28]; }
    __device__ __forceinline__ const float* w_down() const { return Ap->in[29]; }
    __device__ __forceinline__ const float* ln_ple_g() const { return Ap->in[30]; }
    __device__ __forceinline__ const float* w_pg() const { return Ap->in[31]; }
    __device__ __forceinline__ const float* w_pp() const { return Ap->in[32]; }
    __device__ __forceinline__ const float* fin_g() const { return Ap->in[33]; }
    __device__ __forceinline__ float* out() const { return Ap->out; }
    __device__ __forceinline__ bf16* Win_t() const { return (bf16*)(Ap->ws + WS_WIN); }
    __device__ __forceinline__ bf16* Wout_t() const { return (bf16*)(Ap->ws + WS_WOUT); }
    __device__ __forceinline__ bf16* Wgu_t() const { return (bf16*)(Ap->ws + WS_WGU); }
    __device__ __forceinline__ bf16* Wdown_t() const { return (bf16*)(Ap->ws + WS_WDOWN); }
    __device__ __forceinline__ bf16* Wpg_t() const { return (bf16*)(Ap->ws + WS_WPG); }
    __device__ __forceinline__ bf16* Wpp_t() const { return (bf16*)(Ap->ws + WS_WPP); }
    __device__ __forceinline__ bf16* Wlora_t() const { return (bf16*)(Ap->ws + WS_WLORA); }
    __device__ __forceinline__ bf16* XN() const { return (bf16*)(Ap->ws + WS_XN); }
    __device__ __forceinline__ bf16* PROJ() const { return (bf16*)(Ap->ws + WS_PROJ); }
    __device__ __forceinline__ bf16* ACT() const { return (bf16*)(Ap->ws + WS_ACT); }
    __device__ __forceinline__ bf16* XA() const { return (bf16*)(Ap->ws + WS_XA); }
    __device__ __forceinline__ bf16* AA() const { return (bf16*)(Ap->ws + WS_AA); }
    __device__ __forceinline__ bf16* GA() const { return (bf16*)(Ap->ws + WS_GA); }
    __device__ __forceinline__ bf16* PB() const { return (bf16*)(Ap->ws + WS_PB); }
    __device__ __forceinline__ bf16* LIN() const { return (bf16*)(Ap->ws + WS_LIN); }
    __device__ __forceinline__ float* RN() const { return (float*)(Ap->ws + WS_RN); }
    __device__ __forceinline__ float* BA() const { return (float*)(Ap->ws + WS_BA); }
    __device__ __forceinline__ float* SSQ2() const { return (float*)(Ap->ws + WS_SSQ2); }
    __device__ __forceinline__ float* SSQ3() const { return (float*)(Ap->ws + WS_SSQ3); }
    __device__ __forceinline__ float* SSQS2() const { return (float*)(Ap->ws + WS_SSQS2); }
    __device__ __forceinline__ float* SSQS3() const { return (float*)(Ap->ws + WS_SSQS3); }
    __device__ __forceinline__ bf16* RPHI() const { return (bf16*)Ap->out; }
    __device__ __forceinline__ bf16* RPSI() const { return (bf16*)Ap->out + (size_t)4224 * 4096; }
    __device__ __forceinline__ bf16* RRH() const { return (bf16*)Ap->out + (size_t)2 * 4224 * 4096; }
    __device__ __forceinline__ bf16* RYI() const { return (bf16*)(Ap->ws + WS_RYI); }
    __device__ __forceinline__ bf16* RS() const { return (bf16*)(Ap->ws + WS_RS); }
    __device__ __forceinline__ bf16* GM() const { return (bf16*)Ap->out; }
    __device__ __forceinline__ bf16* GQH() const { return (bf16*)Ap->out + (size_t)2112 * 16384; }
    __device__ __forceinline__ bf16* GNT() const { return (bf16*)(Ap->ws + WS_GNT); }
    __device__ __forceinline__ bf16* GOI() const { return (bf16*)(Ap->ws + WS_GOI); }
    __device__ __forceinline__ bf16* GS() const { return (bf16*)(Ap->ws + WS_GS); }
    __device__ __forceinline__ bf16* PP() const { return (bf16*)(Ap->ws + WS_PP); }
};
__device__ __forceinline__ void p0_prologue(const Ptrs& P, LAS unsigned char* lds, int gw, int NGW, int wave, int lane) {
    LAS float* scr = (LAS float*)(lds + RING_OFF + wave * 16384);
    constexpr int I_IN = 16 * 120, I_OUT = 16 * 32, I_G = 16 * 88, I_DN = 44 * 32, I_PG = 16 * 32, I_PP = 4 * 32, I_LO = 4 * 48;
    constexpr int NITEMS = I_IN + I_OUT + 2 * I_G + I_DN + I_PG + I_PP + I_LO;
    for (int it = gw; it < NITEMS; it += NGW) {
        int r = it;
        if (r < I_IN) { p0_tr(P.w_in(), DIN, 64 * (r / 120), 32 * (r % 120), P.Win_t(), 1024, 64 * (r / 120), 32 * (r % 120), scr, lane, nullptr, 0); continue; } r -= I_IN;
        if (r < I_OUT) { p0_tr(P.w_out(), 1024, 64 * (r / 32), 32 * (r % 32), P.Wout_t(), 1024, 64 * (r / 32), 32 * (r % 32), scr, lane, nullptr, 0); continue; } r -= I_OUT;
        if (r < I_G) { p0_tr(P.w_gate(), DFF, 64 * (r / 88), 32 * (r % 88), P.Wgu_t(), 1024, 64 * (r / 88), 0, scr, lane, P.ln_ffn_g(), 1); continue; } r -= I_G;
        if (r < I_G) { p0_tr(P.w_up(), DFF, 64 * (r / 88), 32 * (r % 88), P.Wgu_t(), 1024, 64 * (r / 88), 0, scr, lane, P.ln_ffn_g(), 2); continue; } r -= I_G;
        if (r < I_DN) { p0_tr(P.w_down(), 1024, 64 * (r / 32), 32 * (r % 32), P.Wdown_t(), DFF, 64 * (r / 32), 32 * (r % 32), scr, lane, nullptr, 0); continue; } r -= I_DN;
        if (r < I_PG) { p0_tr(P.w_pg(), 1024, 64 * (r / 32), 32 * (r % 32), P.Wpg_t(), 1024, 64 * (r / 32), 32 * (r % 32), scr, lane, P.ln_ple_g(), 0); continue; } r -= I_PG;
        if (r < I_PP) { p0_tr(P.w_pp(), 1024, 64 * (r / 32), 32 * (r % 32), P.Wpp_t(), 256, 64 * (r / 32), 32 * (r % 32), scr, lane, nullptr, 0); continue; } r -= I_PP;
        {
            const int kb = r / 48, nb = r % 48, part = nb / 16, n0 = 32 * (nb % 16);
            const bool nz = (part == 0 && kb == 0) || (part == 1 && kb == 1) || (part == 2 && kb >= 2);
            if (nz) { const float* W = part == 0 ? P.wl_up() : (part == 1 ? P.al_up() : P.gl_up()); p0_tr(W, 512, part == 2 ? 64 * (kb - 2) : 0, n0, P.Wlora_t(), 256, 64 * kb, 512 * part + n0, scr, lane, nullptr, 0); }
            else { const int c = lane & 7;
#pragma unroll
                for (int j = 0; j < 4; ++j) { const int n = (lane >> 3) + 8 * j; *(GAS v4u*)(P.Wlora_t() + (size_t)(512 * part + n0 + n) * 256 + 64 * kb + 8 * c) = (v4u){0u, 0u, 0u, 0u}; } }
        }
    }
    f32x4 gv[4];
#pragma unroll
    for (int j = 0; j < 4; ++j) gv[j] = *(const f32x4*)(P.ln_mix_g() + 4 * lane + 256 * j);
    f32x4 wq[16][2];
#pragma unroll
    for (int j = 0; j < 4; ++j)
#pragma unroll
        for (int i = 0; i < 4; ++i) { const float* wr_ = P.w_in() + (size_t)(256 * j + 4 * lane + i) * DIN + NPROJ; wq[4 * j + i][0] = *(const f32x4*)wr_; wq[4 * j + i][1] = *(const f32x4*)(wr_ + 4); }
    for (int m = gw; m < MROWS; m += NGW) {
        const float* xr = m < MP ? P.xp() + (size_t)m * DM : P.xs() + (size_t)(m - MP) * DM;
        const GAS f32x4* x4 = (const GAS f32x4*)xr + lane;
        f32x4 v[4]; float ss = 0.f;
#pragma unroll
        for (int j = 0; j < 4; ++j) { v[j] = x4[64 * j]; ss += (v[j].x * v[j].x + v[j].y * v[j].y) + (v[j].z * v[j].z + v[j].w * v[j].w); }
        const float rstd = 1.0f / sqrtf(wave_sum(ss) * (1.f / DM) + RMS_EPS);
        GAS unsigned long long* o8 = (GAS unsigned long long*)(P.XN() + (size_t)m * DM) + lane;
        f32x4 d0 = {0.f, 0.f, 0.f, 0.f}, d1 = {0.f, 0.f, 0.f, 0.f};
#pragma unroll
        for (int j = 0; j < 4; ++j) { const f32x4 h = v[j] * rstd * gv[j];
            o8[64 * j] = (unsigned long long)pk2(h.x, h.y) | ((unsigned long long)pk2(h.z, h.w) << 32);
#pragma unroll
            for (int i = 0; i < 4; ++i) { d0 += wq[4 * j + i][0] * h[i]; d1 += wq[4 * j + i][1] * h[i]; } }
#pragma unroll
        for (int c = 0; c < 4; ++c) { d0[c] = wave_sum(d0[c]); d1[c] = wave_sum(d1[c]); }
        if (lane == 0) { *(f32x4*)(P.BA() + (size_t)m * 8) = d0; *(f32x4*)(P.BA() + (size_t)m * 8 + 4) = d1; }
    }
}
__device__ __forceinline__ void row_info(int m, int& t, int& sb) { if (m < MP) { t = m & (SEQL - 1); sb = -1; } else { t = (m - MP) & (SSL - 1); sb = (m - MP) >> 4; } }
__device__ __forceinline__ void load_fm8(const Ptrs& P, int m, int t, int sb, int c0, float (&o)[8]) {
    float f[8], p[8];
    unpack8(*(const GAS v4u*)(P.PROJ() + (size_t)m * NPROJ + c0), f);
    if (t > 0) unpack8(*(const GAS v4u*)(P.PROJ() + (size_t)(m - 1) * NPROJ + c0), p);
    else if (sb >= 0) { const f32x4 a = *(const f32x4*)(P.sshift() + (size_t)sb * RPROJ + c0), b = *(const f32x4*)(P.sshift() + (size_t)sb * RPROJ + c0 + 4); p[0] = a.x; p[1] = a.y; p[2] = a.z; p[3] = a.w; p[4] = b.x; p[5] = b.y; p[6] = b.z; p[7] = b.w; }
    else {
#pragma unroll
        for (int i = 0; i < 8; ++i) p[i] = 0.f; }
    const f32x4 m0 = *(const f32x4*)(P.mu() + c0), m1 = *(const f32x4*)(P.mu() + c0 + 4);
#pragma unroll
    for (int i = 0; i < 8; ++i) o[i] = f[i] + (p[i] - f[i]) * (i < 4 ? m0[i] : m1[i - 4]);
}
__device__ __forceinline__ float load_fm1(const Ptrs& P, int m, int t, int sb, int c) {
    const float f = __uint_as_float((unsigned)P.PROJ()[(size_t)m * NPROJ + c] << 16);
    float p = 0.f;
    if (t > 0) p = __uint_as_float((unsigned)P.PROJ()[(size_t)(m - 1) * NPROJ + c] << 16); else if (sb >= 0) p = P.sshift()[(size_t)sb * RPROJ + c];
    return f + (p - f) * P.mu()[c];
}
__device__ __forceinline__ void p2_token_prep(const Ptrs& P, int gw, int NGW, int lane) {
    for (int m = gw; m < MROWS; m += NGW) {
        int t, sb; row_info(m, t, sb);
        {
            const float fw = load_fm1(P, m, t, sb, 1536 + lane), fa = load_fm1(P, m, t, sb, 1600 + lane), fg0 = load_fm1(P, m, t, sb, 1664 + lane), fg1 = load_fm1(P, m, t, sb, 1728 + lane);
            bf16* lr = P.LIN() + (size_t)m * KLORA;
            lr[lane] = (bf16)f2bf(ftanh(fw)); lr[64 + lane] = (bf16)f2bf(fa); lr[128 + lane] = (bf16)f2bf(fsig(fg0)); lr[192 + lane] = (bf16)f2bf(fsig(fg1));
        }
        {
            float k[8]; load_fm8(P, m, t, sb, 512 + 8 * lane, k);
            const f32x4 kk0 = *(const f32x4*)(P.k_k() + 8 * lane), kk1 = *(const f32x4*)(P.k_k() + 8 * lane + 4); float s = 0.f;
#pragma unroll
            for (int i = 0; i < 8; ++i) { const float q = k[i] * (i < 4 ? kk0[i] : kk1[i - 4]); s += q * q; }
            s += __shfl_xor(s, 1); s += __shfl_xor(s, 2); s += __shfl_xor(s, 4);
            if ((lane & 7) == 0) P.RN()[(size_t)m * 8 + (lane >> 3)] = 1.0f / sqrtf(s + 1e-12f);
        }
    }
}
__device__ __forceinline__ void copy_state_rows(const Ptrs& P, int gw, int NGW, int lane) {
    for (int s = gw; s < 20; s += NGW) { const int sb = s - 4; const int mlast = s < 4 ? s * SEQL + SEQL - 1 : MP + sb * SSL + SSL - 1;
        float* dsh = s < 4 ? P.out() + O_SHIFT_P + (size_t)s * RPROJ : P.out() + O_SHIFT_S + (size_t)sb * RPROJ;
        for (int c = lane; c < RPROJ; c += 64) dsh[c] = __uint_as_float((unsigned)P.PROJ()[(size_t)mlast * NPROJ + c] << 16);
        float* dcv = s < 4 ? P.out() + O_CONV_P + (size_t)s * 3 * GQ : P.out() + O_CONV_S + (size_t)sb * 3 * GQ;
        for (int r = 0; r < 3; ++r) for (int c = lane; c < GQ; c += 64) dcv[(size_t)r * GQ + c] = __uint_as_float((unsigned)P.PROJ()[(size_t)(mlast - 2 + r) * NPROJ + OFF_QKV + c] << 16); }
}
__device__ __forceinline__ void p_final_norm(const Ptrs& P, int gw, int NGW, int lane) {
    f32x4 gv[4];
#pragma unroll
    for (int j = 0; j < 4; ++j) gv[j] = *(const f32x4*)(P.fin_g() + 4 * lane + 256 * j);
    for (int m = gw; m < MROWS; m += NGW) {
        GAS f32x4* x4 = (GAS f32x4*)(P.out() + (size_t)m * DM) + lane; f32x4 v[4]; float ss = 0.f;
#pragma unroll
        for (int j = 0; j < 4; ++j) { v[j] = x4[64 * j]; ss += (v[j].x * v[j].x + v[j].y * v[j].y) + (v[j].z * v[j].z + v[j].w * v[j].w); }
        const float rstd = 1.0f / sqrtf(wave_sum(ss) * (1.f / DM) + RMS_EPS);
#pragma unroll
        for (int j = 0; j < 4; ++j) x4[64 * j] = v[j] * rstd * gv[j];
    }
}
typedef float f32x16 __attribute__((ext_vector_type(16)));
typedef unsigned v2u __attribute__((ext_vector_type(2)));
constexpr int NCID = 528, NITEM_G = NCID * 4, NITEM_R = NCID * 8;
constexpr int GL_VEC = 0, GL_AT = 512, GL_QK = 17920, GL_QH = 27136, GL_KH = 44544, GL_VH = 61952, GL_UT = 79360, GL_WT = 97792, GL_KD = 116224;
struct ChunkInfo { int m0, ntok, sb, n; };
__device__ __forceinline__ ChunkInfo chunk_info(int cid) { ChunkInfo c; if (cid < 512) { c.m0 = (cid >> 7) * SEQL + (cid & 127) * 64; c.ntok = 64; c.sb = -1; c.n = cid & 127; } else { c.sb = cid - 512; c.m0 = MP + c.sb * SSL; c.ntok = SSL; c.n = 0; } return c; }
__device__ __forceinline__ f32x16 mfma32(bf16x8 a, bf16x8 b, f32x16 c) { return __builtin_amdgcn_mfma_f32_32x32x16_bf16(a, b, c, 0, 0, 0); }
__device__ __forceinline__ bf16x8 ldfrag(LAS unsigned char* lds, int byteoff) { return *(const LAS bf16x8*)(lds + byteoff); }
__device__ __forceinline__ f32x16 zero16() { f32x16 z;
#pragma unroll
    for (int i = 0; i < 16; ++i) z[i] = 0.f; return z; }

__device__ __forceinline__ void gdn_prep_item(const Ptrs& P, LAS unsigned char* lds, int cid, int h, int tid) {
    const ChunkInfo ci = chunk_info(cid); const int item = cid * 4 + h;
    int lane = tid & 63, wave = __builtin_amdgcn_readfirstlane(tid >> 6), c32 = lane & 31, hh = lane >> 5;
#define OPAQUE_LANE() do { asm volatile("" : "+v"(lane)); asm volatile("" : "+s"(wave)); c32 = lane & 31; hh = lane >> 5; } while (0)
    LAS float* vec = (LAS float*)(lds + GL_VEC);
#ifndef NO_S1
    {   const int tok = tid >> 3, sub = tid & 7, ch0 = 16 * sub; const bool valid = tok < ci.ntok; const int m = ci.m0 + tok; const int tseq = ci.n * 64 + tok;
#pragma unroll 1
        for (int part = 0; part < 3; ++part) {
            float acc[16];
#pragma unroll
            for (int i = 0; i < 16; ++i) acc[i] = 0.f;
            const int col = part * 512 + h * 128 + ch0;
            if (valid) {
#pragma unroll
                for (int j = 0; j < 4; ++j) { const int tt = tseq - 3 + j; float v[16];
                    if (tt >= 0) { const bf16* pr = P.PROJ() + (size_t)(m - 3 + j) * NPROJ + OFF_QKV + col; float a[8], b[8]; unpack8(*(const GAS v4u*)pr, a); unpack8(*(const GAS v4u*)(pr + 8), b);
#pragma unroll
                        for (int i = 0; i < 8; ++i) { v[i] = a[i]; v[8 + i] = b[i]; } }
                    else if (ci.sb >= 0) { const float* sp = P.sconv() + ((size_t)ci.sb * 3 + (3 + tt)) * GQ + col;
#pragma unroll
                        for (int q4 = 0; q4 < 4; ++q4) { const f32x4 a = *(const f32x4*)(sp + 4 * q4); v[4 * q4] = a.x; v[4 * q4 + 1] = a.y; v[4 * q4 + 2] = a.z; v[4 * q4 + 3] = a.w; } }
                    else {
#pragma unroll
                        for (int i = 0; i < 16; ++i) v[i] = 0.f; }
                    const float* cw = P.conv_w() + (size_t)j * GQ + col;
#pragma unroll
                    for (int q4 = 0; q4 < 4; ++q4) { const f32x4 w4 = *(const f32x4*)(cw + 4 * q4); acc[4 * q4] += v[4 * q4] * w4.x; acc[4 * q4 + 1] += v[4 * q4 + 1] * w4.y; acc[4 * q4 + 2] += v[4 * q4 + 2] * w4.z; acc[4 * q4 + 3] += v[4 * q4 + 3] * w4.w; }
                }
            }
            float s = 0.f;
#pragma unroll
            for (int i = 0; i < 16; ++i) { acc[i] = acc[i] * fsig(acc[i]); s += acc[i] * acc[i]; }
            if (part < 2) { s += __shfl_xor(s, 1); s += __shfl_xor(s, 2); s += __shfl_xor(s, 4);
                const float sc = (1.0f / sqrtf(s + 1e-6f)) * (part == 0 ? 0.08838834764831845f : 1.0f);
#pragma unroll
                for (int i = 0; i < 16; ++i) acc[i] *= sc; }
            LAS unsigned char* dst = lds + GL_QH + part * 17408 + tok * 272 + ch0 * 2;
            v4u w0, w1; w0.x = pk2(acc[0], acc[1]); w0.y = pk2(acc[2], acc[3]); w0.z = pk2(acc[4], acc[5]); w0.w = pk2(acc[6], acc[7]); w1.x = pk2(acc[8], acc[9]); w1.y = pk2(acc[10], acc[11]); w1.z = pk2(acc[12], acc[13]); w1.w = pk2(acc[14], acc[15]);
            *(LAS v4u*)dst = w0; *(LAS v4u*)(dst + 16) = w1;
        }
        if (tid < 64) { const int tk = tid; float beta = 0.f, gl = 0.f;
            if (tk < ci.ntok) { const float* ba = P.BA() + (size_t)(ci.m0 + tk) * 8; beta = fsig(ba[h]); gl = -__expf(P.a_log()[h]) * fsoftplus(ba[4 + h] + P.dt_bias()[h]); }
#pragma unroll
            for (int o = 1; o < 64; o <<= 1) { const float t = __shfl_up(gl, o); if (lane >= o) gl += t; }
            vec[tk] = beta; vec[64 + tk] = gl; }
    }
#endif
    __syncthreads();
    const float Glast = vec[64 + 63];
    OPAQUE_LANE();
    if (wave < 6) {
        const int type = wave / 3, tl = wave % 3, ti = tl == 0 ? 0 : 1, tj = tl == 2 ? 1 : 0;
        f32x16 acc = zero16();
        if (type == 0) {
#pragma unroll
            for (int s = 0; s < 8; ++s) acc = mfma32(ldfrag(lds, GL_KH + (32 * ti + c32) * 272 + (16 * s + 8 * hh) * 2), ldfrag(lds, GL_KH + (32 * tj + c32) * 272 + (16 * s + 8 * hh) * 2), acc);
            const int j = 32 * tj + c32; const float Gj = vec[64 + j];
#pragma unroll
            for (int q = 0; q < 4; ++q) { f32x4 o;
#pragma unroll
                for (int e = 0; e < 4; ++e) { const int i = 32 * ti + 8 * q + 4 * hh + e; o[e] = i > j ? vec[i] * acc[4 * q + e] * __expf(vec[64 + i] - Gj) : 0.f; }
                *(LAS f32x4*)(lds + GL_AT + j * 272 + (32 * ti + 8 * q + 4 * hh) * 4) = o; }
        } else {
#pragma unroll
            for (int s = 0; s < 8; ++s) acc = mfma32(ldfrag(lds, GL_KH + (32 * tj + c32) * 272 + (16 * s + 8 * hh) * 2), ldfrag(lds, GL_QH + (32 * ti + c32) * 272 + (16 * s + 8 * hh) * 2), acc);
            const int i = 32 * ti + c32; const float Gi = vec[64 + i];
#pragma unroll
            for (int q = 0; q < 4; ++q) { float o[4];
#pragma unroll
                for (int e = 0; e < 4; ++e) { const int j = 32 * tj + 8 * q + 4 * hh + e; o[e] = i >= j ? acc[4 * q + e] * __expf(Gi - vec[64 + j]) : 0.f; }
                v2u w; w.x = pk2(o[0], o[1]); w.y = pk2(o[2], o[3]);
                *(LAS v2u*)(lds + GL_QK + i * 144 + (32 * tj + 8 * q + 4 * hh) * 2) = w; }
        }
    } else if (wave == 6) {
        LAS unsigned char* dst = lds + GL_QK + (lane >> 1) * 144 + 64 + (lane & 1) * 32;
        *(LAS v4u*)dst = (v4u){0u, 0u, 0u, 0u}; *(LAS v4u*)(dst + 16) = (v4u){0u, 0u, 0u, 0u};
    }
    __syncthreads();
#ifndef NO_S3
    OPAQUE_LANE();
    if (wave < 4) {
        const bool isU = wave < 2; const int col = 64 * (wave & 1) + lane;
        LAS unsigned char* xout = lds + (isU ? GL_UT : GL_WT) + col * 144;
        const LAS unsigned char* src = lds + (isU ? GL_VH : GL_KH) + col * 2;
#pragma unroll 1
        for (int bb = 0; bb < 4; ++bb) {
            float X[16];
            {   float kd[16];
#pragma unroll
                for (int i = 0; i < 16; ++i) { const int r = 16 * bb + i; const float xv = __uint_as_float((unsigned)(*(const LAS unsigned short*)(src + r * 272)) << 16); const float Gr = vec[64 + r];
                    X[i] = vec[r] * xv * (isU ? 1.f : __expf(Gr)); kd[i] = xv * __expf(Glast - Gr); }
                if (!isU) { float o[8];
#pragma unroll
                    for (int i = 0; i < 8; ++i) o[i] = kd[i];
                    *(LAS v4u*)(lds + GL_KD + col * 144 + bb * 32) = pack8(o);
#pragma unroll
                    for (int i = 0; i < 8; ++i) o[i] = kd[8 + i];
                    *(LAS v4u*)(lds + GL_KD + col * 144 + bb * 32 + 16) = pack8(o); }
            }
#pragma unroll 1
            for (int jb = 0; jb < 2 * bb; ++jb) {
                float xj[8]; unpack8(*(const LAS v4u*)(xout + jb * 16), xj);
#pragma unroll
                for (int jj = 0; jj < 8; ++jj) { const LAS unsigned char* ar = lds + GL_AT + (8 * jb + jj) * 272 + bb * 64;
#pragma unroll
                    for (int g4 = 0; g4 < 4; ++g4) { const f32x4 a4 = *(const LAS f32x4*)(ar + g4 * 16);
#pragma unroll
                        for (int e = 0; e < 4; ++e) X[4 * g4 + e] = fmaf(-a4[e], xj[jj], X[4 * g4 + e]); } }
            }
#pragma unroll
            for (int j = 0; j < 15; ++j) { const LAS unsigned char* ar = lds + GL_AT + (16 * bb + j) * 272 + bb * 64;
#pragma unroll
                for (int g4 = (j + 1) >> 2; g4 < 4; ++g4) { const f32x4 a4 = *(const LAS f32x4*)(ar + g4 * 16);
#pragma unroll
                    for (int e = 0; e < 4; ++e) { const int i = 4 * g4 + e; if (i > j) X[i] = fmaf(-a4[e], X[j], X[i]); } } }
            {   float o[8];
#pragma unroll
                for (int i = 0; i < 8; ++i) o[i] = X[i];
                *(LAS v4u*)(xout + bb * 32) = pack8(o);
#pragma unroll
                for (int i = 0; i < 8; ++i) o[i] = X[8 + i];
                *(LAS v4u*)(xout + bb * 32 + 16) = pack8(o); }
            LDS_WAIT(); asm volatile("" ::: "memory");
        }
    }
#endif
    __syncthreads();
#ifndef NO_S4
    {   bf16* GM = P.GM() + (size_t)item * 16384; bf16* GNT = P.GNT() + (size_t)item * 16384; bf16* GQH = P.GQH() + (size_t)item * 8192; bf16* GOI = P.GOI() + (size_t)item * 8192;
        const float eGl = __expf(Glast);
        OPAQUE_LANE();
        {   const int dpt = wave & 3; const int dp = 32 * dpt + c32;
#pragma unroll
            for (int u = 0; u < 2; ++u) { const int dt = 2 * (wave >> 2) + u; f32x16 acc = zero16();
#pragma unroll
                for (int s = 0; s < 4; ++s) acc = mfma32(ldfrag(lds, GL_WT + (32 * dt + c32) * 144 + (16 * s + 8 * hh) * 2), ldfrag(lds, GL_KD + dp * 144 + (16 * s + 8 * hh) * 2), acc);
#pragma unroll
                for (int q = 0; q < 4; ++q) { float o[4];
#pragma unroll
                    for (int e = 0; e < 4; ++e) { const int d = 32 * dt + 8 * q + 4 * hh + e; o[e] = (d == dp ? eGl : 0.f) - acc[4 * q + e]; }
                    v2u w; w.x = pk2(o[0], o[1]); w.y = pk2(o[2], o[3]);
                    *(GAS v2u*)((unsigned char*)GM + ((dpt * 8 + 2 * dt + (q >> 1)) * 64 + lane) * 16 + (q & 1) * 8) = w; } }
        }
        OPAQUE_LANE();
        {   const int et = wave & 3; const int e_ = 32 * et + c32;
#pragma unroll
            for (int u = 0; u < 2; ++u) { const int dpt = 2 * (wave >> 2) + u; f32x16 acc = zero16();
#pragma unroll
                for (int s = 0; s < 4; ++s) acc = mfma32(ldfrag(lds, GL_KD + (32 * dpt + c32) * 144 + (16 * s + 8 * hh) * 2), ldfrag(lds, GL_UT + e_ * 144 + (16 * s + 8 * hh) * 2), acc);
#pragma unroll
                for (int q = 0; q < 4; ++q) { v2u w; w.x = pk2(acc[4 * q], acc[4 * q + 1]); w.y = pk2(acc[4 * q + 2], acc[4 * q + 3]);
                    *(GAS v2u*)((unsigned char*)GNT + (((et * 4 + dpt) * 4 + q) * 64 + lane) * 8) = w; } }
        }
        OPAQUE_LANE();
        {   const int xt = wave & 3, it = wave >> 2; const int i = 32 * it + c32; const float eGi = __expf(vec[64 + i]); const int ns = it == 0 ? 2 : 4;
            f32x16 acc = zero16(), acc2 = zero16();
            for (int s = 0; s < ns; ++s) { const bf16x8 b = ldfrag(lds, GL_QK + i * 144 + (16 * s + 8 * hh) * 2);
                acc = mfma32(ldfrag(lds, GL_WT + (32 * xt + c32) * 144 + (16 * s + 8 * hh) * 2), b, acc);
                acc2 = mfma32(ldfrag(lds, GL_UT + (32 * xt + c32) * 144 + (16 * s + 8 * hh) * 2), b, acc2); }
#pragma unroll
            for (int q = 0; q < 4; ++q) { const int d = 32 * xt + 8 * q + 4 * hh; const v2u qq = *(const LAS v2u*)(lds + GL_QH + i * 272 + d * 2);
                v2u w; w.x = pk2(bflo(qq.x) * eGi - acc[4 * q], bfhi(qq.x) * eGi - acc[4 * q + 1]); w.y = pk2(bflo(qq.y) * eGi - acc[4 * q + 2], bfhi(qq.y) * eGi - acc[4 * q + 3]);
                *(GAS v2u*)((unsigned char*)GQH + ((it * 8 + 2 * xt + (q >> 1)) * 64 + lane) * 16 + (q & 1) * 8) = w;
                v2u w2; w2.x = pk2(acc2[4 * q], acc2[4 * q + 1]); w2.y = pk2(acc2[4 * q + 2], acc2[4 * q + 3]);
                *(GAS v2u*)((unsigned char*)GOI + (((it * 4 + xt) * 4 + q) * 64 + lane) * 8) = w2; }
        }
    }
#endif
    __syncthreads();
#undef OPAQUE_LANE
}
__device__ __forceinline__ void gdn_serial_job(const Ptrs& P, LAS unsigned char* lds, int item0, int istride, int nch, const float* s0, float* sfinal, int et, int tid) {
    const int lane = tid & 63, wave = tid >> 6, c32 = lane & 31, hh = lane >> 5; const int e_ = 32 * et + c32;
    f32x16 acc[4];
#pragma unroll
    for (int mt = 0; mt < 4; ++mt)
#pragma unroll
        for (int r = 0; r < 16; ++r) acc[mt][r] = s0 ? s0[(size_t)(32 * mt + (r & 3) + 8 * (r >> 2) + 4 * hh) * 128 + e_] : 0.f;
    v4u st[2][4]; v2u nf[2][4][4];
#define GS_ITEM(n_) (item0 + ((n_) < nch ? (n_) : nch - 1) * istride)
#define GS_LOAD_M(set, n_) do { const GAS v4u* src_ = (const GAS v4u*)(P.GM() + (size_t)GS_ITEM(n_) * 16384) + tid; _Pragma("unroll") for (int k = 0; k < 4; ++k) st[set][k] = src_[512 * k]; } while (0)
#define GS_LOAD_N(set, n_) do { const unsigned char* gn_ = (const unsigned char*)(P.GNT() + (size_t)GS_ITEM(n_) * 16384); _Pragma("unroll") for (int mt = 0; mt < 4; ++mt) _Pragma("unroll") for (int q = 0; q < 4; ++q) nf[set][mt][q] = *(const GAS v2u*)(gn_ + (((et * 4 + mt) * 4 + q) * 64 + lane) * 8); } while (0)
#define GS_WRITE_M(set, slot) do { _Pragma("unroll") for (int k = 0; k < 4; ++k) *(LAS v4u*)(lds + (slot) * 32768 + (tid + 512 * k) * 16) = st[set][k]; } while (0)
    GS_LOAD_M(0, 0); GS_LOAD_M(1, 1);
    if (wave == 0) { GS_LOAD_N(0, 0); GS_LOAD_N(1, 1); }
    GS_WRITE_M(0, 0);
    __syncthreads();
#define GS_ITER(n_, cur, oth) do { const int item_ = GS_ITEM(n_); LAS unsigned char* mb = lds + (cur) * 32768; \
        GS_LOAD_M(cur, (n_) + 2); \
        if (wave == 0) { bf16x8 sf[8]; unsigned char* gs = (unsigned char*)(P.GS() + (size_t)item_ * 16384); \
            _Pragma("unroll") for (int mt = 0; mt < 4; ++mt) _Pragma("unroll") for (int s2 = 0; s2 < 2; ++s2) { v4u w; w.x = pk2(acc[mt][8 * s2], acc[mt][8 * s2 + 1]); w.y = pk2(acc[mt][8 * s2 + 2], acc[mt][8 * s2 + 3]); w.z = pk2(acc[mt][8 * s2 + 4], acc[mt][8 * s2 + 5]); w.w = pk2(acc[mt][8 * s2 + 6], acc[mt][8 * s2 + 7]); \
                sf[2 * mt + s2] = __builtin_bit_cast(bf16x8, w); *(GAS v4u*)(gs + ((et * 8 + 2 * mt + s2) * 64 + lane) * 16) = w; } \
            _Pragma("unroll") for (int mt = 0; mt < 4; ++mt) _Pragma("unroll") for (int q = 0; q < 4; ++q) { const v2u w = nf[cur][mt][q]; acc[mt][4 * q] = bflo(w.x); acc[mt][4 * q + 1] = bfhi(w.x); acc[mt][4 * q + 2] = bflo(w.y); acc[mt][4 * q + 3] = bfhi(w.y); } \
            GS_LOAD_N(cur, (n_) + 2); \
            _Pragma("unroll") for (int s = 0; s < 8; ++s) _Pragma("unroll") for (int mt = 0; mt < 4; ++mt) acc[mt] = mfma32(ldfrag(mb, ((mt * 8 + s) * 64 + lane) * 16), sf[s], acc[mt]); } \
        GS_WRITE_M(oth, oth); \
        __syncthreads(); } while (0)
    for (int n = 0; n < nch; n += 2) { GS_ITER(n, 0, 1); if (n + 1 < nch) GS_ITER(n + 1, 1, 0); }
#undef GS_ITER
#undef GS_WRITE_M
#undef GS_LOAD_N
#undef GS_LOAD_M
#undef GS_ITEM
    if (wave == 0) {
#pragma unroll
        for (int mt = 0; mt < 4; ++mt)
#pragma unroll
            for (int r = 0; r < 16; ++r) sfinal[(size_t)(32 * mt + (r & 3) + 8 * (r >> 2) + 4 * hh) * 128 + e_] = acc[mt][r];
    }
}
__device__ __forceinline__ void gdn_out_item(const Ptrs& P, LAS unsigned char* wl, int cid, int h, int lane) {
    const ChunkInfo ci = chunk_info(cid); const int item = cid * 4 + h; const int c32 = lane & 31, hh = lane >> 5;
    const unsigned char* gs = (const unsigned char*)(P.GS() + (size_t)item * 16384); const unsigned char* gq = (const unsigned char*)(P.GQH() + (size_t)item * 8192); const unsigned char* go = (const unsigned char*)(P.GOI() + (size_t)item * 8192);
#pragma unroll 1
    for (int it = 0; it < 2; ++it) { const int i = 32 * it + c32;
        bf16x8 bq[8];
#pragma unroll
        for (int s = 0; s < 8; ++s) bq[s] = *(const GAS bf16x8*)(gq + ((it * 8 + s) * 64 + lane) * 16);
        f32x16 acc[4]; float ss = 0.f;
#pragma unroll
        for (int et = 0; et < 4; ++et) {
#pragma unroll
            for (int q = 0; q < 4; ++q) { const v2u w = *(const GAS v2u*)(go + (((it * 4 + et) * 4 + q) * 64 + lane) * 8); acc[et][4 * q] = bflo(w.x); acc[et][4 * q + 1] = bfhi(w.x); acc[et][4 * q + 2] = bflo(w.y); acc[et][4 * q + 3] = bfhi(w.y); }
#pragma unroll
            for (int s = 0; s < 8; ++s) acc[et] = mfma32(*(const GAS bf16x8*)(gs + ((et * 8 + s) * 64 + lane) * 16), bq[s], acc[et]);
#pragma unroll
            for (int r = 0; r < 16; ++r) ss += acc[et][r] * acc[et][r];
        }
        ss += __shfl_xor(ss, 32);
        const float rstd = 1.0f / sqrtf(ss * (1.f / 128.f) + RMS_EPS);
#pragma unroll
        for (int et = 0; et < 4; ++et)
#pragma unroll
            for (int q = 0; q < 4; ++q) { v2u w; w.x = pk2(acc[et][4 * q] * rstd, acc[et][4 * q + 1] * rstd); w.y = pk2(acc[et][4 * q + 2] * rstd, acc[et][4 * q + 3] * rstd);
                *(LAS v2u*)(wl + i * 272 + (32 * et + 8 * q + 4 * hh) * 2) = w; }
    }
    LDS_WAIT(); asm volatile("" ::: "memory");
    {   const int e8 = (lane & 15) * 8; const f32x4 g0 = *(const f32x4*)(P.gdn_g() + e8), g1 = *(const f32x4*)(P.gdn_g() + e8 + 4);
#pragma unroll 4
        for (int k = 0; k < 16; ++k) { const int row = 4 * k + (lane >> 4);
            if (row < ci.ntok) { const int m = ci.m0 + row; float o[8], z[8];
                unpack8(*(const LAS v4u*)(wl + row * 272 + e8 * 2), o); unpack8(*(const GAS v4u*)(P.PROJ() + (size_t)m * NPROJ + OFF_Z + h * 128 + e8), z);
#pragma unroll
                for (int e = 0; e < 8; ++e) o[e] = o[e] * (e < 4 ? g0[e] : g1[e - 4]) * (z[e] * fsig(z[e]));
                *(GAS v4u*)(P.XN() + (size_t)m * DM + 512 + h * 128 + e8) = pack8(o); } }
    }
    LDS_WAIT(); asm volatile("" ::: "memory");
}
constexpr int RL_LT = 0, RL_VEC = 17408, RL_SCR = 17664, RL_IMG = 19712;
enum { RI_AL = 0, RI_BE, RI_KT, RI_RT, RI_BET, RI_KTT, RI_VT, RI_LK, RI_QRB, RI_OMT, RI_XT, RI_CM, RI_KHT };
__device__ __forceinline__ int rimg(int i) { return RL_IMG + i * 9216; }
static_assert(RL_IMG + 13 * 9216 <= LDSCTL_OFF, "rwkv prep LDS");
__device__ __forceinline__ f32x16 tile_mm(LAS unsigned char* lds, int a_img, int at, int b_img, int bt, int s0, int s1, int c32, int hh, f32x16 acc) {
    const int ao = a_img + (32 * at + c32) * 144 + hh * 16, bo = b_img + (32 * bt + c32) * 144 + hh * 16;
#pragma unroll
    for (int s = 0; s < 4; ++s) if (s >= s0 && s < s1) acc = mfma32(ldfrag(lds, ao + s * 32), ldfrag(lds, bo + s * 32), acc);
    return acc;
}
__device__ __forceinline__ void rwkv_prep_item(const Ptrs& P, LAS unsigned char* lds, int cid, int h, int tid) {
    const ChunkInfo ci = chunk_info(cid); const int item = cid * 8 + h;
    int lane = tid & 63, wave = __builtin_amdgcn_readfirstlane(tid >> 6), c32 = lane & 31, hh = lane >> 5;
#define OPAQUE_LANE() do { asm volatile("" : "+v"(lane)); asm volatile("" : "+s"(wave)); c32 = lane & 31; hh = lane >> 5; } while (0)
    LAS float* pc = (LAS float*)(lds + RL_VEC); LAS float* scr = (LAS float*)(lds + RL_SCR);
#ifndef DUP_R1
#define DUP_R1 1
#endif
#ifndef DUP_R2
#define DUP_R2 1
#endif
#ifndef DUP_R3
#define DUP_R3 1
#endif
#ifndef DUP_R4
#define DUP_R4 1
#endif
    for (int d_ = 0; d_ < DUP_R1; ++d_) {   const int ch = lane, col = h * 64 + ch; const int tk0 = 8 * wave;
        const float mur = P.mu()[col], muk = P.mu()[512 + col], muv = P.mu()[1024 + col], kkc = P.k_k()[col], kac = P.k_a()[col];
        float fr[9], fk[9], fv[9];
#pragma unroll
        for (int i = 0; i < 9; ++i) { const int tk = tk0 - 1 + i; const int tseq = ci.n * 64 + tk; float a = 0.f, b = 0.f, c = 0.f;
            if (tk < ci.ntok) {
                if (tseq >= 0) { const bf16* pr = P.PROJ() + (size_t)(ci.m0 + tk) * NPROJ + col; a = __uint_as_float((unsigned)pr[0] << 16); b = __uint_as_float((unsigned)pr[512] << 16); c = __uint_as_float((unsigned)pr[1024] << 16); }
                else if (ci.sb >= 0) { const float* sp = P.sshift() + (size_t)ci.sb * RPROJ + col; a = sp[0]; b = sp[512]; c = sp[1024]; } }
            fr[i] = a; fk[i] = b; fv[i] = c; }
        float xs[8], av[8], rnv[8];
#pragma unroll
        for (int i = 0; i < 8; ++i) { const int tk = tk0 + i; xs[i] = 0.f; av[i] = 0.f; rnv[i] = 0.f;
            if (tk < ci.ntok) { const size_t m = (size_t)(ci.m0 + tk); xs[i] = __uint_as_float((unsigned)P.XA()[m * 512 + col] << 16); av[i] = __uint_as_float((unsigned)P.AA()[m * 512 + col] << 16); rnv[i] = P.RN()[m * 8 + h]; } }
        float cum[8]; float run = 0.f;
#pragma unroll
        for (int i = 0; i < 8; ++i) { run += xs[i]; cum[i] = run; }
        scr[wave * 64 + ch] = run;
        __syncthreads();
        float off = 0.f;
#pragma unroll
        for (int w2 = 0; w2 < 8; ++w2) if (w2 < wave) off += scr[w2 * 64 + ch];
        float be[8], kt[8], vv[8];
#pragma unroll
        for (int i = 0; i < 8; ++i) { const int tk = tk0 + i; const bool valid = tk < ci.ntok;
            const float r = fr[i + 1] + (fr[i] - fr[i + 1]) * mur, k = fk[i + 1] + (fk[i] - fk[i + 1]) * muk, v = fv[i + 1] + (fv[i] - fv[i + 1]) * muv;
            const float c1 = off + cum[i], c0 = c1 - xs[i]; const float kap = k * kkc * rnv[i], keff = k * (1.f + (av[i] - 1.f) * kac);
            const float ec = __expf(c1);
            const float al = valid ? kap * __expf(-c0) : 0.f, b_ = valid ? kap * av[i] * ec : 0.f, kt_ = valid ? keff * ec : 0.f, rt = valid ? r * __expf(-c1) : 0.f;
            be[i] = b_; kt[i] = kt_; vv[i] = valid ? v : 0.f;
            *(LAS unsigned short*)(lds + rimg(RI_AL) + tk * 144 + ch * 2) = (unsigned short)f2bf(al);
            *(LAS unsigned short*)(lds + rimg(RI_BE) + tk * 144 + ch * 2) = (unsigned short)f2bf(b_);
            *(LAS unsigned short*)(lds + rimg(RI_KT) + tk * 144 + ch * 2) = (unsigned short)f2bf(kt_);
            *(LAS unsigned short*)(lds + rimg(RI_RT) + tk * 144 + ch * 2) = (unsigned short)f2bf(rt);
            if (tk == 63) pc[ch] = __expf(-c1); }
        *(LAS v4u*)(lds + rimg(RI_BET) + ch * 144 + tk0 * 2) = pack8(be);
        *(LAS v4u*)(lds + rimg(RI_KTT) + ch * 144 + tk0 * 2) = pack8(kt);
        *(LAS v4u*)(lds + rimg(RI_VT) + ch * 144 + tk0 * 2) = pack8(vv);
    }
    __syncthreads();
    OPAQUE_LANE();
    for (int d_ = 0; d_ < DUP_R2; ++d_)
#pragma unroll 1
    for (int task = wave; task < 11; task += 8) {
        if (task < 9) { const int type = task / 3, tl = task % 3, ti = tl == 1 ? 0 : 1, tj = tl == 2 ? 1 : 0;
            if (type == 0) { const f32x16 acc = tile_mm(lds, rimg(RI_AL), ti, rimg(RI_BE), tj, 0, 4, c32, hh, zero16()); const int j = 32 * tj + c32;
#pragma unroll
                for (int q = 0; q < 4; ++q) { f32x4 o;
#pragma unroll
                    for (int e = 0; e < 4; ++e) { const int t = 32 * ti + 8 * q + 4 * hh + e; o[e] = t > j ? acc[4 * q + e] : 0.f; }
                    *(LAS f32x4*)(lds + RL_LT + j * 272 + (32 * ti + 8 * q + 4 * hh) * 4) = o; } }
            else if (type == 1) { const f32x16 acc = tile_mm(lds, rimg(RI_AL), ti, rimg(RI_KT), tj, 0, 4, c32, hh, zero16()); const int j = 32 * tj + c32;
#pragma unroll
                for (int r = 0; r < 16; ++r) { const int t = 32 * ti + (r & 3) + 8 * (r >> 2) + 4 * hh; *(LAS unsigned short*)(lds + rimg(RI_LK) + t * 144 + j * 2) = (unsigned short)f2bf(t > j ? acc[r] : 0.f); } }
            else { const f32x16 acc = tile_mm(lds, rimg(RI_BE), tj, rimg(RI_RT), ti, 0, 4, c32, hh, zero16()); const int t = 32 * ti + c32;
#pragma unroll
                for (int q = 0; q < 4; ++q) { float o[4];
#pragma unroll
                    for (int e = 0; e < 4; ++e) { const int j = 32 * tj + 8 * q + 4 * hh + e; o[e] = j <= t ? acc[4 * q + e] : 0.f; }
                    v2u w; w.x = pk2(o[0], o[1]); w.y = pk2(o[2], o[3]); *(LAS v2u*)(lds + rimg(RI_QRB) + t * 144 + (32 * tj + 8 * q + 4 * hh) * 2) = w; } }
        } else { const int img = task == 9 ? RI_LK : RI_QRB;
            LAS unsigned char* dst = lds + rimg(img) + (lane >> 1) * 144 + 64 + (lane & 1) * 32;
            *(LAS v4u*)dst = (v4u){0u, 0u, 0u, 0u}; *(LAS v4u*)(dst + 16) = (v4u){0u, 0u, 0u, 0u}; }
    }
    __syncthreads();
    OPAQUE_LANE();
    for (int d_ = 0; d_ < DUP_R3; ++d_)
    if (wave < 2) {
        const int col = lane; LAS unsigned char* xout = lds + rimg(wave == 0 ? RI_OMT : RI_XT) + col * 144; const LAS unsigned char* src = lds + rimg(wave == 0 ? RI_AL : RI_LK) + col * 2;
#pragma unroll 1
        for (int bb = 0; bb < 4; ++bb) {
            float X[16];
#pragma unroll
            for (int i = 0; i < 16; ++i) X[i] = __uint_as_float((unsigned)(*(const LAS unsigned short*)(src + (16 * bb + i) * 144)) << 16);
#pragma unroll 1
            for (int jb = 0; jb < 2 * bb; ++jb) { float xj[8]; unpack8(*(const LAS v4u*)(xout + jb * 16), xj);
#pragma unroll
                for (int jj = 0; jj < 8; ++jj) { const LAS unsigned char* ar = lds + RL_LT + (8 * jb + jj) * 272 + bb * 64;
#pragma unroll
                    for (int g4 = 0; g4 < 4; ++g4) { const f32x4 a4 = *(const LAS f32x4*)(ar + g4 * 16);
#pragma unroll
                        for (int e = 0; e < 4; ++e) X[4 * g4 + e] = fmaf(-a4[e], xj[jj], X[4 * g4 + e]); } } }
#pragma unroll
            for (int j = 0; j < 15; ++j) { const LAS unsigned char* ar = lds + RL_LT + (16 * bb + j) * 272 + bb * 64;
#pragma unroll
                for (int g4 = (j + 1) >> 2; g4 < 4; ++g4) { const f32x4 a4 = *(const LAS f32x4*)(ar + g4 * 16);
#pragma unroll
                    for (int e = 0; e < 4; ++e) { const int i = 4 * g4 + e; if (i > j) X[i] = fmaf(-a4[e], X[j], X[i]); } } }
            {   float o[8];
#pragma unroll
                for (int i = 0; i < 8; ++i) o[i] = X[i];
                *(LAS v4u*)(xout + bb * 32) = pack8(o);
#pragma unroll
                for (int i = 0; i < 8; ++i) o[i] = X[8 + i];
                *(LAS v4u*)(xout + bb * 32 + 16) = pack8(o); }
            LDS_WAIT(); asm volatile("" ::: "memory");
        }
    }
    __syncthreads();
    OPAQUE_LANE();
    for (int d_ = 0; d_ < DUP_R4; ++d_)
    {   bf16* RRH = P.RRH() + (size_t)item * 4096; bf16* RPHI = P.RPHI() + (size_t)item * 4096;
#pragma unroll 1
        for (int task = wave; task < 16; task += 8) { const int type = task >> 2, ta = (task >> 1) & 1, tb = task & 1;
            if (type == 0) {
                const int t = 32 * tb + c32; v2u w[4];
                if (ta <= tb) { const f32x16 acc = tile_mm(lds, rimg(RI_KT), ta, rimg(RI_RT), tb, 0, 4, c32, hh, zero16());
                    const f32x16 acx = tile_mm(lds, rimg(RI_XT), ta, rimg(RI_QRB), tb, 0, 4, c32, hh, zero16());
#pragma unroll
                    for (int q = 0; q < 4; ++q) { float o[4];
#pragma unroll
                        for (int e = 0; e < 4; ++e) { const int j = 32 * ta + 8 * q + 4 * hh + e; o[e] = (j <= t ? acc[4 * q + e] : 0.f) - acx[4 * q + e]; }
                        w[q].x = pk2(o[0], o[1]); w[q].y = pk2(o[2], o[3]); } }
                else {
#pragma unroll
                    for (int q = 0; q < 4; ++q) w[q] = (v2u){0u, 0u}; }
#pragma unroll
                for (int q = 0; q < 4; ++q) *(LAS v2u*)(lds + rimg(RI_CM) + t * 144 + (32 * ta + 8 * q + 4 * hh) * 2) = w[q]; }
            else if (type == 1) {
                const int t = 32 * tb + c32; const f32x16 acc = tile_mm(lds, rimg(RI_OMT), ta, rimg(RI_QRB), tb, 0, 4, c32, hh, zero16());
#pragma unroll
                for (int q = 0; q < 4; ++q) { const int k = 32 * ta + 8 * q + 4 * hh; const v2u rr = *(const LAS v2u*)(lds + rimg(RI_RT) + t * 144 + k * 2);
                    v2u w; w.x = pk2(bflo(rr.x) - acc[4 * q], bfhi(rr.x) - acc[4 * q + 1]); w.y = pk2(bflo(rr.y) - acc[4 * q + 2], bfhi(rr.y) - acc[4 * q + 3]);
                    *(GAS v2u*)((unsigned char*)RRH + ((tb * 4 + 2 * ta + (q >> 1)) * 64 + lane) * 16 + (q & 1) * 8) = w; } }
            else if (type == 2) {
                const int k = 32 * tb + c32; const float pk = pc[k]; const f32x16 acc = tile_mm(lds, rimg(RI_XT), ta, rimg(RI_BET), tb, 0, 4, c32, hh, zero16());
#pragma unroll
                for (int q = 0; q < 4; ++q) { const int j = 32 * ta + 8 * q + 4 * hh; const v2u kk = *(const LAS v2u*)(lds + rimg(RI_KTT) + k * 144 + j * 2);
                    v2u w; w.x = pk2((bflo(kk.x) - acc[4 * q]) * pk, (bfhi(kk.x) - acc[4 * q + 1]) * pk); w.y = pk2((bflo(kk.y) - acc[4 * q + 2]) * pk, (bfhi(kk.y) - acc[4 * q + 3]) * pk);
                    *(LAS v2u*)(lds + rimg(RI_KHT) + k * 144 + j * 2) = w; } }
            else {
                const int k = 32 * tb + c32; const float pk = pc[k]; const f32x16 acc = tile_mm(lds, rimg(RI_OMT), ta, rimg(RI_BET), tb, 0, 4, c32, hh, zero16());
#pragma unroll
                for (int q = 0; q < 4; ++q) { float o[4];
#pragma unroll
                    for (int e = 0; e < 4; ++e) { const int kp = 32 * ta + 8 * q + 4 * hh + e; o[e] = ((kp == k ? 1.f : 0.f) - acc[4 * q + e]) * pk; }
                    v2u w; w.x = pk2(o[0], o[1]); w.y = pk2(o[2], o[3]);
                    *(GAS v2u*)((unsigned char*)RPHI + ((tb * 4 + 2 * ta + (q >> 1)) * 64 + lane) * 16 + (q & 1) * 8) = w; } }
        }
    }
    __syncthreads();
    OPAQUE_LANE();
    {   const int type = wave >> 2, ta = (wave >> 1) & 1, tb = wave & 1;
        if (type == 0) {
            const int v = 32 * tb + c32; const f32x16 acc = tile_mm(lds, rimg(RI_KHT), ta, rimg(RI_VT), tb, 0, 4, c32, hh, zero16()); bf16* RPSI = P.RPSI() + (size_t)item * 4096;
#pragma unroll
            for (int q = 0; q < 4; ++q) { v2u w; w.x = pk2(acc[4 * q], acc[4 * q + 1]); w.y = pk2(acc[4 * q + 2], acc[4 * q + 3]); *(GAS v2u*)((unsigned char*)RPSI + (((tb * 2 + ta) * 4 + q) * 64 + lane) * 8) = w; } }
        else {
            const int t = 32 * tb + c32; const f32x16 acc = tile_mm(lds, rimg(RI_VT), ta, rimg(RI_CM), tb, 0, 4, c32, hh, zero16()); bf16* RYI = P.RYI() + (size_t)item * 4096;
#pragma unroll
            for (int q = 0; q < 4; ++q) { v2u w; w.x = pk2(acc[4 * q], acc[4 * q + 1]); w.y = pk2(acc[4 * q + 2], acc[4 * q + 3]); *(GAS v2u*)((unsigned char*)RYI + (((tb * 2 + ta) * 4 + q) * 64 + lane) * 8) = w; } }
    }
    __syncthreads();
#undef OPAQUE_LANE
}
__device__ __forceinline__ void rwkv_serial_job(const Ptrs& P, int item0, int istride, int nch, const float* s0, float* sfinal, int wsel, int lane) {
    const int c32 = lane & 31, hh = lane >> 5, v = 32 * wsel + c32;
    f32x16 acc[2];
#pragma unroll
    for (int mt = 0; mt < 2; ++mt)
#pragma unroll
        for (int r = 0; r < 16; ++r) acc[mt][r] = s0 ? s0[(size_t)v * 64 + 32 * mt + (r & 3) + 8 * (r >> 2) + 4 * hh] : 0.f;
    bf16x8 af[3][2][4]; v2u pf[3][2][4];
#define RS_ITEM(n_) (item0 + ((n_) < nch ? (n_) : nch - 1) * istride)
#define RS_LOAD(set, n_) do { const unsigned char* ph_ = (const unsigned char*)(P.RPHI() + (size_t)RS_ITEM(n_) * 4096); const unsigned char* ps_ = (const unsigned char*)(P.RPSI() + (size_t)RS_ITEM(n_) * 4096); \
        _Pragma("unroll") for (int mt = 0; mt < 2; ++mt) _Pragma("unroll") for (int s = 0; s < 4; ++s) { af[set][mt][s] = *(const GAS bf16x8*)(ph_ + ((mt * 4 + s) * 64 + lane) * 16); pf[set][mt][s] = *(const GAS v2u*)(ps_ + (((wsel * 2 + mt) * 4 + s) * 64 + lane) * 8); } } while (0)
#define RS_ITER(n_, set) do { bf16x8 sf[4]; unsigned char* rs = (unsigned char*)(P.RS() + (size_t)RS_ITEM(n_) * 4096); \
        _Pragma("unroll") for (int mt = 0; mt < 2; ++mt) _Pragma("unroll") for (int s2 = 0; s2 < 2; ++s2) { v4u w; w.x = pk2(acc[mt][8 * s2], acc[mt][8 * s2 + 1]); w.y = pk2(acc[mt][8 * s2 + 2], acc[mt][8 * s2 + 3]); w.z = pk2(acc[mt][8 * s2 + 4], acc[mt][8 * s2 + 5]); w.w = pk2(acc[mt][8 * s2 + 6], acc[mt][8 * s2 + 7]); \
            sf[2 * mt + s2] = __builtin_bit_cast(bf16x8, w); *(GAS v4u*)(rs + ((wsel * 4 + 2 * mt + s2) * 64 + lane) * 16) = w; } \
        _Pragma("unroll") for (int mt = 0; mt < 2; ++mt) _Pragma("unroll") for (int q = 0; q < 4; ++q) { const v2u w = pf[set][mt][q]; acc[mt][4 * q] = bflo(w.x); acc[mt][4 * q + 1] = bfhi(w.x); acc[mt][4 * q + 2] = bflo(w.y); acc[mt][4 * q + 3] = bfhi(w.y); } \
        _Pragma("unroll") for (int s = 0; s < 4; ++s) _Pragma("unroll") for (int mt = 0; mt < 2; ++mt) acc[mt] = mfma32(af[set][mt][s], sf[s], acc[mt]); \
        RS_LOAD(set, (n_) + 3); } while (0)
    RS_LOAD(0, 0); RS_LOAD(1, 1); RS_LOAD(2, 2);
    for (int n = 0; n < nch; n += 3) { RS_ITER(n, 0); if (n + 1 < nch) RS_ITER(n + 1, 1); if (n + 2 < nch) RS_ITER(n + 2, 2); }
#undef RS_ITER
#undef RS_LOAD
#undef RS_ITEM
#pragma unroll
    for (int mt = 0; mt < 2; ++mt)
#pragma unroll
        for (int q = 0; q < 4; ++q) *(f32x4*)(sfinal + (size_t)v * 64 + 32 * mt + 8 * q + 4 * hh) = (f32x4){acc[mt][4 * q], acc[mt][4 * q + 1], acc[mt][4 * q + 2], acc[mt][4 * q + 3]};
}
__device__ __forceinline__ void rwkv_out_item(const Ptrs& P, LAS unsigned char* wl, int cid, int h, int lane) {
    const ChunkInfo ci = chunk_info(cid); const int item = cid * 8 + h; const int c32 = lane & 31, hh = lane >> 5;
    const unsigned char* rs = (const unsigned char*)(P.RS() + (size_t)item * 4096); const unsigned char* rh = (const unsigned char*)(P.RRH() + (size_t)item * 4096); const unsigned char* yi = (const unsigned char*)(P.RYI() + (size_t)item * 4096);
#pragma unroll 1
    for (int tb = 0; tb < 2; ++tb) { const int t = 32 * tb + c32;
        bf16x8 bq[4];
#pragma unroll
        for (int s = 0; s < 4; ++s) bq[s] = *(const GAS bf16x8*)(rh + ((tb * 4 + s) * 64 + lane) * 16);
        f32x16 acc[2]; float sm = 0.f;
#pragma unroll
        for (int vt = 0; vt < 2; ++vt) {
#pragma unroll
            for (int q = 0; q < 4; ++q) { const v2u w = *(const GAS v2u*)(yi + (((tb * 2 + vt) * 4 + q) * 64 + lane) * 8); acc[vt][4 * q] = bflo(w.x); acc[vt][4 * q + 1] = bfhi(w.x); acc[vt][4 * q + 2] = bflo(w.y); acc[vt][4 * q + 3] = bfhi(w.y); }
#pragma unroll
            for (int s = 0; s < 4; ++s) acc[vt] = mfma32(*(const GAS bf16x8*)(rs + ((vt * 4 + s) * 64 + lane) * 16), bq[s], acc[vt]);
#pragma unroll
            for (int r = 0; r < 16; ++r) sm += acc[vt][r];
        }
        sm += __shfl_xor(sm, 32); const float mean = sm * (1.f / 64.f); float sq = 0.f;
#pragma unroll
        for (int vt = 0; vt < 2; ++vt)
#pragma unroll
            for (int r = 0; r < 16; ++r) { acc[vt][r] -= mean; sq += acc[vt][r] * acc[vt][r]; }
        sq += __shfl_xor(sq, 32); const float rstd = 1.0f / sqrtf(sq * (1.f / 64.f) + GN_EPS);
#pragma unroll
        for (int vt = 0; vt < 2; ++vt)
#pragma unroll
            for (int q = 0; q < 4; ++q) { v2u w; w.x = pk2(acc[vt][4 * q] * rstd, acc[vt][4 * q + 1] * rstd); w.y = pk2(acc[vt][4 * q + 2] * rstd, acc[vt][4 * q + 3] * rstd);
                *(LAS v2u*)(wl + t * 144 + (32 * vt + 8 * q + 4 * hh) * 2) = w; }
    }
    LDS_WAIT(); asm volatile("" ::: "memory");
    {   const int c0 = h * 64 + (lane & 7) * 8;
#pragma unroll 2
        for (int kk = 0; kk < 8; ++kk) { const int row = 8 * kk + (lane >> 3);
            if (row < ci.ntok) { const int m = ci.m0 + row; int t, sb; row_info(m, t, sb);
                float y[8], r[8], k[8], v[8], a[8], g[8];
                unpack8(*(const LAS v4u*)(wl + row * 144 + (lane & 7) * 16), y);
                load_fm8(P, m, t, sb, c0, r); load_fm8(P, m, t, sb, 512 + c0, k); load_fm8(P, m, t, sb, 1024 + c0, v);
                unpack8(*(const GAS v4u*)(P.AA() + (size_t)m * 512 + c0), a); unpack8(*(const GAS v4u*)(P.GA() + (size_t)m * 512 + c0), g);
                float rk = 0.f;
#pragma unroll
                for (int i = 0; i < 8; ++i) rk += r[i] * k[i] * (1.f + (a[i] - 1.f) * P.k_a()[c0 + i]) * P.r_k()[c0 + i];
                rk += __shfl_xor(rk, 1); rk += __shfl_xor(rk, 2); rk += __shfl_xor(rk, 4);
                float o[8];
#pragma unroll
                for (int i = 0; i < 8; ++i) o[i] = (y[i] * P.lnx_w()[c0 + i] + P.lnx_b()[c0 + i] + rk * v[i]) * g[i];
                *(GAS v4u*)(P.XN() + (size_t)m * DM + c0) = pack8(o); } }
    }
    LDS_WAIT(); asm volatile("" ::: "memory");
}
struct MiniOp { const bf16* A; int lda; int K; };
template <int NB, class BRow0, class BRow1, class Epi>
__device__ __forceinline__ void mini_tile(LAS unsigned char* lds, const MiniOp o0, const MiniOp o1, int mt, BRow0 brow0, BRow1 brow1, Epi epi, int tid) {
    const int lane = tid & 63, wave = __builtin_amdgcn_readfirstlane(tid >> 6), c32 = lane & 31, hh = lane >> 5;
    f32x16 acc[NB];
#pragma unroll
    for (int b = 0; b < NB; ++b) { acc[b] = zero16();
        const MiniOp o = b == 0 ? o0 : o1; const int kw = o.K >> 3, k0 = wave * kw;
        const bf16* ap = o.A + (size_t)(32 * mt + c32) * o.lda + k0 + 8 * hh; const bf16* bp = (b == 0 ? brow0(c32) : brow1(c32)) + k0 + 8 * hh;
#pragma unroll 4
        for (int s = 0; s < kw; s += 16) acc[b] = mfma32(*(const GAS bf16x8*)(ap + s), *(const GAS bf16x8*)(bp + s), acc[b]);
    }
    LAS float* part = (LAS float*)lds;
#pragma unroll
    for (int b = 0; b < NB; ++b)
#pragma unroll
        for (int r = 0; r < 16; ++r) part[((wave * NB + b) * 16 + r) * 64 + lane] = acc[b][r];
    __syncthreads();
#pragma unroll
    for (int i = 0; i < 2; ++i) { const int e = tid + 512 * i, reg = e >> 6, ln = e & 63; float v[NB];
#pragma unroll
        for (int b = 0; b < NB; ++b) { float s = 0.f;
#pragma unroll
            for (int w = 0; w < 8; ++w) s += part[((w * NB + b) * 16 + reg) * 64 + ln];
            v[b] = s; }
        epi(32 * mt + (reg & 3) + 8 * (reg >> 2) + 4 * (ln >> 5), ln & 31, v[0], v[NB - 1]); }
    __syncthreads();
}
__device__ __forceinline__ float sample_rstd(const float* ssq, int ms) { const f32x4* p = (const f32x4*)(ssq + (size_t)ms * 32); float s = 0.f;
#pragma unroll
    for (int i = 0; i < 8; ++i) { const f32x4 a = p[i]; s += (a.x + a.y) + (a.z + a.w); }
    return 1.0f / sqrtf(s * (1.f / DM) + RMS_EPS); }
__device__ __forceinline__ float half_wave_sum32(float v) { v += __shfl_xor(v, 1); v += __shfl_xor(v, 2); v += __shfl_xor(v, 4); v += __shfl_xor(v, 8); v += __shfl_xor(v, 16); return v; }
__device__ __forceinline__ void mini_lora(const Ptrs& P, LAS unsigned char* lds, int vcu, int G, int tid) {
    for (int t = vcu; t < 8 * 48; t += G) { const int mt = t & 7, nt = t >> 3;
        const bf16* W = P.Wlora_t(); const float* w0 = P.w0(); const float* a0 = P.a0(); bf16* XA = P.XA();
        auto brow = [=](int c) { return W + (size_t)(32 * nt + c) * KLORA; };
        auto epi = [=](int ms, int c, float v, float) { const int n = 32 * nt + c, part = n >> 9, cc = n & 511; float o = v;
            if (part == 0) { const float z = -(v + w0[cc]); o = __expf(-fsoftplus(z) - 0.5f); } else if (part == 1) o = fsig(v + a0[cc]);
            XA[(size_t)part * ((WS_AA - WS_XA) / 2) + (size_t)(MP + ms) * 512 + cc] = (bf16)f2bf(o); };
        mini_tile<1>(lds, MiniOp{P.LIN() + (size_t)MP * KLORA, KLORA, KLORA}, MiniOp{nullptr, 0, 0}, mt, brow, brow, epi, tid); }
}
__device__ __forceinline__ void mini_outproj(const Ptrs& P, LAS unsigned char* lds, int vcu, int G, int tid) {
    for (int t = vcu; t < 8 * 32; t += G) { const int mt = t & 7, nt = t >> 3;
        const bf16* W = P.Wout_t(); const float* xs = P.xs(); float* out = P.out() + (size_t)MP * DM; bf16* xb = P.PROJ() + (size_t)MP * DM; float* ssq = P.SSQS2();
        auto brow = [=](int c) { return W + (size_t)(32 * nt + c) * DM; };
        auto epi = [=](int ms, int c, float v, float) { const size_t o = (size_t)ms * DM + 32 * nt + c; const float x2 = xs[o] + v; out[o] = x2; xb[o] = (bf16)f2bf(x2);
            const float s = half_wave_sum32(x2 * x2); if (c == 0) ssq[(size_t)ms * 32 + nt] = s; };
        mini_tile<1>(lds, MiniOp{P.XN() + (size_t)MP * DM, DM, DM}, MiniOp{nullptr, 0, 0}, mt, brow, brow, epi, tid); }
}
__device__ __forceinline__ void mini_gateup(const Ptrs& P, LAS unsigned char* lds, int vcu, int G, int tid) {
    for (int t = vcu; t < 8 * 88; t += G) { const int mt = t & 7, nt = t >> 3;
        const bf16* W = P.Wgu_t(); bf16* act = P.ACT() + (size_t)MP * DFF; const float* ssq = P.SSQS2();
        auto brow0 = [=](int c) { return W + (size_t)gu_row(32 * nt + c, 0) * DM; };
        auto brow1 = [=](int c) { return W + (size_t)gu_row(32 * nt + c, 1) * DM; };
        auto epi = [=](int ms, int c, float g, float u) { const float rs = sample_rstd(ssq, ms); const float gg = g * rs; act[(size_t)ms * DFF + 32 * nt + c] = (bf16)f2bf(gg * fsig(gg) * (u * rs)); };
        const MiniOp o{P.PROJ() + (size_t)MP * DM, DM, DM};
        mini_tile<2>(lds, o, o, mt, brow0, brow1, epi, tid); }
}
__device__ __forceinline__ void mini_down(const Ptrs& P, LAS unsigned char* lds, int vcu, int G, int tid) {
    for (int t = vcu; t < 8 * 32; t += G) { const int mt = t & 7, nt = t >> 3;
        const bf16* W = P.Wdown_t(); float* out = P.out() + (size_t)MP * DM; bf16* xb = P.XN() + (size_t)MP * DM; float* ssq = P.SSQS3();
        auto brow = [=](int c) { return W + (size_t)(32 * nt + c) * DFF; };
        auto epi = [=](int ms, int c, float v, float) { const size_t o = (size_t)ms * DM + 32 * nt + c; const float x3 = out[o] + v; out[o] = x3; xb[o] = (bf16)f2bf(x3);
            const float s = half_wave_sum32(x3 * x3); if (c == 0) ssq[(size_t)ms * 32 + nt] = s; };
        mini_tile<1>(lds, MiniOp{P.ACT() + (size_t)MP * DFF, DFF, DFF}, MiniOp{nullptr, 0, 0}, mt, brow, brow, epi, tid); }
}
__device__ __forceinline__ void mini_ple(const Ptrs& P, LAS unsigned char* lds, int vcu, int G, int tid) {
    for (int t = vcu; t < 8 * 32; t += G) { const int mt = t & 7, nt = t >> 3;
        const bf16* Wg = P.Wpg_t(); const bf16* Wp = P.Wpp_t(); float* out = P.out() + (size_t)MP * DM; const float* ssq = P.SSQS3();
        auto brow0 = [=](int c) { return Wg + (size_t)(32 * nt + c) * DM; };
        auto brow1 = [=](int c) { return Wp + (size_t)(32 * nt + c) * DPLE; };
        auto epi = [=](int ms, int c, float gl, float pp) { const size_t o = (size_t)ms * DM + 32 * nt + c; out[o] = out[o] + fsig(gl * sample_rstd(ssq, ms)) * pp; };
        mini_tile<2>(lds, MiniOp{P.XN() + (size_t)MP * DM, DM, DM}, MiniOp{P.PB() + (size_t)MP * DPLE, DPLE, DPLE}, mt, brow0, brow1, epi, tid); }
}
#ifndef MK_N_LAUNCHES
#define MK_N_LAUNCHES 1
#endif
constexpr int PER_PHASE = 16;
constexpr int N_LAUNCHES = MK_N_LAUNCHES;
__global__ void __launch_bounds__(NWAVES * 64, 2) hybrid_fwd(Args args) {
    extern __shared__ __attribute__((aligned(16))) unsigned char lds_raw[];
    LAS unsigned char* lds = (LAS unsigned char*)lds_raw;
    volatile LAS unsigned* MISC = (volatile LAS unsigned*)(lds + MISC_OFF);
    const int tid = threadIdx.x, lane = tid & 63, wave = __builtin_amdgcn_readfirstlane(tid >> 6);
    const int G = gridDim.x; const int bx = blockIdx.x; const int vcu = (G % 8 == 0) ? (bx % 8) * (G / 8) + bx / 8 : bx;
    const int gw = vcu * NWAVES + wave, NGW = G * NWAVES;
    gu32* ctl = (gu32*)(args.ws + WS_CTL);
    for (int u = tid; u < (LDS_BYTES - LDSCTL_OFF) / 4; u += NWAVES * 64) ((LAS unsigned*)(lds + LDSCTL_OFF))[u] = 0u;
    __syncthreads();
    XcdBarrier bar; bar.bar = (unsigned*)(ctl + CW_BAR); bar.x = 0; bar.st = nullptr;
    if (N_LAUNCHES != PER_PHASE) bar = xcd_barrier_post((unsigned*)(ctl + CW_BAR), MISC + 8);
#define GRID_BAR() do { if (N_LAUNCHES != PER_PHASE) xcd_barrier(bar); } while (0)
    const int lo = args.ph_lo, hi = args.ph_hi;
#ifndef PHASE_MASK
#define PHASE_MASK 0xFFFF
#endif
#define IN(k) (((PHASE_MASK >> (k)) & 1) && lo <= (k) && (k) < hi)
#define BOTH(k) (IN(k) && IN((k) + 1))
#ifndef REPEAT_MASK
#define REPEAT_MASK 0
#endif
#define REPS(k) ((((REPEAT_MASK) >> (k)) & 1) ? 2 : 1)
#define PHASE_PTRS() const __attribute__((address_space(4))) Args* ap_ = (const __attribute__((address_space(4))) Args*)__builtin_amdgcn_kernarg_segment_ptr(); asm volatile("" : "+s"(ap_)); const Ptrs P{ap_}
    if (IN(0)) { PHASE_PTRS(); for (int rep_ = 0; rep_ < REPS(0); ++rep_) {  p0_prologue(P, lds, gw, NGW, wave, lane); } if (BOTH(0)) GRID_BAR(); }
    if (IN(1)) { PHASE_PTRS(); for (int rep_ = 0; rep_ < REPS(1); ++rep_) {  pg8::Gemm g{P.XN(), P.Win_t(), MROWS, NPROJ, DM}; pg8::StaticOrder S; S.init(MROWS, NPROJ, G, bx); pg8::EpiBf16P E{P.PROJ(), NPROJ};
        pg8::gemm_phase<pg8::EpiBf16P, pg8::StaticOrder, true, true>(lds + RING_OFF, g, S, E); } if (BOTH(1)) GRID_BAR(); }
    if (IN(2)) { PHASE_PTRS(); for (int rep_ = 0; rep_ < REPS(2); ++rep_) {  p2_token_prep(P, gw, NGW, lane); } if (BOTH(2)) GRID_BAR(); }
    if (IN(3)) { PHASE_PTRS(); for (int rep_ = 0; rep_ < REPS(3); ++rep_) {  mini_lora(P, lds, vcu, G, tid); pg8::Gemm g{P.LIN(), P.Wlora_t(), MP, NLORA, KLORA}; pg8::StaticOrder S; S.init(MP, NLORA, G, bx); pg8::EpiLora E{P.XA(), (WS_AA - WS_XA) / 2, P.w0(), P.a0()}; static_assert(WS_GA - WS_AA == WS_AA - WS_XA, "x|a|g spacing");
        pg8::gemm_phase<pg8::EpiLora, pg8::StaticOrder, true, true>(lds + RING_OFF, g, S, E); } if (BOTH(3)) GRID_BAR(); }
    if (IN(4)) { PHASE_PTRS(); for (int rep_ = 0; rep_ < REPS(4); ++rep_) {  for (int it = vcu; it < NITEM_R; it += G) rwkv_prep_item(P, lds, it >> 3, it & 7, tid); } if (BOTH(4)) GRID_BAR(); }
    if (IN(5)) { PHASE_PTRS(); for (int rep_ = 0; rep_ < REPS(5); ++rep_) {
        if (vcu < 32) { if (wave < 2) { const int b = vcu >> 3, h = vcu & 7; rwkv_serial_job(P, b * 128 * 8 + h, 8, 128, nullptr, P.out() + O_WKV_P + ((size_t)b * 8 + h) * 4096, wave, lane); } }
        else if (vcu < 64) { const int j = (vcu - 32) * 4 + (wave >> 1), sb = j >> 3, h = j & 7; rwkv_serial_job(P, (512 + sb) * 8 + h, 8, 1, P.swkv() + ((size_t)sb * 8 + h) * 4096, P.out() + O_WKV_S + ((size_t)sb * 8 + h) * 4096, wave & 1, lane); }
        } if (BOTH(5)) GRID_BAR(); }
    if (IN(6)) { PHASE_PTRS(); for (int rep_ = 0; rep_ < REPS(6); ++rep_) {  for (int it = gw; it < NITEM_R; it += NGW) rwkv_out_item(P, lds + wave * 9216, it >> 3, it & 7, lane); copy_state_rows(P, gw, NGW, lane); } if (BOTH(6)) GRID_BAR(); }
    if (IN(7)) { PHASE_PTRS(); for (int rep_ = 0; rep_ < REPS(7); ++rep_) {  for (int it = vcu; it < NITEM_G; it += G) gdn_prep_item(P, lds, it >> 2, it & 3, tid); } if (BOTH(7)) GRID_BAR(); }
    if (IN(8)) { PHASE_PTRS(); for (int rep_ = 0; rep_ < REPS(8); ++rep_) {
        if (vcu < 64) { const int j = vcu >> 2, b = j >> 2, h = j & 3; gdn_serial_job(P, lds, b * 128 * 4 + h, 4, 128, nullptr, P.out() + O_GDN_P + ((size_t)b * 4 + h) * 16384, vcu & 3, tid); }
        else for (int t = vcu - 64; t < 256; t += G - 64) { const int j = t >> 2, sb = j >> 2, h = j & 3; gdn_serial_job(P, lds, (512 + sb) * 4 + h, 4, 1, P.sgdn() + ((size_t)sb * 4 + h) * 16384, P.out() + O_GDN_S + ((size_t)sb * 4 + h) * 16384, t & 3, tid); } }
        if (BOTH(8)) GRID_BAR(); }
    if (IN(9)) { PHASE_PTRS(); for (int rep_ = 0; rep_ < REPS(9); ++rep_) {  for (int it = gw; it < NITEM_G; it += NGW) gdn_out_item(P, lds + wave * 17408, it >> 2, it & 3, lane);
        for (int m = gw; m < MROWS; m += NGW) { const float* pr = m < MP ? P.pp_() + (size_t)m * DPLE : P.ps_() + (size_t)(m - MP) * DPLE; const f32x4 pv = *(const f32x4*)(pr + 4 * lane);
            *(GAS unsigned long long*)(P.PB() + (size_t)m * DPLE + 4 * lane) = (unsigned long long)pk2(pv.x, pv.y) | ((unsigned long long)pk2(pv.z, pv.w) << 32); }
        } if (BOTH(9)) GRID_BAR(); }
    if (IN(10)) { PHASE_PTRS(); for (int rep_ = 0; rep_ < REPS(10); ++rep_) {  mini_outproj(P, lds, vcu, G, tid); pg8::Gemm g{P.XN(), P.Wout_t(), MP, DM, DM}; pg8::StaticOrder S; S.init(MP, DM, G, bx); pg8::EpiRes E{P.xp(), P.xs(), P.out(), P.PROJ(), P.SSQ2(), MP};
        pg8::gemm_phase<pg8::EpiRes, pg8::StaticOrder, true, true>(lds + RING_OFF, g, S, E); } if (BOTH(10)) GRID_BAR(); }
    if (IN(11)) { PHASE_PTRS(); for (int rep_ = 0; rep_ < REPS(11); ++rep_) {  mini_gateup(P, lds, vcu, G, tid); pg8::Gemm g{P.PROJ(), P.Wgu_t(), MP, NGU, DM}; pg8::StaticOrder S; S.init(MP, NGU, G, bx); pg8::EpiSwiGLU E{P.ACT(), P.SSQ2()};
        pg8::gemm_phase<pg8::EpiSwiGLU, pg8::StaticOrder, true, true>(lds + RING_OFF, g, S, E); } if (BOTH(11)) GRID_BAR(); }
    if (IN(12)) { PHASE_PTRS(); for (int rep_ = 0; rep_ < REPS(12); ++rep_) {  mini_down(P, lds, vcu, G, tid); pg8::Gemm g{P.ACT(), P.Wdown_t(), MP, DM, DFF}; pg8::StaticOrder S; S.init(MP, DM, G, bx); pg8::EpiRes E{P.out(), P.out() + (size_t)MP * DM, P.out(), P.XN(), P.SSQ3(), MP};
        pg8::gemm_phase<pg8::EpiRes, pg8::StaticOrder, true, true>(lds + RING_OFF, g, S, E); } if (BOTH(12)) GRID_BAR(); }
    if (IN(13)) { PHASE_PTRS(); for (int rep_ = 0; rep_ < REPS(13); ++rep_) {  pg8::Gemm g{P.PB(), P.Wpp_t(), MP, DM, DPLE}; pg8::StaticOrder S; S.init(MP, DM, G, bx); pg8::EpiBf16P E{P.PP(), DM};
        pg8::gemm_phase<pg8::EpiBf16P, pg8::StaticOrder, true, true>(lds + RING_OFF, g, S, E); } if (BOTH(13)) GRID_BAR(); }
    if (IN(14)) { PHASE_PTRS(); for (int rep_ = 0; rep_ < REPS(14); ++rep_) {  mini_ple(P, lds, vcu, G, tid); pg8::Gemm g{P.XN(), P.Wpg_t(), MP, DM, DM}; pg8::StaticOrder S; S.init(MP, DM, G, bx); pg8::EpiPle E{P.out(), P.PP(), P.SSQ3()};
        pg8::gemm_phase<pg8::EpiPle, pg8::StaticOrder, true, true>(lds + RING_OFF, g, S, E); } if (BOTH(14)) GRID_BAR(); }
    if (IN(15)) { PHASE_PTRS(); p_final_norm(P, gw, NGW, lane); }
#undef IN
#undef BOTH
}

extern "C" void kernel_launch(void* const* d_in, const int* in_sizes, int n_in, void* d_out, int out_size, void* d_ws, size_t ws_size, hipStream_t stream) {
    static int grid = 0;
    if (grid == 0) {
        if (n_in != 34 || in_sizes[0] != MP * DM || (size_t)out_size != O_END || ws_size < WS_END) { fprintf(stderr, "kernel_launch: unexpected shapes: n_in %d in0 %d out %d ws %zu (need %zu)\n", n_in, n_in > 0 ? in_sizes[0] : -1, out_size, ws_size, (size_t)WS_END); grid = -1; return; }
        int dev = 0, cus = 0, per_cu = 0;
        if (hipGetDevice(&dev) != hipSuccess || hipDeviceGetAttribute(&cus, hipDeviceAttributeMultiprocessorCount, dev) != hipSuccess) { grid = -1; return; }
        if (hipFuncSetAttribute((const void*)hybrid_fwd, hipFuncAttributeMaxDynamicSharedMemorySize, LDS_BYTES) != hipSuccess) { fprintf(stderr, "kernel_launch: hipFuncSetAttribute failed\n"); grid = -1; return; }
        if (hipOccupancyMaxActiveBlocksPerMultiprocessor(&per_cu, (const void*)hybrid_fwd, NWAVES * 64, LDS_BYTES) != hipSuccess || per_cu < 1) fprintf(stderr, "kernel_launch: occupancy query reports %d\n", per_cu);
        (void)hipGetLastError();
        grid = cus;
    }
    if (grid < 0) return;
    if (hipMemsetAsync((char*)d_ws + WS_CTL, 0, CTL_ZERO_BYTES, stream) != hipSuccess) { fprintf(stderr, "kernel_launch: memset failed\n"); return; }
    Args a{};
    for (int i = 0; i < 34; ++i) a.in[i] = (const float*)d_in[i];
    a.out = (float*)d_out; a.ws = (unsigned char*)d_ws;
    for (int li = 0; li < N_LAUNCHES; ++li) {
        a.ph_lo = (N_LAUNCHES == PER_PHASE) ? li : 0; a.ph_hi = (N_LAUNCHES == PER_PHASE) ? li + 1 : PER_PHASE;
        hipLaunchKernelGGL(hybrid_fwd, dim3(grid), dim3(NWAVES * 64), LDS_BYTES, stream, a);
        const hipError_t le = hipPeekAtLastError();
        if (le != hipSuccess) { fprintf(stderr, "kernel_launch: launch %d failed: %s\n", li, hipGetErrorName(le)); break; }
    }
}
```

```cpp
#include <hip/hip_runtime.h>
#include <cstdio>
#include <cstdint>
namespace pg8 {
#define PG8_LAS __attribute__((address_space(3)))
typedef unsigned short bf16_t;
typedef short bf16x8 __attribute__((ext_vector_type(8)));
typedef float f32x4 __attribute__((ext_vector_type(4)));
typedef unsigned u32x4 __attribute__((ext_vector_type(4)));
constexpr int BM = 256, BK = 64, HALF = 128, HTB = HALF * BK * 2  , STAGE_BYTES = 8 * HTB, NXCD = 8, WGM = 8;

__host__ __device__ __forceinline__ int lds_byte(int r, int c) { const int st = (r >> 4) * 2 + (c >> 5), rr = r & 15, cc = c & 31, ob = rr * 64 + cc * 2; return st * 1024 + (ob ^ (((ob >> 9) & 1) << 5)); }
__host__ __device__ __forceinline__ void stage_rc(int b, int& R, int& C) { const int st = b / 1024, sb = b % 1024, swz = sb ^ (((sb >> 9) & 1) << 5); R = (st >> 1) * 16 + swz / 64; C = (st & 1) * 32 + (swz % 64) / 2; }
__host__ __device__ __forceinline__ int perm32(int rho) { const int n = rho >> 4, i = rho & 15; return 8 * (i >> 2) + 4 * n + (i & 3); }

struct Unit { int pm, pn; };
struct Gemm { const bf16_t* A; const bf16_t* Bt; int M, N, K; };

struct StaticOrder {
    int nM, nN, nwg, G, c;
    __host__ __device__ void init(int M, int N, int G_, int c_) { nM = M / BM; nN = N / BM; nwg = nM * nN; G = G_; c = c_; }
    __host__ __device__ bool next(int i, Unit& u) const {
        const long L = (long)i * G + c; if (L >= nwg) return false;
        int wgid = (int)L; { const int q = nwg / NXCD, r = nwg % NXCD, xcd = wgid % NXCD, off = wgid / NXCD; wgid = (xcd < r ? xcd * (q + 1) : r * (q + 1) + (xcd - r) * q) + off; }
        const int nig = WGM * nN, gid = wgid / nig, fm = gid * WGM, gsz = (nM - fm) < WGM ? (nM - fm) : WGM;
        u.pm = fm + ((wgid % nig) % gsz); u.pn = (wgid % nig) / gsz; return true;
    }
    __device__ __forceinline__ void a_ready(const Unit&) const {}
    __device__ __forceinline__ void done(const Unit&) const {}
};

__device__ __forceinline__ unsigned cvt_pk_bf16(float lo, float hi) { unsigned r; asm volatile("v_cvt_pk_bf16_f32 %0, %1, %2" : "=v"(r) : "v"(lo), "v"(hi)); return r; }
typedef float f32x2 __attribute__((ext_vector_type(2)));
__device__ __forceinline__ float fsigmoid(float x) { return __builtin_amdgcn_rcpf(1.f + __builtin_amdgcn_exp2f(-1.44269504f * x)); }
struct EpiBf16P {
    static constexpr bool PERM = true, AFTER_DRAIN = false;
    bf16_t* O; int ldc;
    __device__ __forceinline__ void operator()(const f32x4 (&acc)[2][2][4][2], const Unit& u, int wr, int wc, int fr, int fq) const {
        const int row0 = u.pm * BM + wr * 64 + fr, col0 = u.pn * BM + wc * 32 + 8 * fq;
#pragma unroll
        for (int ai = 0; ai < 2; ++ai)
#pragma unroll
            for (int m = 0; m < 4; ++m) { bf16_t* rowp = O + (size_t)(row0 + ai * HALF + m * 16) * ldc + col0;
#pragma unroll
                for (int bj = 0; bj < 2; ++bj) { const f32x4 v0 = acc[ai][bj][m][0], v1 = acc[ai][bj][m][1];
                    u32x4 w; w.x = cvt_pk_bf16(v0[0], v0[1]); w.y = cvt_pk_bf16(v0[2], v0[3]); w.z = cvt_pk_bf16(v1[0], v1[1]); w.w = cvt_pk_bf16(v1[2], v1[3]);
                    *(u32x4*)(rowp + bj * HALF) = w; } }
    }
};
struct EpiRes {
    static constexpr bool PERM = true, AFTER_DRAIN = false;
    const float* base_p; const float* base_s; float* out; bf16_t* ob; float* ssq; int msplit;
    __device__ __forceinline__ void operator()(const f32x4 (&acc)[2][2][4][2], const Unit& u, int wr, int wc, int fr, int fq) const {
        const int row0 = u.pm * BM + wr * 64 + fr, col0 = u.pn * BM + wc * 32 + 8 * fq;
#pragma unroll
        for (int ai = 0; ai < 2; ++ai)
#pragma unroll
            for (int m = 0; m < 4; ++m) { const int r = row0 + ai * HALF + m * 16;
                const float* bp = (r < msplit ? base_p + (size_t)r * 1024 : base_s + (size_t)(r - msplit) * 1024) + col0;
                float* op = out + (size_t)r * 1024 + col0; bf16_t* obp = ob + (size_t)r * 1024 + col0; float s = 0.f;
#pragma unroll
                for (int bj = 0; bj < 2; ++bj) { const f32x4 b0 = *(const f32x4*)(bp + bj * HALF), b1 = *(const f32x4*)(bp + bj * HALF + 4);
                    const f32x4 v0 = acc[ai][bj][m][0] + b0, v1 = acc[ai][bj][m][1] + b1;
                    *(f32x4*)(op + bj * HALF) = v0; *(f32x4*)(op + bj * HALF + 4) = v1;
                    u32x4 w; w.x = cvt_pk_bf16(v0[0], v0[1]); w.y = cvt_pk_bf16(v0[2], v0[3]); w.z = cvt_pk_bf16(v1[0], v1[1]); w.w = cvt_pk_bf16(v1[2], v1[3]);
                    *(u32x4*)(obp + bj * HALF) = w;
                    s += (v0[0] * v0[0] + v0[1] * v0[1]) + (v0[2] * v0[2] + v0[3] * v0[3]) + (v1[0] * v1[0] + v1[1] * v1[1]) + (v1[2] * v1[2] + v1[3] * v1[3]); }
                s += __shfl_xor(s, 16); s += __shfl_xor(s, 32);
                if (fq == 0) ssq[(size_t)r * 16 + u.pn * 4 + wc] = s; }
    }
};
__device__ __forceinline__ float row_rstd16(const float* ssq, int r, int fq) {
    const f32x4 p = *(const f32x4*)(ssq + (size_t)r * 16 + 4 * fq); float s = (p[0] + p[1]) + (p[2] + p[3]);
    s += __shfl_xor(s, 16); s += __shfl_xor(s, 32); return __builtin_amdgcn_rsqf(s * (1.0f / 1024.0f) + 1e-6f);
}
struct EpiSwiGLU {
    static constexpr bool PERM = false, AFTER_DRAIN = false;
    bf16_t* O; const float* ssq;
    __device__ __forceinline__ void operator()(const f32x4 (&acc)[2][2][4][2], const Unit& u, int wr, int wc, int fr, int fq) const {
        const int row0 = u.pm * BM + wr * 64 + fr, col0 = u.pn * 128 + wc * 32 + 8 * fq;
#pragma unroll
        for (int ai = 0; ai < 2; ++ai)
#pragma unroll
            for (int m = 0; m < 4; ++m) { const int r = row0 + ai * HALF + m * 16; const float rs = row_rstd16(ssq, r, fq);
                float o[8];
#pragma unroll
                for (int bj = 0; bj < 2; ++bj)
#pragma unroll
                    for (int j = 0; j < 4; ++j) { const float g = acc[ai][bj][m][0][j] * rs, up = acc[ai][bj][m][1][j] * rs; o[4 * bj + j] = g * fsigmoid(g) * up; }
                u32x4 w; w.x = cvt_pk_bf16(o[0], o[1]); w.y = cvt_pk_bf16(o[2], o[3]); w.z = cvt_pk_bf16(o[4], o[5]); w.w = cvt_pk_bf16(o[6], o[7]);
                *(u32x4*)(O + (size_t)r * 2816 + col0) = w; }
    }
};
struct EpiPle {
    static constexpr bool PERM = true, AFTER_DRAIN = false;
    float* io; const bf16_t* pp; const float* ssq;
    __device__ __forceinline__ void operator()(const f32x4 (&acc)[2][2][4][2], const Unit& u, int wr, int wc, int fr, int fq) const {
        const int row0 = u.pm * BM + wr * 64 + fr, col0 = u.pn * BM + wc * 32 + 8 * fq;
#pragma unroll
        for (int ai = 0; ai < 2; ++ai)
#pragma unroll
            for (int m = 0; m < 4; ++m) { const int r = row0 + ai * HALF + m * 16; const float rs = row_rstd16(ssq, r, fq);
                float* op = io + (size_t)r * 1024 + col0; const bf16_t* ppp = pp + (size_t)r * 1024 + col0;
#pragma unroll
                for (int bj = 0; bj < 2; ++bj) { const f32x4 b0 = *(const f32x4*)(op + bj * HALF), b1 = *(const f32x4*)(op + bj * HALF + 4); const u32x4 pw = *(const u32x4*)(ppp + bj * HALF);
                    f32x4 v0, v1;
                    v0[0] = b0[0] + fsigmoid(acc[ai][bj][m][0][0] * rs) * __uint_as_float(pw.x << 16); v0[1] = b0[1] + fsigmoid(acc[ai][bj][m][0][1] * rs) * __uint_as_float(pw.x & 0xffff0000u);
                    v0[2] = b0[2] + fsigmoid(acc[ai][bj][m][0][2] * rs) * __uint_as_float(pw.y << 16); v0[3] = b0[3] + fsigmoid(acc[ai][bj][m][0][3] * rs) * __uint_as_float(pw.y & 0xffff0000u);
                    v1[0] = b1[0] + fsigmoid(acc[ai][bj][m][1][0] * rs) * __uint_as_float(pw.z << 16); v1[1] = b1[1] + fsigmoid(acc[ai][bj][m][1][1] * rs) * __uint_as_float(pw.z & 0xffff0000u);
                    v1[2] = b1[2] + fsigmoid(acc[ai][bj][m][1][2] * rs) * __uint_as_float(pw.w << 16); v1[3] = b1[3] + fsigmoid(acc[ai][bj][m][1][3] * rs) * __uint_as_float(pw.w & 0xffff0000u);
                    *(f32x4*)(op + bj * HALF) = v0; *(f32x4*)(op + bj * HALF + 4) = v1; } }
    }
};
struct EpiLora {
    static constexpr bool PERM = true, AFTER_DRAIN = false;
    bf16_t* XA; size_t part_stride; const float* w0; const float* a0;
    __device__ __forceinline__ void operator()(const f32x4 (&acc)[2][2][4][2], const Unit& u, int wr, int wc, int fr, int fq) const {
        const int row0 = u.pm * BM + wr * 64 + fr; const int part = u.pn >> 1; const int col0 = (u.pn & 1) * BM + wc * 32 + 8 * fq;
        bf16_t* O = XA + (size_t)part * part_stride; const float* bias = part == 0 ? w0 : a0;
        f32x4 bv[2][2];
#pragma unroll
        for (int bj = 0; bj < 2; ++bj)
#pragma unroll
            for (int n = 0; n < 2; ++n) bv[bj][n] = part < 2 ? *(const f32x4*)(bias + col0 + bj * HALF + 4 * n) : (f32x4){0.f, 0.f, 0.f, 0.f};
#pragma unroll
        for (int ai = 0; ai < 2; ++ai)
#pragma unroll
            for (int m = 0; m < 4; ++m) { bf16_t* rowp = O + (size_t)(row0 + ai * HALF + m * 16) * 512 + col0;
#pragma unroll
                for (int bj = 0; bj < 2; ++bj) { const f32x4 v0 = acc[ai][bj][m][0] + bv[bj][0], v1 = acc[ai][bj][m][1] + bv[bj][1];
                    float o[8] = {v0[0], v0[1], v0[2], v0[3], v1[0], v1[1], v1[2], v1[3]};
                    if (part == 0) {
#pragma unroll
                        for (int j = 0; j < 8; ++j) { const float z = -o[j]; const float sp = fmaxf(z, 0.f) + __logf(1.f + __expf(-fabsf(z))); o[j] = __expf(-sp - 0.5f); } }
                    else if (part == 1) {
#pragma unroll
                        for (int j = 0; j < 8; ++j) o[j] = fsigmoid(o[j]); }
                    u32x4 w; w.x = cvt_pk_bf16(o[0], o[1]); w.y = cvt_pk_bf16(o[2], o[3]); w.z = cvt_pk_bf16(o[4], o[5]); w.w = cvt_pk_bf16(o[6], o[7]);
                    *(u32x4*)(rowp + bj * HALF) = w; }
                __builtin_amdgcn_sched_barrier(0); }
    }
};

template <class Epi, class Sched, bool ALIGN_EPI = false, bool SP2 = false>
__device__ __forceinline__ void gemm_phase(PG8_LAS unsigned char* lds, const Gemm g, const Sched& S, const Epi& E) {
    const int tid = threadIdx.x, wid = __builtin_amdgcn_readfirstlane(tid >> 6), lane = tid & 63, wr = wid >> 2, wc = wid & 3, fr = lane & 15, fq = lane >> 4;
    int K_ = g.K; asm volatile("" : "+s"(K_)); const int K = K_, nt = K / BK;
    unsigned voffA[2], voffB[2];
#pragma unroll
    for (int i = 0; i < 2; ++i) { int R, C; stage_rc(tid * 16 + i * 8192, R, C); const int Rb = Epi::PERM ? ((R & ~31) + perm32(R & 31)) : R;
        voffA[i] = (unsigned)(R * K + C) * 2u; voffB[i] = (unsigned)(Rb * K + C) * 2u; }
    const size_t kstep = (size_t)(BK * 2);
    const size_t hstep = (size_t)HALF * K * 2;
    const size_t tstep = 2 * hstep;
    const unsigned ldsw = (unsigned)wid * 1024u;
    const int aoff = lds_byte(wr * 64 + fr, fq * 8), boff = lds_byte(wc * 32 + fr, fq * 8);
#define PG8_SA(b, h) (((b) * 2 + (h)) * HTB)
#define PG8_SB(b, h) ((4 + (b) * 2 + (h)) * HTB)
#define PG8_STAGE(bufoff, gbase, voff) do { _Pragma("unroll") for (int _i = 0; _i < 2; ++_i) \
        __builtin_amdgcn_global_load_lds((const unsigned*)((const char*)(gbase) + (voff)[_i]), (PG8_LAS unsigned*)(lds + (bufoff) + ldsw + _i * 8192), 16, 0, 0); } while (0)
#define PG8_LDA(dst, b, h) do { _Pragma("unroll") for (int m = 0; m < 4; ++m) _Pragma("unroll") for (int k = 0; k < 2; ++k) dst[m][k] = *(const PG8_LAS bf16x8*)(lds + PG8_SA(b, h) + aoff + m * 2048 + k * 1024); } while (0)
#define PG8_LDB(dst, b, h) do { _Pragma("unroll") for (int n = 0; n < 2; ++n) _Pragma("unroll") for (int k = 0; k < 2; ++k) dst[n][k] = *(const PG8_LAS bf16x8*)(lds + PG8_SB(b, h) + boff + n * 2048 + k * 1024); } while (0)
#define PG8_MMA(ai, bj, At, Bt) do { __builtin_amdgcn_s_setprio(1); _Pragma("unroll") for (int m = 0; m < 4; ++m) _Pragma("unroll") for (int n = 0; n < 2; ++n) _Pragma("unroll") for (int k = 0; k < 2; ++k) \
        acc[ai][bj][m][n] = __builtin_amdgcn_mfma_f32_16x16x32_bf16(Bt[n][k], At[m][k], acc[ai][bj][m][n], 0, 0, 0); __builtin_amdgcn_s_setprio(0); } while (0)
#define PG8_WAIT_V(n) asm volatile("s_waitcnt vmcnt(" #n ")" ::: "memory")
#define PG8_WAIT_L(n) asm volatile("s_waitcnt lgkmcnt(" #n ")" ::: "memory")
#define PG8_BAR __builtin_amdgcn_s_barrier()
#define PG8_SCHED __builtin_amdgcn_sched_barrier(0)
    Unit cur, nxt; int ui = 0;
    if (!S.next(0, cur)) return;
    f32x4 acc[2][2][4][2];
#pragma unroll
    for (int a = 0; a < 2; ++a)
#pragma unroll
        for (int b = 0; b < 2; ++b)
#pragma unroll
            for (int m = 0; m < 4; ++m)
#pragma unroll
                for (int n = 0; n < 2; ++n) acc[a][b][m][n] = (f32x4){0.f, 0.f, 0.f, 0.f};
    bf16x8 At[4][2], B0[2][2], B1[2][2];
    const char* cA = (const char*)g.A + (size_t)cur.pm * tstep; const char* cB = (const char*)g.Bt + (size_t)cur.pn * tstep;
    S.a_ready(cur);
    if constexpr (SP2) {
        PG8_STAGE(PG8_SB(0, 0), cB, voffB); PG8_STAGE(PG8_SB(0, 1), cB + hstep, voffB); PG8_STAGE(PG8_SA(0, 0), cA, voffA); PG8_STAGE(PG8_SA(0, 1), cA + hstep, voffA);
        if (wr == 1) PG8_BAR;
        PG8_WAIT_V(2); PG8_BAR;
        PG8_STAGE(PG8_SB(1, 0), cB + kstep, voffB); PG8_STAGE(PG8_SA(1, 0), cA + kstep, voffA); PG8_STAGE(PG8_SB(1, 1), cB + hstep + kstep, voffB);
        PG8_WAIT_V(6); PG8_BAR;
    } else {
        PG8_STAGE(PG8_SB(0, 0), cB, voffB); PG8_STAGE(PG8_SA(0, 0), cA, voffA); PG8_STAGE(PG8_SB(0, 1), cB + hstep, voffB); PG8_STAGE(PG8_SA(0, 1), cA + hstep, voffA);
        if (wr == 1) PG8_BAR;
        PG8_WAIT_V(4); PG8_BAR;
        PG8_STAGE(PG8_SB(1, 0), cB + kstep, voffB); PG8_STAGE(PG8_SA(1, 0), cA + kstep, voffA); PG8_STAGE(PG8_SB(1, 1), cB + hstep + kstep, voffB);
        PG8_WAIT_V(6); PG8_BAR;
    }
    for (;;) {
        const bool has_next = S.next(ui + 1, nxt);
        const char* nA = has_next ? (const char*)g.A + (size_t)nxt.pm * tstep : cA; const char* nB = has_next ? (const char*)g.Bt + (size_t)nxt.pn * tstep : cB;
        for (int t = 0; t < nt; t += 2) {
            const bool last = (t == nt - 2);
            const char* a1 = cA + (size_t)(t + 1) * kstep;
            const char* a2 = last ? nA : cA + (size_t)(t + 2) * kstep; const char* b2 = last ? nB : cB + (size_t)(t + 2) * kstep;
            const char* a3 = a2 + kstep; const char* b3 = b2 + kstep;
            if (last && has_next) S.a_ready(nxt);
            if constexpr (SP2) {
            PG8_LDB(B0, 0, 0); PG8_LDB(B1, 0, 1); PG8_SCHED; PG8_LDA(At, 0, 0); PG8_STAGE(PG8_SA(1, 1), a1 + hstep, voffA);
            PG8_WAIT_V(8); PG8_WAIT_L(0); PG8_BAR; PG8_MMA(0, 0, At, B0); PG8_MMA(0, 1, At, B1); PG8_BAR; PG8_SCHED;
            PG8_LDA(At, 0, 1); PG8_STAGE(PG8_SB(0, 0), b2, voffB); PG8_STAGE(PG8_SB(0, 1), b2 + hstep, voffB); PG8_STAGE(PG8_SA(0, 0), a2, voffA);
            PG8_WAIT_V(8); PG8_WAIT_L(0); PG8_BAR; PG8_MMA(1, 0, At, B0); PG8_MMA(1, 1, At, B1); PG8_BAR; PG8_SCHED;
            PG8_LDB(B0, 1, 0); PG8_LDB(B1, 1, 1); PG8_SCHED; PG8_LDA(At, 1, 0); PG8_STAGE(PG8_SA(0, 1), a2 + hstep, voffA);
            PG8_WAIT_V(8); PG8_WAIT_L(0); PG8_BAR; PG8_MMA(0, 0, At, B0); PG8_MMA(0, 1, At, B1); PG8_BAR; PG8_SCHED;
            PG8_LDA(At, 1, 1); PG8_STAGE(PG8_SB(1, 0), b3, voffB); PG8_STAGE(PG8_SB(1, 1), b3 + hstep, voffB); PG8_STAGE(PG8_SA(1, 0), a3, voffA);
            PG8_WAIT_V(8); PG8_WAIT_L(0); PG8_BAR; PG8_MMA(1, 0, At, B0); PG8_MMA(1, 1, At, B1); PG8_BAR; PG8_SCHED;
            } else {
            PG8_LDB(B0, 0, 0); PG8_SCHED; PG8_LDA(At, 0, 0); PG8_STAGE(PG8_SA(1, 1), a1 + hstep, voffA);
            PG8_WAIT_L(8); PG8_BAR; PG8_WAIT_L(0); PG8_MMA(0, 0, At, B0); PG8_BAR; PG8_SCHED;
            PG8_LDB(B1, 0, 1); PG8_STAGE(PG8_SB(0, 0), b2, voffB);
            PG8_BAR; PG8_WAIT_L(0); PG8_MMA(0, 1, At, B1); PG8_BAR;
            PG8_LDA(At, 0, 1); PG8_STAGE(PG8_SA(0, 0), a2, voffA);
            PG8_BAR; PG8_WAIT_L(0); PG8_MMA(1, 0, At, B0); PG8_BAR; PG8_SCHED;
            PG8_STAGE(PG8_SB(0, 1), b2 + hstep, voffB);
            PG8_WAIT_V(6); PG8_BAR; PG8_MMA(1, 1, At, B1); PG8_BAR;
            PG8_LDB(B0, 1, 0); PG8_SCHED; PG8_LDA(At, 1, 0); PG8_STAGE(PG8_SA(0, 1), a2 + hstep, voffA);
            PG8_WAIT_L(8); PG8_BAR; PG8_WAIT_L(0); PG8_MMA(0, 0, At, B0); PG8_BAR; PG8_SCHED;
            PG8_LDB(B1, 1, 1); PG8_STAGE(PG8_SB(1, 0), b3, voffB);
            PG8_BAR; PG8_WAIT_L(0); PG8_MMA(0, 1, At, B1); PG8_BAR;
            PG8_LDA(At, 1, 1); PG8_STAGE(PG8_SA(1, 0), a3, voffA);
            PG8_BAR; PG8_WAIT_L(0); PG8_MMA(1, 0, At, B0); PG8_BAR; PG8_SCHED;
            PG8_STAGE(PG8_SB(1, 1), b3 + hstep, voffB);
            PG8_WAIT_V(6); PG8_BAR; PG8_MMA(1, 1, At, B1); PG8_BAR;
            }
        }
        if constexpr (ALIGN_EPI) { if (wr == 0) PG8_BAR; }
        if constexpr (!Epi::AFTER_DRAIN) { E(acc, cur, wr, wc, fr, fq); S.done(cur); }
        if (!has_next) break;
#pragma unroll
        for (int a = 0; a < 2; ++a)
#pragma unroll
            for (int b = 0; b < 2; ++b)
#pragma unroll
                for (int m = 0; m < 4; ++m)
#pragma unroll
                    for (int n = 0; n < 2; ++n) acc[a][b][m][n] = (f32x4){0.f, 0.f, 0.f, 0.f};
        cur = nxt; cA = nA; cB = nB; ++ui;
        if constexpr (ALIGN_EPI) { if (wr == 1) PG8_BAR; }
    }
    PG8_WAIT_V(0);
    if constexpr (!ALIGN_EPI) { if (wr == 0) PG8_BAR; }
    PG8_BAR;
    if constexpr (Epi::AFTER_DRAIN) { E.fused(acc, cur, wr, wc, fr, fq, lds, wid, lane); S.done(cur); }
#undef PG8_SA
#undef PG8_SB
#undef PG8_STAGE
#undef PG8_LDA
#undef PG8_LDB
#undef PG8_MMA
#undef PG8_WAIT_V
#undef PG8_WAIT_L
#undef PG8_BAR
#undef PG8_SCHED
}
}
using bf16 = unsigned short;
constexpr int NWAVES = 8;
constexpr int DM = 1024, MP = 32768, MS = 256, MROWS = MP + MS, SEQL = 8192, SSL = 16;
constexpr int NPROJ = 3840, DIN = 3848, RPROJ = 1792, OFF_QKV = 1792, OFF_Z = 3328, DFF = 2816, NGU = 5632, DPLE = 256, NLORA = 1536, KLORA = 256;
constexpr int GQ = 1536;
constexpr float RMS_EPS = 1e-6f, GN_EPS = 64e-5f;
constexpr size_t O_Y = 0, O_SHIFT_P = (size_t)MROWS * DM, O_WKV_P = O_SHIFT_P + 4 * 1792, O_CONV_P = O_WKV_P + 4 * 8 * 4096, O_GDN_P = O_CONV_P + 4 * 3 * 1536,
                 O_SHIFT_S = O_GDN_P + 4 * 4 * 16384, O_WKV_S = O_SHIFT_S + 16 * 1792, O_CONV_S = O_WKV_S + 16 * 8 * 4096, O_GDN_S = O_CONV_S + 16 * 3 * 1536, O_END = O_GDN_S + 16 * 4 * 16384;
static_assert(O_END == 35910656, "d_out size");
constexpr size_t MiB = 1u << 20;
constexpr size_t WS_CTL = 0, CTL_ZERO_BYTES = 1 * MiB;
constexpr size_t WS_WIN = 2 * MiB, WS_WOUT = 10 * MiB, WS_WGU = 12 * MiB, WS_WDOWN = 23 * MiB, WS_WPG = 29 * MiB, WS_WPP = 31 * MiB, WS_WLORA = 31 * MiB + 512 * 1024;
constexpr size_t WS_XN = 33 * MiB;
constexpr size_t WS_PROJ = 98 * MiB;
constexpr size_t WS_ACT = 163 * MiB;
constexpr size_t WS_BIG = 340 * MiB;
constexpr size_t WS_XA = WS_BIG, WS_AA = WS_BIG + 33 * MiB, WS_GA = WS_BIG + 66 * MiB;
constexpr size_t WS_LIN = WS_BIG + 99 * MiB;
constexpr size_t WS_RYI = WS_BIG + 99 * MiB, WS_RS = WS_BIG + 132 * MiB;
constexpr size_t WS_RN = WS_BIG + 166 * MiB, WS_BA = WS_BIG + 168 * MiB;
constexpr size_t WS_GNT = WS_BIG, WS_GOI = WS_BIG + 66 * MiB, WS_GS = WS_BIG + 99 * MiB;
constexpr size_t WS_PB = WS_BIG + 1 * MiB;
constexpr size_t WS_SSQ2 = WS_BIG + 20 * MiB, WS_SSQ3 = WS_BIG + 23 * MiB, WS_SSQS2 = WS_BIG + 26 * MiB, WS_SSQS3 = WS_BIG + 27 * MiB, WS_PP = WS_BIG + 30 * MiB;
constexpr size_t WS_END = 512 * MiB;
static_assert(WS_PROJ + (size_t)MROWS * NPROJ * 2 <= WS_BIG && WS_ACT + (size_t)MROWS * DFF * 2 <= WS_PB && WS_XN + (size_t)MROWS * DM * 2 <= WS_PROJ && WS_PROJ + (size_t)MROWS * DM * 2 <= WS_ACT, "ws map");
static_assert(WS_RS + (size_t)4224 * 8192 <= WS_RN && WS_RYI + (size_t)4224 * 8192 <= WS_RS && WS_LIN + (size_t)MROWS * 256 * 2 <= WS_RN && (size_t)3 * 4224 * 8192 <= (size_t)MROWS * DM * 4 && WS_XA + (size_t)MROWS * 512 * 2 <= WS_AA && WS_GA + (size_t)MROWS * 512 * 2 <= WS_LIN && WS_BA + (size_t)MROWS * 32 <= WS_END, "ws map 2");
static_assert(WS_GS + (size_t)2112 * 32768 <= WS_RN && WS_GNT + (size_t)2112 * 32768 <= WS_GOI && WS_GOI + (size_t)2112 * 16384 <= WS_GS && WS_PP + (size_t)MROWS * DM * 2 <= WS_END && WS_PB + (size_t)MROWS * 512 <= WS_SSQ2, "ws map 3");
static_assert((size_t)2112 * (32768 + 16384) <= (size_t)MROWS * DM * 4, "GM + GQH fit in the y region of d_out");
constexpr int CW_BAR = 4096;
constexpr int RING_OFF = 0, RING_BYTES = 131072;
constexpr int LDS_BYTES = 147456;
constexpr int LDSCTL_OFF = LDS_BYTES - 512, MISC_OFF = LDSCTL_OFF + 320;
#define GAS __attribute__((address_space(1)))
#define LAS __attribute__((address_space(3)))
typedef unsigned v4u __attribute__((ext_vector_type(4)));
typedef float f32x4 __attribute__((ext_vector_type(4)));
typedef short bf16x8 __attribute__((ext_vector_type(8)));
typedef GAS unsigned gu32;
typedef GAS unsigned long long gu64;
#define RLX_AGENT __ATOMIC_RELAXED, __HIP_MEMORY_SCOPE_AGENT
#define LDS_WAIT() asm volatile("s_waitcnt lgkmcnt(0)" ::: "memory")
#define LDS_BARRIER() do { asm volatile("s_waitcnt lgkmcnt(0)" ::: "memory"); __builtin_amdgcn_s_barrier(); asm volatile("" ::: "memory"); } while (0)
#define VM_WAIT() asm volatile("s_waitcnt vmcnt(0)" ::: "memory")
__device__ __forceinline__ unsigned long long rt() { return __builtin_amdgcn_s_memrealtime(); }
__device__ __forceinline__ unsigned f2bf(float f) { return (unsigned)__builtin_bit_cast(unsigned short, (__bf16)f); }
typedef __bf16 bf16x2_t __attribute__((ext_vector_type(2)));
__device__ __forceinline__ unsigned pk2(float lo, float hi) { bf16x2_t v; v[0] = (__bf16)lo; v[1] = (__bf16)hi; return __builtin_bit_cast(unsigned, v); }

#define XB_TMO      128
#define XB_XCNT(j)  (256  + 64 * (j))
#define XB_XSUB(j)  (1280 + 64 * (j))
#define XB_XGEN(j)  (2304 + 64 * (j))
#define XB_TOP      3328
#define XB_TOPGEN   3392
#define XCD_BAR_WORDS 3456
#define XB_SPIN_CAP (1u << 18)

__device__ __forceinline__ unsigned xb_ld(unsigned* p)              { return __hip_atomic_load(p, __ATOMIC_RELAXED, __HIP_MEMORY_SCOPE_AGENT); }
__device__ __forceinline__ unsigned xb_add(unsigned* p, unsigned v) { return __hip_atomic_fetch_add(p, v, __ATOMIC_RELAXED, __HIP_MEMORY_SCOPE_AGENT); }
__device__ __forceinline__ unsigned xb_xcc_id() { return (unsigned)__builtin_amdgcn_s_getreg((3 << 11) | 20) & 0xFu; }
#define XB_SPIN(cond, bar) do { unsigned _sp = 0; while (cond) { __builtin_amdgcn_s_sleep(1); \
    if ((++_sp & 255u) == 0u) { if (xb_ld(&(bar)[XB_TMO])) break; if (_sp > XB_SPIN_CAP) { atomicAdd(&(bar)[XB_TMO], 1u); break; } } } } while (0)

struct XcdBarrier {
    unsigned* bar; unsigned x;
    volatile LAS unsigned* st;
};

__device__ __forceinline__ XcdBarrier xcd_barrier_post(unsigned* bar, volatile LAS unsigned* st) {
    XcdBarrier b; b.bar = bar; b.x = xb_xcc_id(); b.st = st;
    if (threadIdx.x == 0) (void)xb_add(&bar[XB_XCNT(b.x)], 1u);
    return b;
}
__device__ __forceinline__ void xcd_barrier_complete(unsigned* bar, unsigned x, unsigned& nloc, unsigned& nx) {
    const unsigned G = gridDim.x * gridDim.y * gridDim.z;
    unsigned sum, cnt, mine, sp = 0u;
    for (;;) {
        sum = 0u; cnt = 0u; mine = 0u;
#pragma unroll
        for (unsigned j = 0; j < 16; ++j) { const unsigned c = xb_ld(&bar[XB_XCNT(j)]); sum += c; cnt += (c > 0u) ? 1u : 0u; mine = (j == x) ? c : mine; }
        if (sum == G) break;
        __builtin_amdgcn_s_sleep(1);
        if ((++sp & 255u) == 0u) { if (xb_ld(&bar[XB_TMO])) break; if (sp > XB_SPIN_CAP) { atomicAdd(&bar[XB_TMO], 1u); break; } }
    }
    nloc = mine > 0u ? mine : 1u; nx = cnt > 0u ? cnt : 1u;
}

__device__ __forceinline__ void xcd_barrier(const XcdBarrier& b) {
    asm volatile("s_waitcnt vmcnt(0)" ::: "memory");
    __syncthreads();
    if (threadIdx.x == 0) {
        unsigned* bar = b.bar;
        __builtin_amdgcn_s_waitcnt(0);
        unsigned nloc = b.st[0], nx = b.st[1];
        if (nloc == 0u) { xcd_barrier_complete(bar, b.x, nloc, nx); b.st[0] = nloc; b.st[1] = nx; }
        const unsigned old = xb_add(&bar[XB_XSUB(b.x)], 1u);
        const unsigned gen = old / nloc;
        if (old + 1u == (gen + 1u) * nloc) {
            __builtin_amdgcn_fence(__ATOMIC_RELEASE, "agent");
            asm volatile("s_waitcnt vmcnt(0)" ::: "memory");
            const unsigned og = xb_add(&bar[XB_TOP], 1u);
            const unsigned tg = og / nx;
            if (og + 1u == (tg + 1u) * nx) xb_add(&bar[XB_TOPGEN], 1u);
            else XB_SPIN(xb_ld(&bar[XB_TOPGEN]) == tg, bar);
            __builtin_amdgcn_fence(__ATOMIC_ACQUIRE, "agent");
            xb_add(&bar[XB_XGEN(b.x)], 1u);
            asm volatile("s_waitcnt vmcnt(0)" ::: "memory");
        } else {
            XB_SPIN(xb_ld(&bar[XB_XGEN(b.x)]) == gen, bar);
            __builtin_amdgcn_fence(__ATOMIC_ACQUIRE, "agent");
            asm volatile("s_waitcnt vmcnt(0)" ::: "memory");
        }
    }
    __syncthreads();
}
__device__ __forceinline__ float wave_sum(float v) {
#pragma unroll
    for (int o = 1; o < 64; o <<= 1) v += __shfl_xor(v, o);
    return v;
}
__device__ __forceinline__ float bflo(unsigned w) { return __uint_as_float(w << 16); }
__device__ __forceinline__ float bfhi(unsigned w) { return __uint_as_float(w & 0xffff0000u); }
__device__ __forceinline__ void unpack8(const v4u w, float (&o)[8]) { o[0] = bflo(w.x); o[1] = bfhi(w.x); o[2] = bflo(w.y); o[3] = bfhi(w.y); o[4] = bflo(w.z); o[5] = bfhi(w.z); o[6] = bflo(w.w); o[7] = bfhi(w.w); }
__device__ __forceinline__ v4u pack8(const float (&o)[8]) { v4u w; w.x = pk2(o[0], o[1]); w.y = pk2(o[2], o[3]); w.z = pk2(o[4], o[5]); w.w = pk2(o[6], o[7]); return w; }
__device__ __forceinline__ float fsig(float x) { return __builtin_amdgcn_rcpf(1.f + __builtin_amdgcn_exp2f(-1.44269504f * x)); }
__device__ __forceinline__ float ftanh(float x) { return 1.f - 2.f * __builtin_amdgcn_rcpf(1.f + __builtin_amdgcn_exp2f(2.88539008f * x)); }
__device__ __forceinline__ float fsoftplus(float z) { return fmaxf(z, 0.f) + __logf(1.f + __expf(-fabsf(z))); }

__device__ __forceinline__ int gu_row(int c, int ty) { const int pn = c >> 7, cc = c & 127, wc = cc >> 5, rem = cc & 31, fq = rem >> 3, bj = (rem >> 2) & 1, j = rem & 3; return 256 * pn + 128 * bj + 32 * wc + 16 * ty + 4 * fq + j; }
__device__ __forceinline__ void p0_tr(const float* W, int ldw, int sk0, int sn0, bf16* WT, int ldt, int dk0, int dn0, LAS float* scr, int lane, const float* kscale, int mode) {
#pragma unroll 8
    for (int i = 0; i < 32; ++i) { const int kk = 2 * i + (lane >> 5); float w = W[(size_t)(sk0 + kk) * ldw + sn0 + (lane & 31)]; if (kscale) w *= kscale[sk0 + kk]; scr[kk * 33 + (lane & 31)] = w; }
    LDS_WAIT(); asm volatile("" ::: "memory");
    const int c = lane & 7;
#pragma unroll
    for (int j = 0; j < 4; ++j) { const int n = (lane >> 3) + 8 * j; const LAS float* s = scr + (8 * c) * 33 + n;
        v4u o; o.x = pk2(s[0 * 33], s[1 * 33]); o.y = pk2(s[2 * 33], s[3 * 33]); o.z = pk2(s[4 * 33], s[5 * 33]); o.w = pk2(s[6 * 33], s[7 * 33]);
        const int drow = mode == 0 ? dn0 + n : gu_row(sn0 + n, mode - 1);
        *(GAS v4u*)(WT + (size_t)drow * ldt + dk0 + 8 * c) = o; }
    LDS_WAIT(); asm volatile("" ::: "memory");
}
struct Args { const float* in[34]; float* out; unsigned char* ws; int ph_lo, ph_hi; };
struct Ptrs {
    const __attribute__((address_space(4))) Args* Ap;
    __device__ __forceinline__ const float* xp() const { return Ap->in[0]; }
    __device__ __forceinline__ const float* xs() const { return Ap->in[1]; }
    __device__ __forceinline__ const float* sshift() const { return Ap->in[2]; }
    __device__ __forceinline__ const float* swkv() const { return Ap->in[3]; }
    __device__ __forceinline__ const float* sconv() const { return Ap->in[4]; }
    __device__ __forceinline__ const float* sgdn() const { return Ap->in[5]; }
    __device__ __forceinline__ const float* pp_() const { return Ap->in[6]; }
    __device__ __forceinline__ const float* ps_() const { return Ap->in[7]; }
    __device__ __forceinline__ const float* ln_mix_g() const { return Ap->in[8]; }
    __device__ __forceinline__ const float* w_in() const { return Ap->in[9]; }
    __device__ __forceinline__ const float* mu() const { return Ap->in[10]; }
    __device__ __forceinline__ const float* w0() const { return Ap->in[11]; }
    __device__ __forceinline__ const float* wl_up() const { return Ap->in[12]; }
    __device__ __forceinline__ const float* a0() const { return Ap->in[13]; }
    __device__ __forceinline__ const float* al_up() const { return Ap->in[14]; }
    __device__ __forceinline__ const float* gl_up() const { return Ap->in[15]; }
    __device__ __forceinline__ const float* k_k() const { return Ap->in[16]; }
    __device__ __forceinline__ const float* k_a() const { return Ap->in[17]; }
    __device__ __forceinline__ const float* r_k() const { return Ap->in[18]; }
    __device__ __forceinline__ const float* lnx_w() const { return Ap->in[19]; }
    __device__ __forceinline__ const float* lnx_b() const { return Ap->in[20]; }
    __device__ __forceinline__ const float* conv_w() const { return Ap->in[21]; }
    __device__ __forceinline__ const float* a_log() const { return Ap->in[22]; }
    __device__ __forceinline__ const float* dt_bias() const { return Ap->in[23]; }
    __device__ __forceinline__ const float* gdn_g() const { return Ap->in[24]; }
    __device__ __forceinline__ const float* w_out() const { return Ap->in[25]; }
    __device__ __forceinline__ const float* ln_ffn_g() const { return Ap->in[26]; }
    __device__ __forceinline__ const float* w_gate() const { return Ap->in[27]; }
    __device__ __forceinline__ const float* w_up() const { return Ap->in[28]; }
    __device__ __forceinline__ const float* w_down() const { return Ap->in[29]; }
    __device__ __forceinline__ const float* ln_ple_g() const { return Ap->in[30]; }
    __device__ __forceinline__ const float* w_pg() const { return Ap->in[31]; }
    __device__ __forceinline__ const float* w_pp() const { return Ap->in[32]; }
    __device__ __forceinline__ const float* fin_g() const { return Ap->in[33]; }
    __device__ __forceinline__ float* out() const { return Ap->out; }
    __device__ __forceinline__ bf16* Win_t() const { return (bf16*)(Ap->ws + WS_WIN); }
    __device__ __forceinline__ bf16* Wout_t() const { return (bf16*)(Ap->ws + WS_WOUT); }
    __device__ __forceinline__ bf16* Wgu_t() const { return (bf16*)(Ap->ws + WS_WGU); }
    __device__ __forceinline__ bf16* Wdown_t() const { return (bf16*)(Ap->ws + WS_WDOWN); }
    __device__ __forceinline__ bf16* Wpg_t() const { return (bf16*)(Ap->ws + WS_WPG); }
    __device__ __forceinline__ bf16* Wpp_t() const { return (bf16*)(Ap->ws + WS_WPP); }
    __device__ __forceinline__ bf16* Wlora_t() const { return (bf16*)(Ap->ws + WS_WLORA); }
    __device__ __forceinline__ bf16* XN() const { return (bf16*)(Ap->ws + WS_XN); }
    __device__ __forceinline__ bf16* PROJ() const { return (bf16*)(Ap->ws + WS_PROJ); }
    __device__ __forceinline__ bf16* ACT() const { return (bf16*)(Ap->ws + WS_ACT); }
    __device__ __forceinline__ bf16* XA() const { return (bf16*)(Ap->ws + WS_XA); }
    __device__ __forceinline__ bf16* AA() const { return (bf16*)(Ap->ws + WS_AA); }
    __device__ __forceinline__ bf16* GA() const { return (bf16*)(Ap->ws + WS_GA); }
    __device__ __forceinline__ bf16* PB() const { return (bf16*)(Ap->ws + WS_PB); }
    __device__ __forceinline__ bf16* LIN() const { return (bf16*)(Ap->ws + WS_LIN); }
    __device__ __forceinline__ float* RN() const { return (float*)(Ap->ws + WS_RN); }
    __device__ __forceinline__ float* BA() const { return (float*)(Ap->ws + WS_BA); }
    __device__ __forceinline__ float* SSQ2() const { return (float*)(Ap->ws + WS_SSQ2); }
    __device__ __forceinline__ float* SSQ3() const { return (float*)(Ap->ws + WS_SSQ3); }
    __device__ __forceinline__ float* SSQS2() const { return (float*)(Ap->ws + WS_SSQS2); }
    __device__ __forceinline__ float* SSQS3() const { return (float*)(Ap->ws + WS_SSQS3); }
    __device__ __forceinline__ bf16* RPHI() const { return (bf16*)Ap->out; }
    __device__ __forceinline__ bf16* RPSI() const { return (bf16*)Ap->out + (size_t)4224 * 4096; }
    __device__ __forceinline__ bf16* RRH() const { return (bf16*)Ap->out + (size_t)2 * 4224 * 4096; }
    __device__ __forceinline__ bf16* RYI() const { return (bf16*)(Ap->ws + WS_RYI); }
    __device__ __forceinline__ bf16* RS() const { return (bf16*)(Ap->ws + WS_RS); }
    __device__ __forceinline__ bf16* GM() const { return (bf16*)Ap->out; }
    __device__ __forceinline__ bf16* GQH() const { return (bf16*)Ap->out + (size_t)2112 * 16384; }
    __device__ __forceinline__ bf16* GNT() const { return (bf16*)(Ap->ws + WS_GNT); }
    __device__ __forceinline__ bf16* GOI() const { return (bf16*)(Ap->ws + WS_GOI); }
    __device__ __forceinline__ bf16* GS() const { return (bf16*)(Ap->ws + WS_GS); }
    __device__ __forceinline__ bf16* PP() const { return (bf16*)(Ap->ws + WS_PP); }
};
__device__ __forceinline__ void p0_prologue(const Ptrs& P, LAS unsigned char* lds, int gw, int NGW, int wave, int lane) {
    LAS float* scr = (LAS float*)(lds + RING_OFF + wave * 16384);
    constexpr int I_IN = 16 * 120, I_OUT = 16 * 32, I_G = 16 * 88, I_DN = 44 * 32, I_PG = 16 * 32, I_PP = 4 * 32, I_LO = 4 * 48;
    constexpr int NITEMS = I_IN + I_OUT + 2 * I_G + I_DN + I_PG + I_PP + I_LO;
    for (int it = gw; it < NITEMS; it += NGW) {
        int r = it;
        if (r < I_IN) { p0_tr(P.w_in(), DIN, 64 * (r / 120), 32 * (r % 120), P.Win_t(), 1024, 64 * (r / 120), 32 * (r % 120), scr, lane, nullptr, 0); continue; } r -= I_IN;
        if (r < I_OUT) { p0_tr(P.w_out(), 1024, 64 * (r / 32), 32 * (r % 32), P.Wout_t(), 1024, 64 * (r / 32), 32 * (r % 32), scr, lane, nullptr, 0); continue; } r -= I_OUT;
        if (r < I_G) { p0_tr(P.w_gate(), DFF, 64 * (r / 88), 32 * (r % 88), P.Wgu_t(), 1024, 64 * (r / 88), 0, scr, lane, P.ln_ffn_g(), 1); continue; } r -= I_G;
        if (r < I_G) { p0_tr(P.w_up(), DFF, 64 * (r / 88), 32 * (r % 88), P.Wgu_t(), 1024, 64 * (r / 88), 0, scr, lane, P.ln_ffn_g(), 2); continue; } r -= I_G;
        if (r < I_DN) { p0_tr(P.w_down(), 1024, 64 * (r / 32), 32 * (r % 32), P.Wdown_t(), DFF, 64 * (r / 32), 32 * (r % 32), scr, lane, nullptr, 0); continue; } r -= I_DN;
        if (r < I_PG) { p0_tr(P.w_pg(), 1024, 64 * (r / 32), 32 * (r % 32), P.Wpg_t(), 1024, 64 * (r / 32), 32 * (r % 32), scr, lane, P.ln_ple_g(), 0); continue; } r -= I_PG;
        if (r < I_PP) { p0_tr(P.w_pp(), 1024, 64 * (r / 32), 32 * (r % 32), P.Wpp_t(), 256, 64 * (r / 32), 32 * (r % 32), scr, lane, nullptr, 0); continue; } r -= I_PP;
        {
            const int kb = r / 48, nb = r % 48, part = nb / 16, n0 = 32 * (nb % 16);
            const bool nz = (part == 0 && kb == 0) || (part == 1 && kb == 1) || (part == 2 && kb >= 2);
            if (nz) { const float* W = part == 0 ? P.wl_up() : (part == 1 ? P.al_up() : P.gl_up()); p0_tr(W, 512, part == 2 ? 64 * (kb - 2) : 0, n0, P.Wlora_t(), 256, 64 * kb, 512 * part + n0, scr, lane, nullptr, 0); }
            else { const int c = lane & 7;
#pragma unroll
                for (int j = 0; j < 4; ++j) { const int n = (lane >> 3) + 8 * j; *(GAS v4u*)(P.Wlora_t() + (size_t)(512 * part + n0 + n) * 256 + 64 * kb + 8 * c) = (v4u){0u, 0u, 0u, 0u}; } }
        }
    }
    f32x4 gv[4];
#pragma unroll
    for (int j = 0; j < 4; ++j) gv[j] = *(const f32x4*)(P.ln_mix_g() + 4 * lane + 256 * j);
    f32x4 wq[16][2];
#pragma unroll
    for (int j = 0; j < 4; ++j)
#pragma unroll
        for (int i = 0; i < 4; ++i) { const float* wr_ = P.w_in() + (size_t)(256 * j + 4 * lane + i) * DIN + NPROJ; wq[4 * j + i][0] = *(const f32x4*)wr_; wq[4 * j + i][1] = *(const f32x4*)(wr_ + 4); }
    for (int m = gw; m < MROWS; m += NGW) {
        const float* xr = m < MP ? P.xp() + (size_t)m * DM : P.xs() + (size_t)(m - MP) * DM;
        const GAS f32x4* x4 = (const GAS f32x4*)xr + lane;
        f32x4 v[4]; float ss = 0.f;
#pragma unroll
        for (int j = 0; j < 4; ++j) { v[j] = x4[64 * j]; ss += (v[j].x * v[j].x + v[j].y * v[j].y) + (v[j].z * v[j].z + v[j].w * v[j].w); }
        const float rstd = 1.0f / sqrtf(wave_sum(ss) * (1.f / DM) + RMS_EPS);
        GAS unsigned long long* o8 = (GAS unsigned long long*)(P.XN() + (size_t)m * DM) + lane;
        f32x4 d0 = {0.f, 0.f, 0.f, 0.f}, d1 = {0.f, 0.f, 0.f, 0.f};
#pragma unroll
        for (int j = 0; j < 4; ++j) { const f32x4 h = v[j] * rstd * gv[j];
            o8[64 * j] = (unsigned long long)pk2(h.x, h.y) | ((unsigned long long)pk2(h.z, h.w) << 32);
#pragma unroll
            for (int i = 0; i < 4; ++i) { d0 += wq[4 * j + i][0] * h[i]; d1 += wq[4 * j + i][1] * h[i]; } }
#pragma unroll
        for (int c = 0; c < 4; ++c) { d0[c] = wave_sum(d0[c]); d1[c] = wave_sum(d1[c]); }
        if (lane == 0) { *(f32x4*)(P.BA() + (size_t)m * 8) = d0; *(f32x4*)(P.BA() + (size_t)m * 8 + 4) = d1; }
    }
}
__device__ __forceinline__ void row_info(int m, int& t, int& sb) { if (m < MP) { t = m & (SEQL - 1); sb = -1; } else { t = (m - MP) & (SSL - 1); sb = (m - MP) >> 4; } }
__device__ __forceinline__ void load_fm8(const Ptrs& P, int m, int t, int sb, int c0, float (&o)[8]) {
    float f[8], p[8];
    unpack8(*(const GAS v4u*)(P.PROJ() + (size_t)m * NPROJ + c0), f);
    if (t > 0) unpack8(*(const GAS v4u*)(P.PROJ() + (size_t)(m - 1) * NPROJ + c0), p);
    else if (sb >= 0) { const f32x4 a = *(const f32x4*)(P.sshift() + (size_t)sb * RPROJ + c0), b = *(const f32x4*)(P.sshift() + (size_t)sb * RPROJ + c0 + 4); p[0] = a.x; p[1] = a.y; p[2] = a.z; p[3] = a.w; p[4] = b.x; p[5] = b.y; p[6] = b.z; p[7] = b.w; }
    else {
#pragma unroll
        for (int i = 0; i < 8; ++i) p[i] = 0.f; }
    const f32x4 m0 = *(const f32x4*)(P.mu() + c0), m1 = *(const f32x4*)(P.mu() + c0 + 4);
#pragma unroll
    for (int i = 0; i < 8; ++i) o[i] = f[i] + (p[i] - f[i]) * (i < 4 ? m0[i] : m1[i - 4]);
}
__device__ __forceinline__ float load_fm1(const Ptrs& P, int m, int t, int sb, int c) {
    const float f = __uint_as_float((unsigned)P.PROJ()[(size_t)m * NPROJ + c] << 16);
    float p = 0.f;
    if (t > 0) p = __uint_as_float((unsigned)P.PROJ()[(size_t)(m - 1) * NPROJ + c] << 16); else if (sb >= 0) p = P.sshift()[(size_t)sb * RPROJ + c];
    return f + (p - f) * P.mu()[c];
}
__device__ __forceinline__ void p2_token_prep(const Ptrs& P, int gw, int NGW, int lane) {
    for (int m = gw; m < MROWS; m += NGW) {
        int t, sb; row_info(m, t, sb);
        {
            const float fw = load_fm1(P, m, t, sb, 1536 + lane), fa = load_fm1(P, m, t, sb, 1600 + lane), fg0 = load_fm1(P, m, t, sb, 1664 + lane), fg1 = load_fm1(P, m, t, sb, 1728 + lane);
            bf16* lr = P.LIN() + (size_t)m * KLORA;
            lr[lane] = (bf16)f2bf(ftanh(fw)); lr[64 + lane] = (bf16)f2bf(fa); lr[128 + lane] = (bf16)f2bf(fsig(fg0)); lr[192 + lane] = (bf16)f2bf(fsig(fg1));
        }
        {
            float k[8]; load_fm8(P, m, t, sb, 512 + 8 * lane, k);
            const f32x4 kk0 = *(const f32x4*)(P.k_k() + 8 * lane), kk1 = *(const f32x4*)(P.k_k() + 8 * lane + 4); float s = 0.f;
#pragma unroll
            for (int i = 0; i < 8; ++i) { const float q = k[i] * (i < 4 ? kk0[i] : kk1[i - 4]); s += q * q; }
            s += __shfl_xor(s, 1); s += __shfl_xor(s, 2); s += __shfl_xor(s, 4);
            if ((lane & 7) == 0) P.RN()[(size_t)m * 8 + (lane >> 3)] = 1.0f / sqrtf(s + 1e-12f);
        }
    }
}
__device__ __forceinline__ void copy_state_rows(const Ptrs& P, int gw, int NGW, int lane) {
    for (int s = gw; s < 20; s += NGW) { const int sb = s - 4; const int mlast = s < 4 ? s * SEQL + SEQL - 1 : MP + sb * SSL + SSL - 1;
        float* dsh = s < 4 ? P.out() + O_SHIFT_P + (size_t)s * RPROJ : P.out() + O_SHIFT_S + (size_t)sb * RPROJ;
        for (int c = lane; c < RPROJ; c += 64) dsh[c] = __uint_as_float((unsigned)P.PROJ()[(size_t)mlast * NPROJ + c] << 16);
        float* dcv = s < 4 ? P.out() + O_CONV_P + (size_t)s * 3 * GQ : P.out() + O_CONV_S + (size_t)sb * 3 * GQ;
        for (int r = 0; r < 3; ++r) for (int c = lane; c < GQ; c += 64) dcv[(size_t)r * GQ + c] = __uint_as_float((unsigned)P.PROJ()[(size_t)(mlast - 2 + r) * NPROJ + OFF_QKV + c] << 16); }
}
__device__ __forceinline__ void p_final_norm(const Ptrs& P, int gw, int NGW, int lane) {
    f32x4 gv[4];
#pragma unroll
    for (int j = 0; j < 4; ++j) gv[j] = *(const f32x4*)(P.fin_g() + 4 * lane + 256 * j);
    for (int m = gw; m < MROWS; m += NGW) {
        GAS f32x4* x4 = (GAS f32x4*)(P.out() + (size_t)m * DM) + lane; f32x4 v[4]; float ss = 0.f;
#pragma unroll
        for (int j = 0; j < 4; ++j) { v[j] = x4[64 * j]; ss += (v[j].x * v[j].x + v[j].y * v[j].y) + (v[j].z * v[j].z + v[j].w * v[j].w); }
        const float rstd = 1.0f / sqrtf(wave_sum(ss) * (1.f / DM) + RMS_EPS);
#pragma unroll
        for (int j = 0; j < 4; ++j) x4[64 * j] = v[j] * rstd * gv[j];
    }
}
typedef float f32x16 __attribute__((ext_vector_type(16)));
typedef unsigned v2u __attribute__((ext_vector_type(2)));
constexpr int NCID = 528, NITEM_G = NCID * 4, NITEM_R = NCID * 8;
constexpr int GL_VEC = 0, GL_AT = 512, GL_QK = 17920, GL_QH = 27136, GL_KH = 44544, GL_VH = 61952, GL_UT = 79360, GL_WT = 97792, GL_KD = 116224, GL_TBLK = GL_KH  , GL_LP = GL_VH;
struct ChunkInfo { int m0, ntok, sb, n; };
__device__ __forceinline__ ChunkInfo chunk_info(int cid) { ChunkInfo c; if (cid < 512) { c.m0 = (cid >> 7) * SEQL + (cid & 127) * 64; c.ntok = 64; c.sb = -1; c.n = cid & 127; } else { c.sb = cid - 512; c.m0 = MP + c.sb * SSL; c.ntok = SSL; c.n = 0; } return c; }
__device__ __forceinline__ f32x16 mfma32(bf16x8 a, bf16x8 b, f32x16 c) { return __builtin_amdgcn_mfma_f32_32x32x16_bf16(a, b, c, 0, 0, 0); }
__device__ __forceinline__ f32x4 mfma16(bf16x8 a, bf16x8 b, f32x4 c) { return __builtin_amdgcn_mfma_f32_16x16x32_bf16(a, b, c, 0, 0, 0); }
__device__ __forceinline__ bf16x8 ldfrag(LAS unsigned char* lds, int byteoff) { return *(const LAS bf16x8*)(lds + byteoff); }
__device__ __forceinline__ f32x16 zero16() { f32x16 z;
#pragma unroll
    for (int i = 0; i < 16; ++i) z[i] = 0.f; return z; }

struct GRaw { v4u u[3][4][2]; };
__device__ __forceinline__ void gdn_load_raw(const Ptrs& P, int cid, int h, int tid, GRaw& R) {
    const ChunkInfo ci = chunk_info(cid); const int tok = tid >> 3, ch0 = 16 * (tid & 7); const bool valid = tok < ci.ntok; const int m = ci.m0 + tok, tseq = ci.n * 64 + tok;
#pragma unroll
    for (int part = 0; part < 3; ++part)
#pragma unroll
        for (int j = 0; j < 4; ++j) { v4u a = {0u, 0u, 0u, 0u}, b = {0u, 0u, 0u, 0u};
            if (valid && tseq - 3 + j >= 0) { const bf16* pr = P.PROJ() + (size_t)(m - 3 + j) * NPROJ + OFF_QKV + part * 512 + h * 128 + ch0; a = *(const GAS v4u*)pr; b = *(const GAS v4u*)(pr + 8); }
            R.u[part][j][0] = a; R.u[part][j][1] = b; }
}
constexpr int GL_CW = 134656;
static_assert(GL_CW + 6144 <= LDSCTL_OFF, "gdn prep LDS");
__device__ __forceinline__ void gdn_stage_conv_w(const Ptrs& P, LAS unsigned char* lds, int h, int tid) {
    for (int u = tid; u < 1536; u += 512) { const int j = u / 384, part = (u % 384) >> 7, c = u & 127; ((LAS float*)(lds + GL_CW))[u] = P.conv_w()[(size_t)j * GQ + part * 512 + h * 128 + c]; }
    LDS_BARRIER();
}
__device__ __forceinline__ void gdn_prep_item(const Ptrs& P, LAS unsigned char* lds, int cid, int h, int tid, GRaw& R, int ncid) {
    const ChunkInfo ci = chunk_info(cid); const int item = cid * 4 + h;
    int lane = tid & 63, wave = __builtin_amdgcn_readfirstlane(tid >> 6), c32 = lane & 31, hh = lane >> 5;
#define OPAQUE_LANE() do { asm volatile("" : "+v"(lane)); asm volatile("" : "+s"(wave)); c32 = lane & 31; hh = lane >> 5; } while (0)
    LAS float* vec = (LAS float*)(lds + GL_VEC);
#ifndef DUP_G1
#define DUP_G1 1
#endif
#ifndef DUP_G2
#define DUP_G2 1
#endif
#ifndef DUP_G4
#define DUP_G4 1
#endif
    for (int d_ = 0; d_ < DUP_G1; ++d_)
    {   const int tok = tid >> 3, sub = tid & 7, ch0 = 16 * sub; const bool valid = tok < ci.ntok; const int tseq = ci.n * 64 + tok;
#pragma unroll
        for (int part = 0; part < 3; ++part) {
            float acc[16];
#pragma unroll
            for (int i = 0; i < 16; ++i) acc[i] = 0.f;
            if (valid) {
#pragma unroll
                for (int j = 0; j < 4; ++j) { const int tt = tseq - 3 + j; float v[16];
                    {   float a[8], b[8]; unpack8(R.u[part][j][0], a); unpack8(R.u[part][j][1], b);
#pragma unroll
                        for (int i = 0; i < 8; ++i) { v[i] = a[i]; v[8 + i] = b[i]; } }
                    if (tt < 0 && ci.sb >= 0) { const float* sp = P.sconv() + ((size_t)ci.sb * 3 + (3 + tt)) * GQ + part * 512 + h * 128 + ch0;
#pragma unroll
                        for (int q4 = 0; q4 < 4; ++q4) { const f32x4 a = *(const f32x4*)(sp + 4 * q4); v[4 * q4] = a.x; v[4 * q4 + 1] = a.y; v[4 * q4 + 2] = a.z; v[4 * q4 + 3] = a.w; } }
                    const LAS float* cw = (const LAS float*)(lds + GL_CW) + (j * 3 + part) * 128 + ch0;
#pragma unroll
                    for (int q4 = 0; q4 < 4; ++q4) { const f32x4 w4 = *(const LAS f32x4*)(cw + 4 * q4); acc[4 * q4] += v[4 * q4] * w4.x; acc[4 * q4 + 1] += v[4 * q4 + 1] * w4.y; acc[4 * q4 + 2] += v[4 * q4 + 2] * w4.z; acc[4 * q4 + 3] += v[4 * q4 + 3] * w4.w; }
                }
            }
            float s = 0.f;
#pragma unroll
            for (int i = 0; i < 16; ++i) { acc[i] = acc[i] * fsig(acc[i]); s += acc[i] * acc[i]; }
            if (part < 2) { s += __shfl_xor(s, 1); s += __shfl_xor(s, 2); s += __shfl_xor(s, 4);
                const float sc = (1.0f / sqrtf(s + 1e-6f)) * (part == 0 ? 0.08838834764831845f : 1.0f);
#pragma unroll
                for (int i = 0; i < 16; ++i) acc[i] *= sc; }
            LAS unsigned char* dst = lds + GL_QH + part * 17408 + tok * 272 + ch0 * 2;
            v4u w0, w1; w0.x = pk2(acc[0], acc[1]); w0.y = pk2(acc[2], acc[3]); w0.z = pk2(acc[4], acc[5]); w0.w = pk2(acc[6], acc[7]); w1.x = pk2(acc[8], acc[9]); w1.y = pk2(acc[10], acc[11]); w1.z = pk2(acc[12], acc[13]); w1.w = pk2(acc[14], acc[15]);
            *(LAS v4u*)dst = w0; *(LAS v4u*)(dst + 16) = w1;
        }
        if (tid < 64) { const int tk = tid; float beta = 0.f, gl = 0.f;
            if (tk < ci.ntok) { const float* ba = P.BA() + (size_t)(ci.m0 + tk) * 8; beta = fsig(ba[h]); gl = -__expf(P.a_log()[h]) * fsoftplus(ba[4 + h] + P.dt_bias()[h]); }
#pragma unroll
            for (int o = 1; o < 64; o <<= 1) { const float t = __shfl_up(gl, o); if (lane >= o) gl += t; }
            vec[tk] = beta; vec[64 + tk] = gl; }
    }
    if (ncid >= 0) gdn_load_raw(P, ncid, h, tid, R);
    LDS_BARRIER();
    const float Glast = vec[64 + 63];
    OPAQUE_LANE();
    for (int d_ = 0; d_ < DUP_G2; ++d_)
#pragma unroll 1
    for (int task = wave; task < 23; task += 8) {
        if (task < 6) { const int type = task / 3, tl = task % 3, ti = tl == 0 ? 0 : 1, tj = tl == 2 ? 1 : 0;
            f32x16 acc = zero16();
            if (type == 0) {
#pragma unroll
                for (int s = 0; s < 8; ++s) acc = mfma32(ldfrag(lds, GL_KH + (32 * ti + c32) * 272 + (16 * s + 8 * hh) * 2), ldfrag(lds, GL_KH + (32 * tj + c32) * 272 + (16 * s + 8 * hh) * 2), acc);
                const int j = 32 * tj + c32; const float Gj = vec[64 + j];
#pragma unroll
                for (int q = 0; q < 4; ++q) { f32x4 o;
#pragma unroll
                    for (int e = 0; e < 4; ++e) { const int i = 32 * ti + 8 * q + 4 * hh + e; o[e] = i > j ? vec[i] * acc[4 * q + e] * __expf(vec[64 + i] - Gj) : 0.f; }
                    *(LAS f32x4*)(lds + GL_AT + j * 272 + (32 * ti + 8 * q + 4 * hh) * 4) = o; }
            } else {
#pragma unroll
                for (int s = 0; s < 8; ++s) acc = mfma32(ldfrag(lds, GL_KH + (32 * tj + c32) * 272 + (16 * s + 8 * hh) * 2), ldfrag(lds, GL_QH + (32 * ti + c32) * 272 + (16 * s + 8 * hh) * 2), acc);
                const int i = 32 * ti + c32; const float Gi = vec[64 + i];
#pragma unroll
                for (int q = 0; q < 4; ++q) { float o[4];
#pragma unroll
                    for (int e = 0; e < 4; ++e) { const int j = 32 * tj + 8 * q + 4 * hh + e; o[e] = i >= j ? acc[4 * q + e] * __expf(Gi - vec[64 + j]) : 0.f; }
                    v2u w; w.x = pk2(o[0], o[1]); w.y = pk2(o[2], o[3]);
                    *(LAS v2u*)(lds + GL_QK + i * 144 + (32 * tj + 8 * q + 4 * hh) * 2) = w; }
            }
        } else if (task == 6) {
            LAS unsigned char* dst = lds + GL_QK + (lane >> 1) * 144 + 64 + (lane & 1) * 32;
            *(LAS v4u*)dst = (v4u){0u, 0u, 0u, 0u}; *(LAS v4u*)(dst + 16) = (v4u){0u, 0u, 0u, 0u};
        } else { const int tt = task - 7, isK = tt >> 3, rt_ = (tt >> 2) & 1, ct = tt & 3;
            f32x16 acc = zero16(); const int src = isK ? GL_KH : GL_VH;
#pragma unroll
            for (int s2 = 0; s2 < 2; ++s2) { const int s = 2 * ct + s2; v4u id; const int kd = 32 * ct + c32 - 16 * s - 8 * hh;
                id.x = (kd == 0 ? 0x3F80u : 0u) | (kd == 1 ? 0x3F800000u : 0u); id.y = (kd == 2 ? 0x3F80u : 0u) | (kd == 3 ? 0x3F800000u : 0u); id.z = (kd == 4 ? 0x3F80u : 0u) | (kd == 5 ? 0x3F800000u : 0u); id.w = (kd == 6 ? 0x3F80u : 0u) | (kd == 7 ? 0x3F800000u : 0u);
                acc = mfma32(ldfrag(lds, src + (32 * rt_ + c32) * 272 + hh * 16 + s * 32), __builtin_bit_cast(bf16x8, id), acc); }
            const int col = 32 * ct + c32;
#pragma unroll
            for (int q = 0; q < 4; ++q) { const int t0 = 32 * rt_ + 8 * q + 4 * hh; float o[4], o2[4];
#pragma unroll
                for (int e = 0; e < 4; ++e) { const float bt_ = vec[t0 + e], Gt = vec[64 + t0 + e]; o[e] = acc[4 * q + e] * bt_ * (isK ? __expf(Gt) : 1.f); o2[e] = acc[4 * q + e] * __expf(Glast - Gt); }
                v2u w; w.x = pk2(o[0], o[1]); w.y = pk2(o[2], o[3]); *(LAS v2u*)(lds + (isK ? GL_WT : GL_UT) + col * 144 + t0 * 2) = w;
                if (isK) { v2u w2; w2.x = pk2(o2[0], o2[1]); w2.y = pk2(o2[2], o2[3]); *(LAS v2u*)(lds + GL_KD + col * 144 + t0 * 2) = w2; } }
        }
    }
    LDS_BARRIER();
    OPAQUE_LANE();
    if (wave == 0) { const int bb = lane >> 4, c = lane & 15; float T[16];
#pragma unroll
        for (int i = 0; i < 16; ++i) T[i] = i == c ? 1.f : 0.f;
#pragma unroll
        for (int j = 0; j < 15; ++j) { const LAS unsigned char* ar = lds + GL_AT + (16 * bb + j) * 272 + bb * 64;
#pragma unroll
            for (int g4 = (j + 1) >> 2; g4 < 4; ++g4) { const f32x4 a4 = *(const LAS f32x4*)(ar + g4 * 16);
#pragma unroll
                for (int e = 0; e < 4; ++e) { const int i = 4 * g4 + e; if (i > j) T[i] = fmaf(-a4[e], T[j], T[i]); } } }
#pragma unroll
        for (int i = 0; i < 16; ++i)
#pragma unroll
            for (int b2 = 0; b2 < 4; ++b2) *(LAS unsigned short*)(lds + GL_TBLK + (16 * bb + i) * 144 + (16 * b2 + c) * 2) = b2 == bb ? (unsigned short)f2bf(T[i]) : (unsigned short)0;
    } else { for (int u = tid - 64; u < 576; u += 448) *(LAS v4u*)(lds + GL_LP + u * 16) = (v4u){0u, 0u, 0u, 0u}; }
    LDS_BARRIER();
    OPAQUE_LANE();
    if (wave < 6) { const int bt = wave < 1 ? 1 : (wave < 3 ? 2 : 3), bj = wave < 1 ? 0 : (wave < 3 ? wave - 1 : wave - 3); const int s = bt >> 1, r16 = lane & 15, g4 = lane >> 4;
        const LAS float* lp = (const LAS float*)(lds + GL_AT + (16 * bj + r16) * 272 + (32 * s + 8 * g4) * 4); const f32x4 x0 = *(const LAS f32x4*)lp, x1 = *(const LAS f32x4*)(lp + 4);
        v4u aw; aw.x = pk2(x0[0], x0[1]); aw.y = pk2(x0[2], x0[3]); aw.z = pk2(x1[0], x1[1]); aw.w = pk2(x1[2], x1[3]);
        const f32x4 acc = mfma16(__builtin_bit_cast(bf16x8, aw), ldfrag(lds, GL_TBLK + (16 * bt + r16) * 144 + (32 * s + 8 * g4) * 2), (f32x4){0.f, 0.f, 0.f, 0.f});
        v2u w; w.x = pk2(-acc[0], -acc[1]); w.y = pk2(-acc[2], -acc[3]);
        *(LAS v2u*)(lds + GL_LP + (16 * bt + r16) * 144 + (16 * bj + 4 * g4) * 2) = w; }
    LDS_BARRIER();
    OPAQUE_LANE();
    {   const int r16 = lane & 15, g4 = lane >> 4;
#pragma unroll 1
        for (int u = 0; u < 2; ++u) { const int nt = 2 * wave + u; const int img = (nt < 8 ? GL_UT : GL_WT) + (16 * (nt & 7) + r16) * 144;
#pragma unroll
            for (int bt = 0; bt < 4; ++bt) { const int s0 = bt >> 1;
                f32x4 acc = mfma16(ldfrag(lds, GL_TBLK + (16 * bt + r16) * 144 + (32 * s0 + 8 * g4) * 2), ldfrag(lds, img + (32 * s0 + 8 * g4) * 2), (f32x4){0.f, 0.f, 0.f, 0.f});
#pragma unroll
                for (int s = 0; s < 2; ++s) if (s < ((16 * bt + 31) >> 5)) acc = mfma16(ldfrag(lds, GL_LP + (16 * bt + r16) * 144 + (32 * s + 8 * g4) * 2), ldfrag(lds, img + (32 * s + 8 * g4) * 2), acc);
                v2u w; w.x = pk2(acc[0], acc[1]); w.y = pk2(acc[2], acc[3]);
                *(LAS v2u*)(lds + img + (16 * bt + 4 * g4) * 2) = w;
                LDS_WAIT(); asm volatile("" ::: "memory"); } }
    }
    LDS_BARRIER();
    for (int d_ = 0; d_ < DUP_G4; ++d_)
    {   bf16* GM = P.GM() + (size_t)item * 16384; bf16* GNT = P.GNT() + (size_t)item * 16384; bf16* GQH = P.GQH() + (size_t)item * 8192; bf16* GOI = P.GOI() + (size_t)item * 8192;
        const float eGl = __expf(Glast);
        OPAQUE_LANE();
        {   const int dpt = wave & 3; const int dp = 32 * dpt + c32;
#pragma unroll
            for (int u = 0; u < 2; ++u) { const int dt = 2 * (wave >> 2) + u; f32x16 acc = zero16();
#pragma unroll
                for (int s = 0; s < 4; ++s) acc = mfma32(ldfrag(lds, GL_WT + (32 * dt + c32) * 144 + (16 * s + 8 * hh) * 2), ldfrag(lds, GL_KD + dp * 144 + (16 * s + 8 * hh) * 2), acc);
#pragma unroll
                for (int q = 0; q < 4; ++q) { float o[4];
#pragma unroll
                    for (int e = 0; e < 4; ++e) { const int d = 32 * dt + 8 * q + 4 * hh + e; o[e] = (d == dp ? eGl : 0.f) - acc[4 * q + e]; }
                    v2u w; w.x = pk2(o[0], o[1]); w.y = pk2(o[2], o[3]);
                    *(GAS v2u*)((unsigned char*)GM + ((dpt * 8 + 2 * dt + (q >> 1)) * 64 + lane) * 16 + (q & 1) * 8) = w; } }
        }
        OPAQUE_LANE();
        {   const int et = wave & 3; const int e_ = 32 * et + c32;
#pragma unroll
            for (int u = 0; u < 2; ++u) { const int dpt = 2 * (wave >> 2) + u; f32x16 acc = zero16();
#pragma unroll
                for (int s = 0; s < 4; ++s) acc = mfma32(ldfrag(lds, GL_KD + (32 * dpt + c32) * 144 + (16 * s + 8 * hh) * 2), ldfrag(lds, GL_UT + e_ * 144 + (16 * s + 8 * hh) * 2), acc);
#pragma unroll
                for (int q = 0; q < 4; ++q) { v2u w; w.x = pk2(acc[4 * q], acc[4 * q + 1]); w.y = pk2(acc[4 * q + 2], acc[4 * q + 3]);
                    *(GAS v2u*)((unsigned char*)GNT + (((et * 4 + dpt) * 4 + q) * 64 + lane) * 8) = w; } }
        }
        OPAQUE_LANE();
        {   const int xt = wave & 3, it = wave >> 2; const int i = 32 * it + c32; const float eGi = __expf(vec[64 + i]); const int ns = it == 0 ? 2 : 4;
            f32x16 acc = zero16(), acc2 = zero16();
            for (int s = 0; s < ns; ++s) { const bf16x8 b = ldfrag(lds, GL_QK + i * 144 + (16 * s + 8 * hh) * 2);
                acc = mfma32(ldfrag(lds, GL_WT + (32 * xt + c32) * 144 + (16 * s + 8 * hh) * 2), b, acc);
                acc2 = mfma32(ldfrag(lds, GL_UT + (32 * xt + c32) * 144 + (16 * s + 8 * hh) * 2), b, acc2); }
#pragma unroll
            for (int q = 0; q < 4; ++q) { const int d = 32 * xt + 8 * q + 4 * hh; const v2u qq = *(const LAS v2u*)(lds + GL_QH + i * 272 + d * 2);
                v2u w; w.x = pk2(bflo(qq.x) * eGi - acc[4 * q], bfhi(qq.x) * eGi - acc[4 * q + 1]); w.y = pk2(bflo(qq.y) * eGi - acc[4 * q + 2], bfhi(qq.y) * eGi - acc[4 * q + 3]);
                *(GAS v2u*)((unsigned char*)GQH + ((it * 8 + 2 * xt + (q >> 1)) * 64 + lane) * 16 + (q & 1) * 8) = w;
                v2u w2; w2.x = pk2(acc2[4 * q], acc2[4 * q + 1]); w2.y = pk2(acc2[4 * q + 2], acc2[4 * q + 3]);
                *(GAS v2u*)((unsigned char*)GOI + (((it * 4 + xt) * 4 + q) * 64 + lane) * 8) = w2; }
        }
    }
    LDS_BARRIER();
#undef OPAQUE_LANE
}
__device__ __forceinline__ void gdn_serial_job(const Ptrs& P, LAS unsigned char* lds, int item0, int istride, int nch, const float* s0, float* sfinal, int et, int tid) {
    const int lane = tid & 63, wave = tid >> 6, c32 = lane & 31, hh = lane >> 5; const int e_ = 32 * et + c32;
    f32x16 acc[4];
#pragma unroll
    for (int mt = 0; mt < 4; ++mt)
#pragma unroll
        for (int r = 0; r < 16; ++r) acc[mt][r] = s0 ? s0[(size_t)(32 * mt + (r & 3) + 8 * (r >> 2) + 4 * hh) * 128 + e_] : 0.f;
    v4u st[2][4]; v2u nf[2][4][4];
#define GS_ITEM(n_) (item0 + ((n_) < nch ? (n_) : nch - 1) * istride)
#define GS_LOAD_M(set, n_) do { const GAS v4u* src_ = (const GAS v4u*)(P.GM() + (size_t)GS_ITEM(n_) * 16384) + tid; _Pragma("unroll") for (int k = 0; k < 4; ++k) st[set][k] = src_[512 * k]; } while (0)
#define GS_LOAD_N(set, n_) do { const unsigned char* gn_ = (const unsigned char*)(P.GNT() + (size_t)GS_ITEM(n_) * 16384); _Pragma("unroll") for (int mt = 0; mt < 4; ++mt) _Pragma("unroll") for (int q = 0; q < 4; ++q) nf[set][mt][q] = *(const GAS v2u*)(gn_ + (((et * 4 + mt) * 4 + q) * 64 + lane) * 8); } while (0)
#define GS_WRITE_M(set, slot) do { _Pragma("unroll") for (int k = 0; k < 4; ++k) *(LAS v4u*)(lds + (slot) * 32768 + (tid + 512 * k) * 16) = st[set][k]; } while (0)
    GS_LOAD_M(0, 0); GS_LOAD_M(1, 1);
    if (wave == 0) { GS_LOAD_N(0, 0); GS_LOAD_N(1, 1); }
    GS_WRITE_M(0, 0);
    __syncthreads();
#define GS_ITER(n_, cur, oth) do { const int item_ = GS_ITEM(n_); LAS unsigned char* mb = lds + (cur) * 32768; \
        GS_LOAD_M(cur, (n_) + 2); \
        if (wave == 0) { bf16x8 sf[8]; unsigned char* gs = (unsigned char*)(P.GS() + (size_t)item_ * 16384); \
            _Pragma("unroll") for (int mt = 0; mt < 4; ++mt) _Pragma("unroll") for (int s2 = 0; s2 < 2; ++s2) { v4u w; w.x = pk2(acc[mt][8 * s2], acc[mt][8 * s2 + 1]); w.y = pk2(acc[mt][8 * s2 + 2], acc[mt][8 * s2 + 3]); w.z = pk2(acc[mt][8 * s2 + 4], acc[mt][8 * s2 + 5]); w.w = pk2(acc[mt][8 * s2 + 6], acc[mt][8 * s2 + 7]); \
                sf[2 * mt + s2] = __builtin_bit_cast(bf16x8, w); *(GAS v4u*)(gs + ((et * 8 + 2 * mt + s2) * 64 + lane) * 16) = w; } \
            _Pragma("unroll") for (int mt = 0; mt < 4; ++mt) _Pragma("unroll") for (int q = 0; q < 4; ++q) { const v2u w = nf[cur][mt][q]; acc[mt][4 * q] = bflo(w.x); acc[mt][4 * q + 1] = bfhi(w.x); acc[mt][4 * q + 2] = bflo(w.y); acc[mt][4 * q + 3] = bfhi(w.y); } \
            GS_LOAD_N(cur, (n_) + 2); \
            _Pragma("unroll") for (int s = 0; s < 8; ++s) _Pragma("unroll") for (int mt = 0; mt < 4; ++mt) acc[mt] = mfma32(ldfrag(mb, ((mt * 8 + s) * 64 + lane) * 16), sf[s], acc[mt]); } \
        GS_WRITE_M(oth, oth); \
        __syncthreads(); } while (0)
    for (int n = 0; n < nch; n += 2) { GS_ITER(n, 0, 1); if (n + 1 < nch) GS_ITER(n + 1, 1, 0); }
#undef GS_ITER
#undef GS_WRITE_M
#undef GS_LOAD_N
#undef GS_LOAD_M
#undef GS_ITEM
    if (wave == 0) {
#pragma unroll
        for (int mt = 0; mt < 4; ++mt)
#pragma unroll
            for (int r = 0; r < 16; ++r) sfinal[(size_t)(32 * mt + (r & 3) + 8 * (r >> 2) + 4 * hh) * 128 + e_] = acc[mt][r];
    }
}
__device__ __forceinline__ void gdn_out_item(const Ptrs& P, LAS unsigned char* wl, int cid, int h, int lane) {
    const ChunkInfo ci = chunk_info(cid); const int item = cid * 4 + h; const int c32 = lane & 31, hh = lane >> 5;
    const unsigned char* gs = (const unsigned char*)(P.GS() + (size_t)item * 16384); const unsigned char* gq = (const unsigned char*)(P.GQH() + (size_t)item * 8192); const unsigned char* go = (const unsigned char*)(P.GOI() + (size_t)item * 8192);
#pragma unroll 1
    for (int it = 0; it < 2; ++it) { const int i = 32 * it + c32;
        bf16x8 bq[8];
#pragma unroll
        for (int s = 0; s < 8; ++s) bq[s] = *(const GAS bf16x8*)(gq + ((it * 8 + s) * 64 + lane) * 16);
        f32x16 acc[4]; float ss = 0.f;
#pragma unroll
        for (int et = 0; et < 4; ++et) {
#pragma unroll
            for (int q = 0; q < 4; ++q) { const v2u w = *(const GAS v2u*)(go + (((it * 4 + et) * 4 + q) * 64 + lane) * 8); acc[et][4 * q] = bflo(w.x); acc[et][4 * q + 1] = bfhi(w.x); acc[et][4 * q + 2] = bflo(w.y); acc[et][4 * q + 3] = bfhi(w.y); }
#pragma unroll
            for (int s = 0; s < 8; ++s) acc[et] = mfma32(*(const GAS bf16x8*)(gs + ((et * 8 + s) * 64 + lane) * 16), bq[s], acc[et]);
#pragma unroll
            for (int r = 0; r < 16; ++r) ss += acc[et][r] * acc[et][r];
        }
        ss += __shfl_xor(ss, 32);
        const float rstd = 1.0f / sqrtf(ss * (1.f / 128.f) + RMS_EPS);
#pragma unroll
        for (int et = 0; et < 4; ++et)
#pragma unroll
            for (int q = 0; q < 4; ++q) { v2u w; w.x = pk2(acc[et][4 * q] * rstd, acc[et][4 * q + 1] * rstd); w.y = pk2(acc[et][4 * q + 2] * rstd, acc[et][4 * q + 3] * rstd);
                *(LAS v2u*)(wl + i * 272 + (32 * et + 8 * q + 4 * hh) * 2) = w; }
    }
    LDS_WAIT(); asm volatile("" ::: "memory");
    {   const int e8 = (lane & 15) * 8; const f32x4 g0 = *(const f32x4*)(P.gdn_g() + e8), g1 = *(const f32x4*)(P.gdn_g() + e8 + 4);
#pragma unroll 4
        for (int k = 0; k < 16; ++k) { const int row = 4 * k + (lane >> 4);
            if (row < ci.ntok) { const int m = ci.m0 + row; float o[8], z[8];
                unpack8(*(const LAS v4u*)(wl + row * 272 + e8 * 2), o); unpack8(*(const GAS v4u*)(P.PROJ() + (size_t)m * NPROJ + OFF_Z + h * 128 + e8), z);
#pragma unroll
                for (int e = 0; e < 8; ++e) o[e] = o[e] * (e < 4 ? g0[e] : g1[e - 4]) * (z[e] * fsig(z[e]));
                *(GAS v4u*)(P.XN() + (size_t)m * DM + 512 + h * 128 + e8) = pack8(o); } }
    }
    LDS_WAIT(); asm volatile("" ::: "memory");
}
constexpr int RL_LT = 0, RL_VEC = 17408, RL_SCR = 17664, RL_IMG = 19712;
enum { RI_AL = 0, RI_BE, RI_KT, RI_RT, RI_BET, RI_KTT, RI_VT, RI_LK  , RI_QRB, RI_OMT, RI_XT, RI_CM, RI_KHT,
       RI_ALT = RI_OMT  , RI_LKT = RI_XT  , RI_TBLK = RI_CM  , RI_LP = RI_KHT   };
__device__ __forceinline__ int rimg(int i) { return RL_IMG + i * 9216; }
static_assert(RL_IMG + 13 * 9216 <= LDSCTL_OFF, "rwkv prep LDS");
__device__ __forceinline__ f32x16 tile_mm(LAS unsigned char* lds, int a_img, int at, int b_img, int bt, int s0, int s1, int c32, int hh, f32x16 acc) {
    const int ao = a_img + (32 * at + c32) * 144 + hh * 16, bo = b_img + (32 * bt + c32) * 144 + hh * 16;
#pragma unroll
    for (int s = 0; s < 4; ++s) if (s >= s0 && s < s1) acc = mfma32(ldfrag(lds, ao + s * 32), ldfrag(lds, bo + s * 32), acc);
    return acc;
}
struct RRaw { unsigned ur[9], uk[9], uv[9], ux[8], ua[8]; float rn[8]; float s0, s1, s2; };
__device__ __forceinline__ void rwkv_load_raw(const Ptrs& P, int cid, int h, int wave, int lane, RRaw& R) {
    const ChunkInfo ci = chunk_info(cid); const int col = h * 64 + lane, tk0 = 8 * wave;
#pragma unroll
    for (int i = 0; i < 9; ++i) { const int tk = tk0 - 1 + i; unsigned a = 0, b = 0, c = 0;
        if (tk < ci.ntok && ci.n * 64 + tk >= 0) { const bf16* pr = P.PROJ() + (size_t)(ci.m0 + tk) * NPROJ + col; a = pr[0]; b = pr[512]; c = pr[1024]; }
        R.ur[i] = a; R.uk[i] = b; R.uv[i] = c; }
    R.s0 = 0.f; R.s1 = 0.f; R.s2 = 0.f;
    if (tk0 == 0 && ci.sb >= 0) { const float* sp = P.sshift() + (size_t)ci.sb * RPROJ + col; R.s0 = sp[0]; R.s1 = sp[512]; R.s2 = sp[1024]; }
#pragma unroll
    for (int i = 0; i < 8; ++i) { const int tk = tk0 + i; unsigned x = 0, a = 0; float rn = 0.f;
        if (tk < ci.ntok) { const size_t m = (size_t)(ci.m0 + tk); x = P.XA()[m * 512 + col]; a = P.AA()[m * 512 + col]; rn = P.RN()[m * 8 + h]; }
        R.ux[i] = x; R.ua[i] = a; R.rn[i] = rn; }
}
__device__ __forceinline__ void rwkv_prep_item(const Ptrs& P, LAS unsigned char* lds, int cid, int h, int tid, RRaw& R, int ncid) {
    const ChunkInfo ci = chunk_info(cid); const int item = cid * 8 + h;
    int lane = tid & 63, wave = __builtin_amdgcn_readfirstlane(tid >> 6), c32 = lane & 31, hh = lane >> 5;
#define OPAQUE_LANE() do { asm volatile("" : "+v"(lane)); asm volatile("" : "+s"(wave)); c32 = lane & 31; hh = lane >> 5; } while (0)
    LAS float* pc = (LAS float*)(lds + RL_VEC); LAS float* scr = (LAS float*)(lds + RL_SCR);
#ifndef DUP_R1
#define DUP_R1 1
#endif
#ifndef DUP_R2
#define DUP_R2 1
#endif
#ifndef DUP_R3
#define DUP_R3 1
#endif
#ifndef DUP_R4
#define DUP_R4 1
#endif
    for (int d_ = 0; d_ < DUP_R1; ++d_) {   const int ch = lane, col = h * 64 + ch; const int tk0 = 8 * wave;
        const float mur = P.mu()[col], muk = P.mu()[512 + col], muv = P.mu()[1024 + col], kkc = P.k_k()[col], kac = P.k_a()[col];
        float fr[9], fk[9], fv[9];
#pragma unroll
        for (int i = 0; i < 9; ++i) { fr[i] = __uint_as_float(R.ur[i] << 16); fk[i] = __uint_as_float(R.uk[i] << 16); fv[i] = __uint_as_float(R.uv[i] << 16); }
        if (tk0 == 0 && ci.sb >= 0) { fr[0] = R.s0; fk[0] = R.s1; fv[0] = R.s2; }
        float xs[8], av[8], rnv[8];
#pragma unroll
        for (int i = 0; i < 8; ++i) { xs[i] = __uint_as_float(R.ux[i] << 16); av[i] = __uint_as_float(R.ua[i] << 16); rnv[i] = R.rn[i]; }
        float cum[8]; float run = 0.f;
#pragma unroll
        for (int i = 0; i < 8; ++i) { run += xs[i]; cum[i] = run; }
        scr[wave * 64 + ch] = run;
        LDS_BARRIER();
        float off = 0.f;
#pragma unroll
        for (int w2 = 0; w2 < 8; ++w2) if (w2 < wave) off += scr[w2 * 64 + ch];
        float be[8], kt[8], vv[8];
#pragma unroll
        for (int i = 0; i < 8; ++i) { const int tk = tk0 + i; const bool valid = tk < ci.ntok;
            const float r = fr[i + 1] + (fr[i] - fr[i + 1]) * mur, k = fk[i + 1] + (fk[i] - fk[i + 1]) * muk, v = fv[i + 1] + (fv[i] - fv[i + 1]) * muv;
            const float c1 = off + cum[i], c0 = c1 - xs[i]; const float kap = k * kkc * rnv[i], keff = k * (1.f + (av[i] - 1.f) * kac);
            const float ec = __expf(c1);
            const float al = valid ? kap * __expf(-c0) : 0.f, b_ = valid ? kap * av[i] * ec : 0.f, kt_ = valid ? keff * ec : 0.f, rt = valid ? r * __expf(-c1) : 0.f;
            be[i] = b_; kt[i] = kt_; vv[i] = valid ? v : 0.f;
            *(LAS unsigned short*)(lds + rimg(RI_AL) + tk * 144 + ch * 2) = (unsigned short)f2bf(al);
            *(LAS unsigned short*)(lds + rimg(RI_BE) + tk * 144 + ch * 2) = (unsigned short)f2bf(b_);
            *(LAS unsigned short*)(lds + rimg(RI_KT) + tk * 144 + ch * 2) = (unsigned short)f2bf(kt_);
            *(LAS unsigned short*)(lds + rimg(RI_RT) + tk * 144 + ch * 2) = (unsigned short)f2bf(rt);
            if (tk == 63) pc[ch] = __expf(-c1); }
        *(LAS v4u*)(lds + rimg(RI_BET) + ch * 144 + tk0 * 2) = pack8(be);
        *(LAS v4u*)(lds + rimg(RI_KTT) + ch * 144 + tk0 * 2) = pack8(kt);
        *(LAS v4u*)(lds + rimg(RI_VT) + ch * 144 + tk0 * 2) = pack8(vv);
    }
    if (ncid >= 0) rwkv_load_raw(P, ncid, h, wave, lane, R);
    LDS_BARRIER();
    OPAQUE_LANE();
    for (int d_ = 0; d_ < DUP_R2; ++d_)
#pragma unroll 1
    for (int task = wave; task < 15; task += 8) {
        if (task < 9) { const int type = task / 3, tl = task % 3, ti = tl == 1 ? 0 : 1, tj = tl == 2 ? 1 : 0;
            if (type < 2) { const f32x16 acc = tile_mm(lds, rimg(RI_AL), ti, rimg(type == 0 ? RI_BE : RI_KT), tj, 0, 4, c32, hh, zero16()); const int j = 32 * tj + c32;
#pragma unroll
                for (int q = 0; q < 4; ++q) { f32x4 o;
#pragma unroll
                    for (int e = 0; e < 4; ++e) { const int t = 32 * ti + 8 * q + 4 * hh + e; o[e] = t > j ? acc[4 * q + e] : 0.f; }
                    if (type == 0) *(LAS f32x4*)(lds + RL_LT + j * 272 + (32 * ti + 8 * q + 4 * hh) * 4) = o;
                    else { v2u w; w.x = pk2(o[0], o[1]); w.y = pk2(o[2], o[3]); *(LAS v2u*)(lds + rimg(RI_LKT) + j * 144 + (32 * ti + 8 * q + 4 * hh) * 2) = w; } } }
            else { const f32x16 acc = tile_mm(lds, rimg(RI_BE), tj, rimg(RI_RT), ti, 0, 4, c32, hh, zero16()); const int t = 32 * ti + c32;
#pragma unroll
                for (int q = 0; q < 4; ++q) { float o[4];
#pragma unroll
                    for (int e = 0; e < 4; ++e) { const int j = 32 * tj + 8 * q + 4 * hh + e; o[e] = j <= t ? acc[4 * q + e] : 0.f; }
                    v2u w; w.x = pk2(o[0], o[1]); w.y = pk2(o[2], o[3]); *(LAS v2u*)(lds + rimg(RI_QRB) + t * 144 + (32 * tj + 8 * q + 4 * hh) * 2) = w; } }
        } else if (task < 13) { const int rt_ = (task - 9) >> 1, ct = (task - 9) & 1;
            f32x16 acc = zero16();
#pragma unroll
            for (int s2 = 0; s2 < 2; ++s2) { const int s = 2 * ct + s2; v4u id; const int kd = 32 * ct + c32 - 16 * s - 8 * hh;
                id.x = (kd == 0 ? 0x3F80u : 0u) | (kd == 1 ? 0x3F800000u : 0u); id.y = (kd == 2 ? 0x3F80u : 0u) | (kd == 3 ? 0x3F800000u : 0u); id.z = (kd == 4 ? 0x3F80u : 0u) | (kd == 5 ? 0x3F800000u : 0u); id.w = (kd == 6 ? 0x3F80u : 0u) | (kd == 7 ? 0x3F800000u : 0u);
                acc = mfma32(ldfrag(lds, rimg(RI_AL) + (32 * rt_ + c32) * 144 + hh * 16 + s * 32), __builtin_bit_cast(bf16x8, id), acc); }
#pragma unroll
            for (int q = 0; q < 4; ++q) { v2u w; w.x = pk2(acc[4 * q], acc[4 * q + 1]); w.y = pk2(acc[4 * q + 2], acc[4 * q + 3]); *(LAS v2u*)(lds + rimg(RI_ALT) + (32 * ct + c32) * 144 + (32 * rt_ + 8 * q + 4 * hh) * 2) = w; }
        } else {
            LAS unsigned char* dst = task == 13 ? lds + rimg(RI_LKT) + (32 + (lane >> 1)) * 144 + (lane & 1) * 32 : lds + rimg(RI_QRB) + (lane >> 1) * 144 + 64 + (lane & 1) * 32;
            *(LAS v4u*)dst = (v4u){0u, 0u, 0u, 0u}; *(LAS v4u*)(dst + 16) = (v4u){0u, 0u, 0u, 0u}; }
    }
    LDS_BARRIER();
    OPAQUE_LANE();
    for (int d_ = 0; d_ < DUP_R3; ++d_) {
    if (wave == 0) { const int bb = lane >> 4, c = lane & 15; float T[16];
#pragma unroll
        for (int i = 0; i < 16; ++i) T[i] = i == c ? 1.f : 0.f;
#pragma unroll
        for (int j = 0; j < 15; ++j) { const LAS unsigned char* ar = lds + RL_LT + (16 * bb + j) * 272 + bb * 64;
#pragma unroll
            for (int g4 = (j + 1) >> 2; g4 < 4; ++g4) { const f32x4 a4 = *(const LAS f32x4*)(ar + g4 * 16);
#pragma unroll
                for (int e = 0; e < 4; ++e) { const int i = 4 * g4 + e; if (i > j) T[i] = fmaf(-a4[e], T[j], T[i]); } } }
#pragma unroll
        for (int i = 0; i < 16; ++i)
#pragma unroll
            for (int b2 = 0; b2 < 4; ++b2) *(LAS unsigned short*)(lds + rimg(RI_TBLK) + (16 * bb + i) * 144 + (16 * b2 + c) * 2) = b2 == bb ? (unsigned short)f2bf(T[i]) : (unsigned short)0;
    } else { for (int u = tid - 64; u < 576; u += 448) *(LAS v4u*)(lds + rimg(RI_LP) + u * 16) = (v4u){0u, 0u, 0u, 0u}; }
    LDS_BARRIER();
    OPAQUE_LANE();
    if (wave < 6) { const int bt = wave < 1 ? 1 : (wave < 3 ? 2 : 3), bj = wave < 1 ? 0 : (wave < 3 ? wave - 1 : wave - 3); const int s = bt >> 1, r16 = lane & 15, g4 = lane >> 4;
        const LAS float* lp = (const LAS float*)(lds + RL_LT + (16 * bj + r16) * 272 + (32 * s + 8 * g4) * 4); const f32x4 x0 = *(const LAS f32x4*)lp, x1 = *(const LAS f32x4*)(lp + 4);
        v4u aw; aw.x = pk2(x0[0], x0[1]); aw.y = pk2(x0[2], x0[3]); aw.z = pk2(x1[0], x1[1]); aw.w = pk2(x1[2], x1[3]);
        const f32x4 acc = mfma16(__builtin_bit_cast(bf16x8, aw), ldfrag(lds, rimg(RI_TBLK) + (16 * bt + r16) * 144 + (32 * s + 8 * g4) * 2), (f32x4){0.f, 0.f, 0.f, 0.f});
        v2u w; w.x = pk2(-acc[0], -acc[1]); w.y = pk2(-acc[2], -acc[3]);
        *(LAS v2u*)(lds + rimg(RI_LP) + (16 * bt + r16) * 144 + (16 * bj + 4 * g4) * 2) = w; }
    LDS_BARRIER();
    OPAQUE_LANE();
    {   const int r16 = lane & 15, g4 = lane >> 4; const int img = rimg(wave < 4 ? RI_OMT : RI_XT) + (16 * (wave & 3) + r16) * 144;
#pragma unroll
        for (int bt = 0; bt < 4; ++bt) { const int s0 = bt >> 1;
            f32x4 acc = mfma16(ldfrag(lds, rimg(RI_TBLK) + (16 * bt + r16) * 144 + (32 * s0 + 8 * g4) * 2), ldfrag(lds, img + (32 * s0 + 8 * g4) * 2), (f32x4){0.f, 0.f, 0.f, 0.f});
#pragma unroll
            for (int s = 0; s < 2; ++s) if (s < ((16 * bt + 31) >> 5)) acc = mfma16(ldfrag(lds, rimg(RI_LP) + (16 * bt + r16) * 144 + (32 * s + 8 * g4) * 2), ldfrag(lds, img + (32 * s + 8 * g4) * 2), acc);
            v2u w; w.x = pk2(acc[0], acc[1]); w.y = pk2(acc[2], acc[3]);
            *(LAS v2u*)(lds + img + (16 * bt + 4 * g4) * 2) = w;
            LDS_WAIT(); asm volatile("" ::: "memory"); }
    }
    }
    LDS_BARRIER();
    OPAQUE_LANE();
    for (int d_ = 0; d_ < DUP_R4; ++d_)
    {   bf16* RRH = P.RRH() + (size_t)item * 4096; bf16* RPHI = P.RPHI() + (size_t)item * 4096;
#pragma unroll 1
        for (int task = wave; task < 16; task += 8) { const int type = task >> 2, ta = (task >> 1) & 1, tb = task & 1;
            if (type == 0) {
                const int t = 32 * tb + c32; v2u w[4];
                if (ta <= tb) { const f32x16 acc = tile_mm(lds, rimg(RI_KT), ta, rimg(RI_RT), tb, 0, 4, c32, hh, zero16());
                    const f32x16 acx = tile_mm(lds, rimg(RI_XT), ta, rimg(RI_QRB), tb, 0, 4, c32, hh, zero16());
#pragma unroll
                    for (int q = 0; q < 4; ++q) { float o[4];
#pragma unroll
                        for (int e = 0; e < 4; ++e) { const int j = 32 * ta + 8 * q + 4 * hh + e; o[e] = (j <= t ? acc[4 * q + e] : 0.f) - acx[4 * q + e]; }
                        w[q].x = pk2(o[0], o[1]); w[q].y = pk2(o[2], o[3]); } }
                else {
#pragma unroll
                    for (int q = 0; q < 4; ++q) w[q] = (v2u){0u, 0u}; }
#pragma unroll
                for (int q = 0; q < 4; ++q) *(LAS v2u*)(lds + rimg(RI_CM) + t * 144 + (32 * ta + 8 * q + 4 * hh) * 2) = w[q]; }
            else if (type == 1) {
                const int t = 32 * tb + c32; const f32x16 acc = tile_mm(lds, rimg(RI_OMT), ta, rimg(RI_QRB), tb, 0, 4, c32, hh, zero16());
#pragma unroll
                for (int q = 0; q < 4; ++q) { const int k = 32 * ta + 8 * q + 4 * hh; const v2u rr = *(const LAS v2u*)(lds + rimg(RI_RT) + t * 144 + k * 2);
                    v2u w; w.x = pk2(bflo(rr.x) - acc[4 * q], bfhi(rr.x) - acc[4 * q + 1]); w.y = pk2(bflo(rr.y) - acc[4 * q + 2], bfhi(rr.y) - acc[4 * q + 3]);
                    *(GAS v2u*)((unsigned char*)RRH + ((tb * 4 + 2 * ta + (q >> 1)) * 64 + lane) * 16 + (q & 1) * 8) = w; } }
            else if (type == 2) {
                const int k = 32 * tb + c32; const float pk = pc[k]; const f32x16 acc = tile_mm(lds, rimg(RI_XT), ta, rimg(RI_BET), tb, 0, 4, c32, hh, zero16());
#pragma unroll
                for (int q = 0; q < 4; ++q) { const int j = 32 * ta + 8 * q + 4 * hh; const v2u kk = *(const LAS v2u*)(lds + rimg(RI_KTT) + k * 144 + j * 2);
                    v2u w; w.x = pk2((bflo(kk.x) - acc[4 * q]) * pk, (bfhi(kk.x) - acc[4 * q + 1]) * pk); w.y = pk2((bflo(kk.y) - acc[4 * q + 2]) * pk, (bfhi(kk.y) - acc[4 * q + 3]) * pk);
                    *(LAS v2u*)(lds + rimg(RI_KHT) + k * 144 + j * 2) = w; } }
            else {
                const int k = 32 * tb + c32; const float pk = pc[k]; const f32x16 acc = tile_mm(lds, rimg(RI_OMT), ta, rimg(RI_BET), tb, 0, 4, c32, hh, zero16());
#pragma unroll
                for (int q = 0; q < 4; ++q) { float o[4];
#pragma unroll
                    for (int e = 0; e < 4; ++e) { const int kp = 32 * ta + 8 * q + 4 * hh + e; o[e] = ((kp == k ? 1.f : 0.f) - acc[4 * q + e]) * pk; }
                    v2u w; w.x = pk2(o[0], o[1]); w.y = pk2(o[2], o[3]);
                    *(GAS v2u*)((unsigned char*)RPHI + ((tb * 4 + 2 * ta + (q >> 1)) * 64 + lane) * 16 + (q & 1) * 8) = w; } }
        }
    }
    LDS_BARRIER();
    OPAQUE_LANE();
    {   const int type = wave >> 2, ta = (wave >> 1) & 1, tb = wave & 1;
        if (type == 0) {
            const int v = 32 * tb + c32; const f32x16 acc = tile_mm(lds, rimg(RI_KHT), ta, rimg(RI_VT), tb, 0, 4, c32, hh, zero16()); bf16* RPSI = P.RPSI() + (size_t)item * 4096;
#pragma unroll
            for (int q = 0; q < 4; ++q) { v2u w; w.x = pk2(acc[4 * q], acc[4 * q + 1]); w.y = pk2(acc[4 * q + 2], acc[4 * q + 3]); *(GAS v2u*)((unsigned char*)RPSI + (((tb * 2 + ta) * 4 + q) * 64 + lane) * 8) = w; } }
        else {
            const int t = 32 * tb + c32; const f32x16 acc = tile_mm(lds, rimg(RI_VT), ta, rimg(RI_CM), tb, 0, 4, c32, hh, zero16()); bf16* RYI = P.RYI() + (size_t)item * 4096;
#pragma unroll
            for (int q = 0; q < 4; ++q) { v2u w; w.x = pk2(acc[4 * q], acc[4 * q + 1]); w.y = pk2(acc[4 * q + 2], acc[4 * q + 3]); *(GAS v2u*)((unsigned char*)RYI + (((tb * 2 + ta) * 4 + q) * 64 + lane) * 8) = w; } }
    }
    LDS_BARRIER();
#undef OPAQUE_LANE
}
__device__ __forceinline__ void rwkv_serial_job(const Ptrs& P, int item0, int istride, int nch, const float* s0, float* sfinal, int wsel, int lane) {
    const int c32 = lane & 31, hh = lane >> 5, v = 32 * wsel + c32;
    f32x16 acc[2];
#pragma unroll
    for (int mt = 0; mt < 2; ++mt)
#pragma unroll
        for (int r = 0; r < 16; ++r) acc[mt][r] = s0 ? s0[(size_t)v * 64 + 32 * mt + (r & 3) + 8 * (r >> 2) + 4 * hh] : 0.f;
    bf16x8 af[3][2][4]; v2u pf[3][2][4];
#define RS_ITEM(n_) (item0 + ((n_) < nch ? (n_) : nch - 1) * istride)
#define RS_LOAD(set, n_) do { const unsigned char* ph_ = (const unsigned char*)(P.RPHI() + (size_t)RS_ITEM(n_) * 4096); const unsigned char* ps_ = (const unsigned char*)(P.RPSI() + (size_t)RS_ITEM(n_) * 4096); \
        _Pragma("unroll") for (int mt = 0; mt < 2; ++mt) _Pragma("unroll") for (int s = 0; s < 4; ++s) { af[set][mt][s] = *(const GAS bf16x8*)(ph_ + ((mt * 4 + s) * 64 + lane) * 16); pf[set][mt][s] = *(const GAS v2u*)(ps_ + (((wsel * 2 + mt) * 4 + s) * 64 + lane) * 8); } } while (0)
#define RS_ITER(n_, set) do { bf16x8 sf[4]; unsigned char* rs = (unsigned char*)(P.RS() + (size_t)RS_ITEM(n_) * 4096); \
        _Pragma("unroll") for (int mt = 0; mt < 2; ++mt) _Pragma("unroll") for (int s2 = 0; s2 < 2; ++s2) { v4u w; w.x = pk2(acc[mt][8 * s2], acc[mt][8 * s2 + 1]); w.y = pk2(acc[mt][8 * s2 + 2], acc[mt][8 * s2 + 3]); w.z = pk2(acc[mt][8 * s2 + 4], acc[mt][8 * s2 + 5]); w.w = pk2(acc[mt][8 * s2 + 6], acc[mt][8 * s2 + 7]); \
            sf[2 * mt + s2] = __builtin_bit_cast(bf16x8, w); *(GAS v4u*)(rs + ((wsel * 4 + 2 * mt + s2) * 64 + lane) * 16) = w; } \
        _Pragma("unroll") for (int mt = 0; mt < 2; ++mt) _Pragma("unroll") for (int q = 0; q < 4; ++q) { const v2u w = pf[set][mt][q]; acc[mt][4 * q] = bflo(w.x); acc[mt][4 * q + 1] = bfhi(w.x); acc[mt][4 * q + 2] = bflo(w.y); acc[mt][4 * q + 3] = bfhi(w.y); } \
        _Pragma("unroll") for (int s = 0; s < 4; ++s) _Pragma("unroll") for (int mt = 0; mt < 2; ++mt) acc[mt] = mfma32(af[set][mt][s], sf[s], acc[mt]); \
        RS_LOAD(set, (n_) + 3); } while (0)
    RS_LOAD(0, 0); RS_LOAD(1, 1); RS_LOAD(2, 2);
    for (int n = 0; n < nch; n += 3) { RS_ITER(n, 0); if (n + 1 < nch) RS_ITER(n + 1, 1); if (n + 2 < nch) RS_ITER(n + 2, 2); }
#undef RS_ITER
#undef RS_LOAD
#undef RS_ITEM
#pragma unroll
    for (int mt = 0; mt < 2; ++mt)
#pragma unroll
        for (int q = 0; q < 4; ++q) *(f32x4*)(sfinal + (size_t)v * 64 + 32 * mt + 8 * q + 4 * hh) = (f32x4){acc[mt][4 * q], acc[mt][4 * q + 1], acc[mt][4 * q + 2], acc[mt][4 * q + 3]};
}
__device__ __forceinline__ void rwkv_out_item(const Ptrs& P, LAS unsigned char* wl, int cid, int h, int lane) {
    const ChunkInfo ci = chunk_info(cid); const int item = cid * 8 + h; const int c32 = lane & 31, hh = lane >> 5;
    const unsigned char* rs = (const unsigned char*)(P.RS() + (size_t)item * 4096); const unsigned char* rh = (const unsigned char*)(P.RRH() + (size_t)item * 4096); const unsigned char* yi = (const unsigned char*)(P.RYI() + (size_t)item * 4096);
#pragma unroll 1
    for (int tb = 0; tb < 2; ++tb) { const int t = 32 * tb + c32;
        bf16x8 bq[4];
#pragma unroll
        for (int s = 0; s < 4; ++s) bq[s] = *(const GAS bf16x8*)(rh + ((tb * 4 + s) * 64 + lane) * 16);
        f32x16 acc[2]; float sm = 0.f;
#pragma unroll
        for (int vt = 0; vt < 2; ++vt) {
#pragma unroll
            for (int q = 0; q < 4; ++q) { const v2u w = *(const GAS v2u*)(yi + (((tb * 2 + vt) * 4 + q) * 64 + lane) * 8); acc[vt][4 * q] = bflo(w.x); acc[vt][4 * q + 1] = bfhi(w.x); acc[vt][4 * q + 2] = bflo(w.y); acc[vt][4 * q + 3] = bfhi(w.y); }
#pragma unroll
            for (int s = 0; s < 4; ++s) acc[vt] = mfma32(*(const GAS bf16x8*)(rs + ((vt * 4 + s) * 64 + lane) * 16), bq[s], acc[vt]);
#pragma unroll
            for (int r = 0; r < 16; ++r) sm += acc[vt][r];
        }
        sm += __shfl_xor(sm, 32); const float mean = sm * (1.f / 64.f); float sq = 0.f;
#pragma unroll
        for (int vt = 0; vt < 2; ++vt)
#pragma unroll
            for (int r = 0; r < 16; ++r) { acc[vt][r] -= mean; sq += acc[vt][r] * acc[vt][r]; }
        sq += __shfl_xor(sq, 32); const float rstd = 1.0f / sqrtf(sq * (1.f / 64.f) + GN_EPS);
#pragma unroll
        for (int vt = 0; vt < 2; ++vt)
#pragma unroll
            for (int q = 0; q < 4; ++q) { v2u w; w.x = pk2(acc[vt][4 * q] * rstd, acc[vt][4 * q + 1] * rstd); w.y = pk2(acc[vt][4 * q + 2] * rstd, acc[vt][4 * q + 3] * rstd);
                *(LAS v2u*)(wl + t * 144 + (32 * vt + 8 * q + 4 * hh) * 2) = w; }
    }
    LDS_WAIT(); asm volatile("" ::: "memory");
    {   const int c0 = h * 64 + (lane & 7) * 8;
#pragma unroll 2
        for (int kk = 0; kk < 8; ++kk) { const int row = 8 * kk + (lane >> 3);
            if (row < ci.ntok) { const int m = ci.m0 + row; int t, sb; row_info(m, t, sb);
                float y[8], r[8], k[8], v[8], a[8], g[8];
                unpack8(*(const LAS v4u*)(wl + row * 144 + (lane & 7) * 16), y);
                load_fm8(P, m, t, sb, c0, r); load_fm8(P, m, t, sb, 512 + c0, k); load_fm8(P, m, t, sb, 1024 + c0, v);
                unpack8(*(const GAS v4u*)(P.AA() + (size_t)m * 512 + c0), a); unpack8(*(const GAS v4u*)(P.GA() + (size_t)m * 512 + c0), g);
                float rk = 0.f;
#pragma unroll
                for (int i = 0; i < 8; ++i) rk += r[i] * k[i] * (1.f + (a[i] - 1.f) * P.k_a()[c0 + i]) * P.r_k()[c0 + i];
                rk += __shfl_xor(rk, 1); rk += __shfl_xor(rk, 2); rk += __shfl_xor(rk, 4);
                float o[8];
#pragma unroll
                for (int i = 0; i < 8; ++i) o[i] = (y[i] * P.lnx_w()[c0 + i] + P.lnx_b()[c0 + i] + rk * v[i]) * g[i];
                *(GAS v4u*)(P.XN() + (size_t)m * DM + c0) = pack8(o); } }
    }
    LDS_WAIT(); asm volatile("" ::: "memory");
}
struct MiniOp { const bf16* A; int lda; int K; };
template <int NB, class BRow0, class BRow1, class Epi>
__device__ __forceinline__ void mini_tile(LAS unsigned char* lds, const MiniOp o0, const MiniOp o1, int mt, BRow0 brow0, BRow1 brow1, Epi epi, int tid) {
    const int lane = tid & 63, wave = __builtin_amdgcn_readfirstlane(tid >> 6), c32 = lane & 31, hh = lane >> 5;
    f32x16 acc[NB];
#pragma unroll
    for (int b = 0; b < NB; ++b) { acc[b] = zero16();
        const MiniOp o = b == 0 ? o0 : o1; const int kw = o.K >> 3, k0 = wave * kw;
        const bf16* ap = o.A + (size_t)(32 * mt + c32) * o.lda + k0 + 8 * hh; const bf16* bp = (b == 0 ? brow0(c32) : brow1(c32)) + k0 + 8 * hh;
#pragma unroll 4
        for (int s = 0; s < kw; s += 16) acc[b] = mfma32(*(const GAS bf16x8*)(ap + s), *(const GAS bf16x8*)(bp + s), acc[b]);
    }
    LAS float* part = (LAS float*)lds;
#pragma unroll
    for (int b = 0; b < NB; ++b)
#pragma unroll
        for (int r = 0; r < 16; ++r) part[((wave * NB + b) * 16 + r) * 64 + lane] = acc[b][r];
    __syncthreads();
#pragma unroll
    for (int i = 0; i < 2; ++i) { const int e = tid + 512 * i, reg = e >> 6, ln = e & 63; float v[NB];
#pragma unroll
        for (int b = 0; b < NB; ++b) { float s = 0.f;
#pragma unroll
            for (int w = 0; w < 8; ++w) s += part[((w * NB + b) * 16 + reg) * 64 + ln];
            v[b] = s; }
        epi(32 * mt + (reg & 3) + 8 * (reg >> 2) + 4 * (ln >> 5), ln & 31, v[0], v[NB - 1]); }
    __syncthreads();
}
__device__ __forceinline__ float sample_rstd(const float* ssq, int ms) { const f32x4* p = (const f32x4*)(ssq + (size_t)ms * 32); float s = 0.f;
#pragma unroll
    for (int i = 0; i < 8; ++i) { const f32x4 a = p[i]; s += (a.x + a.y) + (a.z + a.w); }
    return 1.0f / sqrtf(s * (1.f / DM) + RMS_EPS); }
__device__ __forceinline__ float half_wave_sum32(float v) { v += __shfl_xor(v, 1); v += __shfl_xor(v, 2); v += __shfl_xor(v, 4); v += __shfl_xor(v, 8); v += __shfl_xor(v, 16); return v; }
__device__ __forceinline__ void mini_lora(const Ptrs& P, LAS unsigned char* lds, int vcu, int G, int tid) {
    for (int t = vcu; t < 8 * 48; t += G) { const int mt = t & 7, nt = t >> 3;
        const bf16* W = P.Wlora_t(); const float* w0 = P.w0(); const float* a0 = P.a0(); bf16* XA = P.XA();
        auto brow = [=](int c) { return W + (size_t)(32 * nt + c) * KLORA; };
        auto epi = [=](int ms, int c, float v, float) { const int n = 32 * nt + c, part = n >> 9, cc = n & 511; float o = v;
            if (part == 0) { const float z = -(v + w0[cc]); o = __expf(-fsoftplus(z) - 0.5f); } else if (part == 1) o = fsig(v + a0[cc]);
            XA[(size_t)part * ((WS_AA - WS_XA) / 2) + (size_t)(MP + ms) * 512 + cc] = (bf16)f2bf(o); };
        mini_tile<1>(lds, MiniOp{P.LIN() + (size_t)MP * KLORA, KLORA, KLORA}, MiniOp{nullptr, 0, 0}, mt, brow, brow, epi, tid); }
}
__device__ __forceinline__ void mini_outproj(const Ptrs& P, LAS unsigned char* lds, int vcu, int G, int tid) {
    for (int t = vcu; t < 8 * 32; t += G) { const int mt = t & 7, nt = t >> 3;
        const bf16* W = P.Wout_t(); const float* xs = P.xs(); float* out = P.out() + (size_t)MP * DM; bf16* xb = P.PROJ() + (size_t)MP * DM; float* ssq = P.SSQS2();
        auto brow = [=](int c) { return W + (size_t)(32 * nt + c) * DM; };
        auto epi = [=](int ms, int c, float v, float) { const size_t o = (size_t)ms * DM + 32 * nt + c; const float x2 = xs[o] + v; out[o] = x2; xb[o] = (bf16)f2bf(x2);
            const float s = half_wave_sum32(x2 * x2); if (c == 0) ssq[(size_t)ms * 32 + nt] = s; };
        mini_tile<1>(lds, MiniOp{P.XN() + (size_t)MP * DM, DM, DM}, MiniOp{nullptr, 0, 0}, mt, brow, brow, epi, tid); }
}
__device__ __forceinline__ void mini_gateup(const Ptrs& P, LAS unsigned char* lds, int vcu, int G, int tid) {
    for (int t = vcu; t < 8 * 88; t += G) { const int mt = t & 7, nt = t >> 3;
        const bf16* W = P.Wgu_t(); bf16* act = P.ACT() + (size_t)MP * DFF; const float* ssq = P.SSQS2();
        auto brow0 = [=](int c) { return W + (size_t)gu_row(32 * nt + c, 0) * DM; };
        auto brow1 = [=](int c) { return W + (size_t)gu_row(32 * nt + c, 1) * DM; };
        auto epi = [=](int ms, int c, float g, float u) { const float rs = sample_rstd(ssq, ms); const float gg = g * rs; act[(size_t)ms * DFF + 32 * nt + c] = (bf16)f2bf(gg * fsig(gg) * (u * rs)); };
        const MiniOp o{P.PROJ() + (size_t)MP * DM, DM, DM};
        mini_tile<2>(lds, o, o, mt, brow0, brow1, epi, tid); }
}
__device__ __forceinline__ void mini_down(const Ptrs& P, LAS unsigned char* lds, int vcu, int G, int tid) {
    for (int t = vcu; t < 8 * 32; t += G) { const int mt = t & 7, nt = t >> 3;
        const bf16* W = P.Wdown_t(); float* out = P.out() + (size_t)MP * DM; bf16* xb = P.XN() + (size_t)MP * DM; float* ssq = P.SSQS3();
        auto brow = [=](int c) { return W + (size_t)(32 * nt + c) * DFF; };
        auto epi = [=](int ms, int c, float v, float) { const size_t o = (size_t)ms * DM + 32 * nt + c; const float x3 = out[o] + v; out[o] = x3; xb[o] = (bf16)f2bf(x3);
            const float s = half_wave_sum32(x3 * x3); if (c == 0) ssq[(size_t)ms * 32 + nt] = s; };
        mini_tile<1>(lds, MiniOp{P.ACT() + (size_t)MP * DFF, DFF, DFF}, MiniOp{nullptr, 0, 0}, mt, brow, brow, epi, tid); }
}
__device__ __forceinline__ void mini_ple(const Ptrs& P, LAS unsigned char* lds, int vcu, int G, int tid) {
    for (int t = vcu; t < 8 * 32; t += G) { const int mt = t & 7, nt = t >> 3;
        const bf16* Wg = P.Wpg_t(); const bf16* Wp = P.Wpp_t(); float* out = P.out() + (size_t)MP * DM; const float* ssq = P.SSQS3();
        auto brow0 = [=](int c) { return Wg + (size_t)(32 * nt + c) * DM; };
        auto brow1 = [=](int c) { return Wp + (size_t)(32 * nt + c) * DPLE; };
        auto epi = [=](int ms, int c, float gl, float pp) { const size_t o = (size_t)ms * DM + 32 * nt + c; out[o] = out[o] + fsig(gl * sample_rstd(ssq, ms)) * pp; };
        mini_tile<2>(lds, MiniOp{P.XN() + (size_t)MP * DM, DM, DM}, MiniOp{P.PB() + (size_t)MP * DPLE, DPLE, DPLE}, mt, brow0, brow1, epi, tid); }
}
#ifndef MK_N_LAUNCHES
#define MK_N_LAUNCHES 1
#endif
constexpr int PER_PHASE = 16;
constexpr int N_LAUNCHES = MK_N_LAUNCHES;
__global__ void __launch_bounds__(NWAVES * 64, 2) hybrid_fwd(Args args) {
    extern __shared__ __attribute__((aligned(16))) unsigned char lds_raw[];
    LAS unsigned char* lds = (LAS unsigned char*)lds_raw;
    volatile LAS unsigned* MISC = (volatile LAS unsigned*)(lds + MISC_OFF);
    const int tid = threadIdx.x, lane = tid & 63, wave = __builtin_amdgcn_readfirstlane(tid >> 6);
    const int G = gridDim.x; const int bx = blockIdx.x; const int vcu = (G % 8 == 0) ? (bx % 8) * (G / 8) + bx / 8 : bx;
    const int gw = vcu * NWAVES + wave, NGW = G * NWAVES;
    gu32* ctl = (gu32*)(args.ws + WS_CTL);
    for (int u = tid; u < (LDS_BYTES - LDSCTL_OFF) / 4; u += NWAVES * 64) ((LAS unsigned*)(lds + LDSCTL_OFF))[u] = 0u;
    __syncthreads();
    XcdBarrier bar; bar.bar = (unsigned*)(ctl + CW_BAR); bar.x = 0; bar.st = nullptr;
    if (N_LAUNCHES != PER_PHASE) bar = xcd_barrier_post((unsigned*)(ctl + CW_BAR), MISC + 8);
#define GRID_BAR() do { if (N_LAUNCHES != PER_PHASE) xcd_barrier(bar); } while (0)
    const int lo = args.ph_lo, hi = args.ph_hi;
#ifndef PHASE_MASK
#define PHASE_MASK 0xFFFF
#endif
#define IN(k) (((PHASE_MASK >> (k)) & 1) && lo <= (k) && (k) < hi)
#define BOTH(k) (IN(k) && IN((k) + 1))
#ifndef REPEAT_MASK
#define REPEAT_MASK 0
#endif
#define REPS(k) ((((REPEAT_MASK) >> (k)) & 1) ? 2 : 1)
#define PHASE_PTRS() const __attribute__((address_space(4))) Args* ap_ = (const __attribute__((address_space(4))) Args*)__builtin_amdgcn_kernarg_segment_ptr(); asm volatile("" : "+s"(ap_)); const Ptrs P{ap_}
    if (IN(0)) { PHASE_PTRS(); for (int rep_ = 0; rep_ < REPS(0); ++rep_) {  p0_prologue(P, lds, gw, NGW, wave, lane); } if (BOTH(0)) GRID_BAR(); }
    if (IN(1)) { PHASE_PTRS(); for (int rep_ = 0; rep_ < REPS(1); ++rep_) {  pg8::Gemm g{P.XN(), P.Win_t(), MROWS, NPROJ, DM}; pg8::StaticOrder S; S.init(MROWS, NPROJ, G, bx); pg8::EpiBf16P E{P.PROJ(), NPROJ};
        pg8::gemm_phase<pg8::EpiBf16P, pg8::StaticOrder, true, true>(lds + RING_OFF, g, S, E); } if (BOTH(1)) GRID_BAR(); }
    if (IN(2)) { PHASE_PTRS(); for (int rep_ = 0; rep_ < REPS(2); ++rep_) {  p2_token_prep(P, gw, NGW, lane); } if (BOTH(2)) GRID_BAR(); }
    if (IN(3)) { PHASE_PTRS(); for (int rep_ = 0; rep_ < REPS(3); ++rep_) {  mini_lora(P, lds, vcu, G, tid); pg8::Gemm g{P.LIN(), P.Wlora_t(), MP, NLORA, KLORA}; pg8::StaticOrder S; S.init(MP, NLORA, G, bx); pg8::EpiLora E{P.XA(), (WS_AA - WS_XA) / 2, P.w0(), P.a0()}; static_assert(WS_GA - WS_AA == WS_AA - WS_XA, "x|a|g spacing");
        pg8::gemm_phase<pg8::EpiLora, pg8::StaticOrder, true, true>(lds + RING_OFF, g, S, E); } if (BOTH(3)) GRID_BAR(); }
    if (IN(4)) { PHASE_PTRS(); for (int rep_ = 0; rep_ < REPS(4); ++rep_) {  { RRaw R; rwkv_load_raw(P, vcu >> 3, vcu & 7, wave, lane, R); for (int it = vcu; it < NITEM_R; it += G) rwkv_prep_item(P, lds, it >> 3, it & 7, tid, R, it + G < NITEM_R ? (it + G) >> 3 : -1); } } if (BOTH(4)) GRID_BAR(); }
    if (IN(5)) { PHASE_PTRS(); for (int rep_ = 0; rep_ < REPS(5); ++rep_) {
        if (vcu < 32) { if (wave < 2) { const int b = vcu >> 3, h = vcu & 7; rwkv_serial_job(P, b * 128 * 8 + h, 8, 128, nullptr, P.out() + O_WKV_P + ((size_t)b * 8 + h) * 4096, wave, lane); } }
        else if (vcu < 64) { const int j = (vcu - 32) * 4 + (wave >> 1), sb = j >> 3, h = j & 7; rwkv_serial_job(P, (512 + sb) * 8 + h, 8, 1, P.swkv() + ((size_t)sb * 8 + h) * 4096, P.out() + O_WKV_S + ((size_t)sb * 8 + h) * 4096, wave & 1, lane); }
        } if (BOTH(5)) GRID_BAR(); }
    if (IN(6)) { PHASE_PTRS(); for (int rep_ = 0; rep_ < REPS(6); ++rep_) {  for (int it = gw; it < NITEM_R; it += NGW) rwkv_out_item(P, lds + wave * 9216, it >> 3, it & 7, lane); copy_state_rows(P, gw, NGW, lane); } if (BOTH(6)) GRID_BAR(); }
    if (IN(7)) { PHASE_PTRS(); for (int rep_ = 0; rep_ < REPS(7); ++rep_) {  { GRaw R; gdn_stage_conv_w(P, lds, vcu & 3, tid); gdn_load_raw(P, vcu >> 2, vcu & 3, tid, R); for (int it = vcu; it < NITEM_G; it += G) gdn_prep_item(P, lds, it >> 2, it & 3, tid, R, it + G < NITEM_G ? (it + G) >> 2 : -1); } } if (BOTH(7)) GRID_BAR(); }
    if (IN(8)) { PHASE_PTRS(); for (int rep_ = 0; rep_ < REPS(8); ++rep_) {
        if (vcu < 64) { const int j = vcu >> 2, b = j >> 2, h = j & 3; gdn_serial_job(P, lds, b * 128 * 4 + h, 4, 128, nullptr, P.out() + O_GDN_P + ((size_t)b * 4 + h) * 16384, vcu & 3, tid); }
        else for (int t = vcu - 64; t < 256; t += G - 64) { const int j = t >> 2, sb = j >> 2, h = j & 3; gdn_serial_job(P, lds, (512 + sb) * 4 + h, 4, 1, P.sgdn() + ((size_t)sb * 4 + h) * 16384, P.out() + O_GDN_S + ((size_t)sb * 4 + h) * 16384, t & 3, tid); } }
        if (BOTH(8)) GRID_BAR(); }
    if (IN(9)) { PHASE_PTRS(); for (int rep_ = 0; rep_ < REPS(9); ++rep_) {  for (int it = gw; it < NITEM_G; it += NGW) gdn_out_item(P, lds + wave * 17408, it >> 2, it & 3, lane);
        for (int m = gw; m < MROWS; m += NGW) { const float* pr = m < MP ? P.pp_() + (size_t)m * DPLE : P.ps_() + (size_t)(m - MP) * DPLE; const f32x4 pv = *(const f32x4*)(pr + 4 * lane);
            *(GAS unsigned long long*)(P.PB() + (size_t)m * DPLE + 4 * lane) = (unsigned long long)pk2(pv.x, pv.y) | ((unsigned long long)pk2(pv.z, pv.w) << 32); }
        } if (BOTH(9)) GRID_BAR(); }
    if (IN(10)) { PHASE_PTRS(); for (int rep_ = 0; rep_ < REPS(10); ++rep_) {  mini_outproj(P, lds, vcu, G, tid); pg8::Gemm g{P.XN(), P.Wout_t(), MP, DM, DM}; pg8::StaticOrder S; S.init(MP, DM, G, bx); pg8::EpiRes E{P.xp(), P.xs(), P.out(), P.PROJ(), P.SSQ2(), MP};
        pg8::gemm_phase<pg8::EpiRes, pg8::StaticOrder, true, true>(lds + RING_OFF, g, S, E); } if (BOTH(10)) GRID_BAR(); }
    if (IN(11)) { PHASE_PTRS(); for (int rep_ = 0; rep_ < REPS(11); ++rep_) {  mini_gateup(P, lds, vcu, G, tid); pg8::Gemm g{P.PROJ(), P.Wgu_t(), MP, NGU, DM}; pg8::StaticOrder S; S.init(MP, NGU, G, bx); pg8::EpiSwiGLU E{P.ACT(), P.SSQ2()};
        pg8::gemm_phase<pg8::EpiSwiGLU, pg8::StaticOrder, true, true>(lds + RING_OFF, g, S, E); } if (BOTH(11)) GRID_BAR(); }
    if (IN(12)) { PHASE_PTRS(); for (int rep_ = 0; rep_ < REPS(12); ++rep_) {  mini_down(P, lds, vcu, G, tid); pg8::Gemm g{P.ACT(), P.Wdown_t(), MP, DM, DFF}; pg8::StaticOrder S; S.init(MP, DM, G, bx); pg8::EpiRes E{P.out(), P.out() + (size_t)MP * DM, P.out(), P.XN(), P.SSQ3(), MP};
        pg8::gemm_phase<pg8::EpiRes, pg8::StaticOrder, true, true>(lds + RING_OFF, g, S, E); } if (BOTH(12)) GRID_BAR(); }
    if (IN(13)) { PHASE_PTRS(); for (int rep_ = 0; rep_ < REPS(13); ++rep_) {  pg8::Gemm g{P.PB(), P.Wpp_t(), MP, DM, DPLE}; pg8::StaticOrder S; S.init(MP, DM, G, bx); pg8::EpiBf16P E{P.PP(), DM};
        pg8::gemm_phase<pg8::EpiBf16P, pg8::StaticOrder, true, true>(lds + RING_OFF, g, S, E); } if (BOTH(13)) GRID_BAR(); }
    if (IN(14)) { PHASE_PTRS(); for (int rep_ = 0; rep_ < REPS(14); ++rep_) {  mini_ple(P, lds, vcu, G, tid); pg8::Gemm g{P.XN(), P.Wpg_t(), MP, DM, DM}; pg8::StaticOrder S; S.init(MP, DM, G, bx); pg8::EpiPle E{P.out(), P.PP(), P.SSQ3()};
        pg8::gemm_phase<pg8::EpiPle, pg8::StaticOrder, true, true>(lds + RING_OFF, g, S, E); } if (BOTH(14)) GRID_BAR(); }
    if (IN(15)) { PHASE_PTRS(); p_final_norm(P, gw, NGW, lane); }
#undef IN
#undef BOTH
}

extern "C" void kernel_launch(void* const* d_in, const int* in_sizes, int n_in, void* d_out, int out_size, void* d_ws, size_t ws_size, hipStream_t stream) {
    static int grid = 0;
    if (grid == 0) {
        if (n_in != 34 || in_sizes[0] != MP * DM || (size_t)out_size != O_END || ws_size < WS_END) { fprintf(stderr, "kernel_launch: unexpected shapes: n_in %d in0 %d out %d ws %zu (need %zu)\n", n_in, n_in > 0 ? in_sizes[0] : -1, out_size, ws_size, (size_t)WS_END); grid = -1; return; }
        int dev = 0, cus = 0, per_cu = 0;
        if (hipGetDevice(&dev) != hipSuccess || hipDeviceGetAttribute(&cus, hipDeviceAttributeMultiprocessorCount, dev) != hipSuccess) { grid = -1; return; }
        if (hipFuncSetAttribute((const void*)hybrid_fwd, hipFuncAttributeMaxDynamicSharedMemorySize, LDS_BYTES) != hipSuccess) { fprintf(stderr, "kernel_launch: hipFuncSetAttribute failed\n"); grid = -1; return; }
        if (hipOccupancyMaxActiveBlocksPerMultiprocessor(&per_cu, (const void*)hybrid_fwd, NWAVES * 64, LDS_BYTES) != hipSuccess || per_cu < 1) fprintf(stderr, "kernel_launch: occupancy query reports %d\n", per_cu);
        (void)hipGetLastError();
        grid = cus;
    }
    if (grid < 0) return;
    if (hipMemsetAsync((char*)d_ws + WS_CTL, 0, CTL_ZERO_BYTES, stream) != hipSuccess) { fprintf(stderr, "kernel_launch: memset failed\n"); return; }
    Args a{};
    for (int i = 0; i < 34; ++i) a.in[i] = (const float*)d_in[i];
    a.out = (float*)d_out; a.ws = (unsigned char*)d_ws;
    for (int li = 0; li < N_LAUNCHES; ++li) {
        a.ph_lo = (N_LAUNCHES == PER_PHASE) ? li : 0; a.ph_hi = (N_LAUNCHES == PER_PHASE) ? li + 1 : PER_PHASE;
        hipLaunchKernelGGL(hybrid_fwd, dim3(grid), dim3(NWAVES * 64), LDS_BYTES, stream, a);
        const hipError_t le = hipPeekAtLastError();
        if (le != hipSuccess) { fprintf(stderr, "kernel_launch: launch %d failed: %s\n", li, hipGetErrorName(le)); break; }
    }
}
```
